# Optimizing an MI355X kernel written in HIP

```python
import jax, jax.numpy as jnp
from jax import lax
import numpy as np

D_MODEL = 1024
BATCH = 8
SEQ = 8192
DEPTH = 1

N_META = 16
Q_BLOCK = 128
ATT_HEADS = 8
ATT_KV_HEADS = 2
HEAD_DIM = 64
ATT_W = ATT_HEADS * HEAD_DIM
KV_W = ATT_KV_HEADS * HEAD_DIM
IDX_HEADS = 8
IDX_DIM = 64
TOPK_MAX = 256
ROPE_THETA = 10000.0
CONV_W = D_MODEL // 2
CONV_K = 3
D_FF = 256 * ((8 * D_MODEL // 3 + 255) // 256)
LN_EPS = 1e-5
DEEPNORM_ALPHA = (2.0 * DEPTH) ** 0.25
DEEPNORM_BETA = (8.0 * DEPTH) ** -0.25
PROJ_WIDTHS = (ATT_W, KV_W, KV_W, IDX_HEADS * IDX_DIM, IDX_DIM, IDX_HEADS,
               CONV_W, CONV_W, CONV_W, D_MODEL, D_MODEL)
PROJ_W = sum(PROJ_WIDTHS)

kernel_name = "hybrid_dsa_shortconv_macaron_deepnorm"


def layer_norm(x, g, b):
    xf = x.astype(jnp.float32)
    mu = jnp.mean(xf, axis=-1, keepdims=True)
    xc = xf - mu
    var = jnp.mean(xc * xc, axis=-1, keepdims=True)
    y = xc * lax.rsqrt(var + LN_EPS) * g.astype(jnp.float32) + b.astype(jnp.float32)
    return y.astype(x.dtype)


def swiglu(x, w_gate, w_up, w_down):
    return (jax.nn.silu(x @ w_gate) * (x @ w_up)) @ w_down


def rope(x, pos):
    half = x.shape[-1] // 2
    inv_freq = ROPE_THETA ** (-jnp.arange(half, dtype=jnp.float32) / half)
    ang = pos.astype(jnp.float32)[:, None] * inv_freq[None, :]
    cos = jnp.cos(ang)[:, None, :]
    sin = jnp.sin(ang)[:, None, :]
    x1 = x[..., :half].astype(jnp.float32)
    x2 = x[..., half:].astype(jnp.float32)
    return jnp.concatenate([x1 * cos - x2 * sin, x2 * cos + x1 * sin], axis=-1).astype(x.dtype)


def dsa_attend(qi, wi, q, qpos, ki, k, v, topk):
    b_, t_ = q.shape[0], q.shape[1]
    kpos = jnp.arange(ki.shape[1], dtype=jnp.int32)
    s = jax.nn.relu(jnp.einsum('bthd,bsd->bths', qi, ki))
    score = jnp.einsum('bths,bth->bts', s, wi).astype(jnp.float32)
    causal = kpos[None, :] <= qpos[:, None]
    score = jnp.where(causal[None], score, -jnp.inf)
    _, idx = lax.top_k(score, topk)
    k_sel = jax.vmap(lambda kb, ib: kb[ib])(k, idx)
    v_sel = jax.vmap(lambda vb, ib: vb[ib])(v, idx)
    valid = idx <= qpos[None, :, None]
    qg = q.reshape(b_, t_, ATT_KV_HEADS, ATT_HEADS // ATT_KV_HEADS, HEAD_DIM)
    logits = jnp.einsum('btgrd,btngd->btgrn', qg, k_sel).astype(jnp.float32) * (HEAD_DIM ** -0.5)
    logits = jnp.where(valid[:, :, None, None, :], logits, -jnp.inf)
    p = jax.nn.softmax(logits, axis=-1).astype(v.dtype)
    o = jnp.einsum('btgrn,btngd->btgrd', p, v_sel)
    return o.reshape(b_, t_, ATT_W)


def short_conv(u, w):
    return lax.conv_general_dilated(
        u, w[:, None, :].astype(u.dtype), window_strides=(1,), padding=[(CONV_K - 1, 0)],
        dimension_numbers=('NWC', 'WIO', 'NWC'), feature_group_count=u.shape[-1])


def hybrid_mixer(h, w_in, conv_w, w_att_out, w_conv_out, w_o, pos, topk):
    b_, l_, _ = h.shape
    offs = np.cumsum(PROJ_WIDTHS)[:-1].tolist()
    proj = h @ w_in
    q, k, v, qi, ki, wi, u, gate_b, gate_c, g_att, g_conv = jnp.split(proj, offs, axis=-1)
    q = rope(q.reshape(b_, l_, ATT_HEADS, HEAD_DIM), pos)
    k = rope(k.reshape(b_, l_, ATT_KV_HEADS, HEAD_DIM), pos)
    v = v.reshape(b_, l_, ATT_KV_HEADS, HEAD_DIM)
    qi = rope(qi.reshape(b_, l_, IDX_HEADS, IDX_DIM), pos)
    ki = rope(ki[:, :, None, :], pos)[:, :, 0, :]
    wi = wi * ((IDX_HEADS * IDX_DIM) ** -0.5)

    att_meta = dsa_attend(qi[:, :N_META], wi[:, :N_META], q[:, :N_META], pos[:N_META], ki, k, v, topk)
    n_blk = (l_ - N_META) // Q_BLOCK

    def to_blocks(a):
        a = a[:, N_META:]
        return jnp.moveaxis(a.reshape((b_, n_blk, Q_BLOCK) + a.shape[2:]), 1, 0)

    qpos_blocks = pos[N_META:].reshape(n_blk, Q_BLOCK)
    att_real = lax.map(lambda args: dsa_attend(args[0], args[1], args[2], args[3], ki, k, v, topk),
                       (to_blocks(qi), to_blocks(wi), to_blocks(q), qpos_blocks))
    att_real = jnp.moveaxis(att_real, 0, 1).reshape(b_, l_ - N_META, ATT_W)
    att = jnp.concatenate([att_meta, att_real], axis=1)
    y_att = att @ w_att_out

    y_conv = (gate_b * short_conv(gate_c * u, conv_w)) @ w_conv_out

    merged = jax.nn.sigmoid(g_att) * y_att + jax.nn.sigmoid(g_conv) * y_conv
    return merged @ w_o


def setup_inputs(seed: int = 0) -> dict:
    key = jax.random.key(seed)
    ks = jax.random.split(key, 20)
    f32 = jnp.float32

    def nrm(k, shape, fan_in, scale=1.0):
        return jax.random.normal(k, shape, f32) * (scale * fan_in ** -0.5)

    def gain(k):
        return 1.0 + 0.02 * jax.random.normal(k, (DEPTH, D_MODEL), f32)

    def bias(k):
        return 0.02 * jax.random.normal(k, (DEPTH, D_MODEL), f32)

    beta = DEEPNORM_BETA
    return {
        "x": jax.random.normal(ks[0], (BATCH, SEQ, D_MODEL), f32),
        "meta_tokens": jax.random.normal(ks[1], (N_META, D_MODEL), f32),
        "ffn1_w_gate": nrm(ks[2], (DEPTH, D_MODEL, D_FF), D_MODEL),
        "ffn1_w_up": nrm(ks[3], (DEPTH, D_MODEL, D_FF), D_MODEL),
        "ffn1_w_down": nrm(ks[4], (DEPTH, D_FF, D_MODEL), D_FF, beta),
        "ln1_g": gain(ks[5]),
        "ln1_b": bias(ks[6]),
        "w_in": nrm(ks[7], (DEPTH, D_MODEL, PROJ_W), D_MODEL),
        "conv_w": nrm(ks[8], (DEPTH, CONV_K, CONV_W), CONV_K),
        "w_att_out": nrm(ks[9], (DEPTH, ATT_W, D_MODEL), ATT_W, beta),
        "w_conv_out": nrm(ks[10], (DEPTH, CONV_W, D_MODEL), CONV_W, beta),
        "w_o": nrm(ks[11], (DEPTH, D_MODEL, D_MODEL), D_MODEL, beta),
        "ln2_g": gain(ks[12]),
        "ln2_b": bias(ks[13]),
        "ffn2_w_gate": nrm(ks[14], (DEPTH, D_MODEL, D_FF), D_MODEL),
        "ffn2_w_up": nrm(ks[15], (DEPTH, D_MODEL, D_FF), D_MODEL),
        "ffn2_w_down": nrm(ks[16], (DEPTH, D_FF, D_MODEL), D_FF, beta),
        "ln3_g": gain(ks[17]),
        "ln3_b": bias(ks[18]),
    }


def reference(x, meta_tokens, ffn1_w_gate, ffn1_w_up, ffn1_w_down, ln1_g, ln1_b, w_in, conv_w,
              w_att_out, w_conv_out, w_o, ln2_g, ln2_b, ffn2_w_gate, ffn2_w_up, ffn2_w_down,
              ln3_g, ln3_b):
    b_ = x.shape[0]
    meta = jnp.broadcast_to(meta_tokens[None].astype(x.dtype), (b_, N_META, D_MODEL))
    h = jnp.concatenate([meta, x], axis=1)
    l_ = h.shape[1]
    pos = jnp.arange(l_, dtype=jnp.int32)
    topk = min(TOPK_MAX, l_ // 4)
    for l in range(DEPTH):
        h = layer_norm(DEEPNORM_ALPHA * h + 0.5 * swiglu(h, ffn1_w_gate[l], ffn1_w_up[l], ffn1_w_down[l]),
                       ln1_g[l], ln1_b[l])
        h = layer_norm(DEEPNORM_ALPHA * h + hybrid_mixer(h, w_in[l], conv_w[l], w_att_out[l], w_conv_out[l],
                                                         w_o[l], pos, topk),
                       ln2_g[l], ln2_b[l])
        h = layer_norm(DEEPNORM_ALPHA * h + 0.5 * swiglu(h, ffn2_w_gate[l], ffn2_w_up[l], ffn2_w_down[l]),
                       ln3_g[l], ln3_b[l])
    return h[:, N_META:]
```

```cpp
#define ONE_LAUNCH 1
#include <hip/hip_runtime.h>
#include <hip/hip_cooperative_groups.h>
#include <cstdio>
#include <cstdint>
#include <cmath>
namespace pg8 {
#define PG8_LAS __attribute__((address_space(3)))
typedef unsigned short bf16_t;
typedef short bf16x8 __attribute__((ext_vector_type(8)));
typedef float f32x4 __attribute__((ext_vector_type(4)));
typedef unsigned u32x4 __attribute__((ext_vector_type(4)));
constexpr int BM = 256, BK = 64, HALF = 128, HTB = HALF * BK * 2  , STAGE_BYTES = 8 * HTB, NXCD = 8, WGM = 8;

__host__ __device__ __forceinline__ int lds_byte(int r, int c) { const int st = (r >> 4) * 2 + (c >> 5), rr = r & 15, cc = c & 31, ob = rr * 64 + cc * 2; return st * 1024 + (ob ^ (((ob >> 9) & 1) << 5)); }
__host__ __device__ __forceinline__ void stage_rc(int b, int& R, int& C) { const int st = b / 1024, sb = b % 1024, swz = sb ^ (((sb >> 9) & 1) << 5); R = (st >> 1) * 16 + swz / 64; C = (st & 1) * 32 + (swz % 64) / 2; }
__host__ __device__ __forceinline__ int perm32(int rho) { const int n = rho >> 4, i = rho & 15; return 8 * (i >> 2) + 4 * n + (i & 3); }

struct Unit { int pm, pn; };
struct Gemm { const bf16_t* A; const bf16_t* Bt; int M, N, K; };

struct StaticOrder {
    int nM, nN, nwg, G, c;
    __host__ __device__ void init(int M, int N, int G_, int c_) { nM = M / BM; nN = N / BM; nwg = nM * nN; G = G_; c = c_; }
    __host__ __device__ bool next(int i, Unit& u) const {
        const long L = (long)i * G + c; if (L >= nwg) return false;
        int wgid = (int)L; { const int q = nwg / NXCD, r = nwg % NXCD, xcd = wgid % NXCD, off = wgid / NXCD; wgid = (xcd < r ? xcd * (q + 1) : r * (q + 1) + (xcd - r) * q) + off; }
        const int nig = WGM * nN, gid = wgid / nig, fm = gid * WGM, gsz = (nM - fm) < WGM ? (nM - fm) : WGM;
        u.pm = fm + ((wgid % nig) % gsz); u.pn = (wgid % nig) / gsz; return true;
    }
    __device__ __forceinline__ void a_ready(const Unit&) const {}
    __device__ __forceinline__ void done(const Unit&) const {}
};

__device__ __forceinline__ unsigned cvt_pk_bf16(float lo, float hi) { unsigned r; asm volatile("v_cvt_pk_bf16_f32 %0, %1, %2" : "=v"(r) : "v"(lo), "v"(hi)); return r; }
template <class Epi, class Sched, bool ALIGN_EPI = false, bool SP2 = false>
__device__ __forceinline__ void gemm_phase(PG8_LAS unsigned char* lds, const Gemm g, const Sched& S, const Epi& E) {
    const int tid = threadIdx.x, wid = __builtin_amdgcn_readfirstlane(tid >> 6), lane = tid & 63, wr = wid >> 2, wc = wid & 3, fr = lane & 15, fq = lane >> 4;
    const int K = g.K, nt = K / BK;
    unsigned voffA[2], voffB[2];
#pragma unroll
    for (int i = 0; i < 2; ++i) { int R, C; stage_rc(tid * 16 + i * 8192, R, C); const int Rb = Epi::PERM ? ((R & ~31) + perm32(R & 31)) : R;
        voffA[i] = (unsigned)(R * K + C) * 2u; voffB[i] = (unsigned)(Rb * K + C) * 2u; }
    const size_t kstep = (size_t)(BK * 2);
    const size_t hstep = (size_t)HALF * K * 2;
    const size_t tstep = 2 * hstep;
    const unsigned ldsw = (unsigned)wid * 1024u;
    const int aoff = lds_byte(wr * 64 + fr, fq * 8), boff = lds_byte(wc * 32 + fr, fq * 8);
#define PG8_SA(b, h) (((b) * 2 + (h)) * HTB)
#define PG8_SB(b, h) ((4 + (b) * 2 + (h)) * HTB)
#define PG8_STAGE(bufoff, gbase, voff) do { _Pragma("unroll") for (int _i = 0; _i < 2; ++_i) \
        __builtin_amdgcn_global_load_lds((const unsigned*)((const char*)(gbase) + (voff)[_i]), (PG8_LAS unsigned*)(lds + (bufoff) + ldsw + _i * 8192), 16, 0, 0); } while (0)
#define PG8_LDA(dst, b, h) do { _Pragma("unroll") for (int m = 0; m < 4; ++m) _Pragma("unroll") for (int k = 0; k < 2; ++k) dst[m][k] = *(const PG8_LAS bf16x8*)(lds + PG8_SA(b, h) + aoff + m * 2048 + k * 1024); } while (0)
#define PG8_LDB(dst, b, h) do { _Pragma("unroll") for (int n = 0; n < 2; ++n) _Pragma("unroll") for (int k = 0; k < 2; ++k) dst[n][k] = *(const PG8_LAS bf16x8*)(lds + PG8_SB(b, h) + boff + n * 2048 + k * 1024); } while (0)
#define PG8_MMA(ai, bj, At, Bt) do { __builtin_amdgcn_s_setprio(1); _Pragma("unroll") for (int m = 0; m < 4; ++m) _Pragma("unroll") for (int n = 0; n < 2; ++n) _Pragma("unroll") for (int k = 0; k < 2; ++k) \
        acc[ai][bj][m][n] = __builtin_amdgcn_mfma_f32_16x16x32_bf16(Bt[n][k], At[m][k], acc[ai][bj][m][n], 0, 0, 0); __builtin_amdgcn_s_setprio(0); } while (0)
#define PG8_WAIT_V(n) asm volatile("s_waitcnt vmcnt(" #n ")" ::: "memory")
#define PG8_WAIT_L(n) asm volatile("s_waitcnt lgkmcnt(" #n ")" ::: "memory")
#define PG8_BAR __builtin_amdgcn_s_barrier()
#define PG8_SCHED __builtin_amdgcn_sched_barrier(0)
    Unit cur, nxt; int ui = 0;
    if (!S.next(0, cur)) return;
    f32x4 acc[2][2][4][2];
#pragma unroll
    for (int a = 0; a < 2; ++a)
#pragma unroll
        for (int b = 0; b < 2; ++b)
#pragma unroll
            for (int m = 0; m < 4; ++m)
#pragma unroll
                for (int n = 0; n < 2; ++n) acc[a][b][m][n] = (f32x4){0.f, 0.f, 0.f, 0.f};
    bf16x8 At[4][2], B0[2][2], B1[2][2];
    const char* cA = (const char*)g.A + (size_t)cur.pm * tstep; const char* cB = (const char*)g.Bt + (size_t)cur.pn * tstep;
    S.a_ready(cur);
    if constexpr (SP2) {
        PG8_STAGE(PG8_SB(0, 0), cB, voffB); PG8_STAGE(PG8_SB(0, 1), cB + hstep, voffB); PG8_STAGE(PG8_SA(0, 0), cA, voffA); PG8_STAGE(PG8_SA(0, 1), cA + hstep, voffA);
        if (wr == 1) PG8_BAR;
        PG8_WAIT_V(2); PG8_BAR;
        PG8_STAGE(PG8_SB(1, 0), cB + kstep, voffB); PG8_STAGE(PG8_SA(1, 0), cA + kstep, voffA); PG8_STAGE(PG8_SB(1, 1), cB + hstep + kstep, voffB);
        PG8_WAIT_V(6); PG8_BAR;
    } else {
        PG8_STAGE(PG8_SB(0, 0), cB, voffB); PG8_STAGE(PG8_SA(0, 0), cA, voffA); PG8_STAGE(PG8_SB(0, 1), cB + hstep, voffB); PG8_STAGE(PG8_SA(0, 1), cA + hstep, voffA);
        if (wr == 1) PG8_BAR;
        PG8_WAIT_V(4); PG8_BAR;
        PG8_STAGE(PG8_SB(1, 0), cB + kstep, voffB); PG8_STAGE(PG8_SA(1, 0), cA + kstep, voffA); PG8_STAGE(PG8_SB(1, 1), cB + hstep + kstep, voffB);
        PG8_WAIT_V(6); PG8_BAR;
    }
    for (;;) {
        const bool has_next = S.next(ui + 1, nxt);
        const char* nA = has_next ? (const char*)g.A + (size_t)nxt.pm * tstep : cA; const char* nB = has_next ? (const char*)g.Bt + (size_t)nxt.pn * tstep : cB;
        for (int t = 0; t < nt; t += 2) {
            const bool last = (t == nt - 2);
            const char* a1 = cA + (size_t)(t + 1) * kstep;
            const char* a2 = last ? nA : cA + (size_t)(t + 2) * kstep; const char* b2 = last ? nB : cB + (size_t)(t + 2) * kstep;
            const char* a3 = a2 + kstep; const char* b3 = b2 + kstep;
            if (last && has_next) S.a_ready(nxt);
            if constexpr (SP2) {
            PG8_LDB(B0, 0, 0); PG8_LDB(B1, 0, 1); PG8_SCHED; PG8_LDA(At, 0, 0); PG8_STAGE(PG8_SA(1, 1), a1 + hstep, voffA);
            PG8_WAIT_V(8); PG8_WAIT_L(0); PG8_BAR; PG8_MMA(0, 0, At, B0); PG8_MMA(0, 1, At, B1); PG8_BAR; PG8_SCHED;
            PG8_LDA(At, 0, 1); PG8_STAGE(PG8_SB(0, 0), b2, voffB); PG8_STAGE(PG8_SB(0, 1), b2 + hstep, voffB); PG8_STAGE(PG8_SA(0, 0), a2, voffA);
            PG8_WAIT_V(8); PG8_WAIT_L(0); PG8_BAR; PG8_MMA(1, 0, At, B0); PG8_MMA(1, 1, At, B1); PG8_BAR; PG8_SCHED;
            PG8_LDB(B0, 1, 0); PG8_LDB(B1, 1, 1); PG8_SCHED; PG8_LDA(At, 1, 0); PG8_STAGE(PG8_SA(0, 1), a2 + hstep, voffA);
            PG8_WAIT_V(8); PG8_WAIT_L(0); PG8_BAR; PG8_MMA(0, 0, At, B0); PG8_MMA(0, 1, At, B1); PG8_BAR; PG8_SCHED;
            PG8_LDA(At, 1, 1); PG8_STAGE(PG8_SB(1, 0), b3, voffB); PG8_STAGE(PG8_SB(1, 1), b3 + hstep, voffB); PG8_STAGE(PG8_SA(1, 0), a3, voffA);
            PG8_WAIT_V(8); PG8_WAIT_L(0); PG8_BAR; PG8_MMA(1, 0, At, B0); PG8_MMA(1, 1, At, B1); PG8_BAR; PG8_SCHED;
            } else {
            PG8_LDB(B0, 0, 0); PG8_SCHED; PG8_LDA(At, 0, 0); PG8_STAGE(PG8_SA(1, 1), a1 + hstep, voffA);
            PG8_WAIT_L(8); PG8_BAR; PG8_WAIT_L(0); PG8_MMA(0, 0, At, B0); PG8_BAR; PG8_SCHED;
            PG8_LDB(B1, 0, 1); PG8_STAGE(PG8_SB(0, 0), b2, voffB);
            PG8_BAR; PG8_WAIT_L(0); PG8_MMA(0, 1, At, B1); PG8_BAR;
            PG8_LDA(At, 0, 1); PG8_STAGE(PG8_SA(0, 0), a2, voffA);
            PG8_BAR; PG8_WAIT_L(0); PG8_MMA(1, 0, At, B0); PG8_BAR; PG8_SCHED;
            PG8_STAGE(PG8_SB(0, 1), b2 + hstep, voffB);
            PG8_WAIT_V(6); PG8_BAR; PG8_MMA(1, 1, At, B1); PG8_BAR;
            PG8_LDB(B0, 1, 0); PG8_SCHED; PG8_LDA(At, 1, 0); PG8_STAGE(PG8_SA(0, 1), a2 + hstep, voffA);
            PG8_WAIT_L(8); PG8_BAR; PG8_WAIT_L(0); PG8_MMA(0, 0, At, B0); PG8_BAR; PG8_SCHED;
            PG8_LDB(B1, 1, 1); PG8_STAGE(PG8_SB(1, 0), b3, voffB);
            PG8_BAR; PG8_WAIT_L(0); PG8_MMA(0, 1, At, B1); PG8_BAR;
            PG8_LDA(At, 1, 1); PG8_STAGE(PG8_SA(1, 0), a3, voffA);
            PG8_BAR; PG8_WAIT_L(0); PG8_MMA(1, 0, At, B0); PG8_BAR; PG8_SCHED;
            PG8_STAGE(PG8_SB(1, 1), b3 + hstep, voffB);
            PG8_WAIT_V(6); PG8_BAR; PG8_MMA(1, 1, At, B1); PG8_BAR;
            }
        }
        if constexpr (ALIGN_EPI) { if (wr == 0) PG8_BAR; }
        if constexpr (!Epi::AFTER_DRAIN) { E(acc, cur, wr, wc, fr, fq); S.done(cur); }
        if (!has_next) break;
#pragma unroll
        for (int a = 0; a < 2; ++a)
#pragma unroll
            for (int b = 0; b < 2; ++b)
#pragma unroll
                for (int m = 0; m < 4; ++m)
#pragma unroll
                    for (int n = 0; n < 2; ++n) acc[a][b][m][n] = (f32x4){0.f, 0.f, 0.f, 0.f};
        cur = nxt; cA = nA; cB = nB; ++ui;
        if constexpr (ALIGN_EPI) { if (wr == 1) PG8_BAR; }
    }
    PG8_WAIT_V(0);
    if constexpr (!ALIGN_EPI) { if (wr == 0) PG8_BAR; }
    PG8_BAR;
    if constexpr (Epi::AFTER_DRAIN) { E.fused(acc, cur, wr, wc, fr, fq, lds, wid, lane); S.done(cur); }
#undef PG8_SA
#undef PG8_SB
#undef PG8_STAGE
#undef PG8_LDA
#undef PG8_LDB
#undef PG8_MMA
#undef PG8_WAIT_V
#undef PG8_WAIT_L
#undef PG8_BAR
#undef PG8_SCHED
}
}

#define LAS __attribute__((address_space(3)))
typedef unsigned short bf16_t;
typedef short bf16x8 __attribute__((ext_vector_type(8)));
typedef short s16x4 __attribute__((ext_vector_type(4)));
typedef float f32x4 __attribute__((ext_vector_type(4)));
typedef float f32x16 __attribute__((ext_vector_type(16)));
typedef unsigned u32x4 __attribute__((ext_vector_type(4)));
typedef unsigned u32x2 __attribute__((ext_vector_type(2)));

constexpr int NB = 8, SEQ = 8192, NMETA = 16, DM = 1024, FF = 2816;
constexpr int NREAL = NB * SEQ;
constexpr int MROWS = NREAL + 256;
constexpr float ALPHA = 1.189207115002721f;
constexpr float LN_EPS = 1e-5f;
constexpr int NWAVES = 8;
constexpr int LDS_BYTES = 147456 + 16384;
constexpr int LDS_BST = 7 * 18432 + 16512;
constexpr int CAND_CAP = 1024;
constexpr int WREG = 18432;
constexpr int NPH = 14;
#ifndef ONE_LAUNCH
#define ONE_LAUNCH 1
#endif

constexpr size_t SZ_ROPE = (size_t)8208 * 32 * 4;
constexpr size_t OFF_CTL = 0, SZ_CTL = 16384;
constexpr size_t OFF_COS = SZ_CTL, OFF_SIN = OFF_COS + SZ_ROPE;
constexpr size_t OFF_ST1 = OFF_SIN + SZ_ROPE, SZ_ST = (size_t)MROWS * 8;
constexpr size_t OFF_ST2 = OFF_ST1 + SZ_ST;
constexpr size_t OFF_WGU1 = OFF_ST2 + SZ_ST, SZ_WGU = (size_t)5632 * 1024 * 2;
constexpr size_t OFF_WD1 = OFF_WGU1 + SZ_WGU, SZ_WD = (size_t)1024 * 2816 * 2;
constexpr size_t OFF_WGU2 = OFF_WD1 + SZ_WD;
constexpr size_t OFF_WD2 = OFF_WGU2 + SZ_WGU;
constexpr size_t OFF_WIN = OFF_WD2 + SZ_WD, SZ_WIN = (size_t)3072 * 1024 * 2;
constexpr size_t OFF_WGA = OFF_WIN + SZ_WIN, SZ_W1K = (size_t)1024 * 1024 * 2;
constexpr size_t OFF_WGC = OFF_WGA + SZ_W1K;
constexpr size_t OFF_WO = OFF_WGC + SZ_W1K;
constexpr size_t OFF_WAO = OFF_WO + SZ_W1K, SZ_W512 = (size_t)1024 * 512 * 2;
constexpr size_t OFF_WCO = OFF_WAO + SZ_W512;
constexpr size_t OFF_AB = OFF_WCO + SZ_W512, SZ_AB = (size_t)MROWS * 1024 * 2;
constexpr size_t OFF_Z = OFF_AB + SZ_AB, SZ_Z = (size_t)MROWS * 1024 * 4;
constexpr size_t OFF_BIG = OFF_Z + SZ_Z, SZ_BIG = (size_t)MROWS * 2816 * 2;
constexpr size_t OFF_QS = OFF_BIG, SZ_R512 = (size_t)MROWS * 512 * 2;
constexpr size_t OFF_QI = OFF_QS + SZ_R512;
constexpr size_t OFF_KV = OFF_QI + SZ_R512;
constexpr size_t OFF_KI = OFF_KV + (size_t)MROWS * 256 * 2;
constexpr size_t OFF_WI = OFF_KI + (size_t)MROWS * 64 * 2;
constexpr size_t OFF_CU = OFF_WI + (size_t)MROWS * 8 * 4;
constexpr size_t OFF_GB = OFF_CU + SZ_R512;
constexpr size_t OFF_K8 = OFF_GB + SZ_R512;
constexpr size_t OFF_QI8 = OFF_K8 + (size_t)MROWS * 128;
constexpr size_t OFF_KI8 = OFF_QI8 + (size_t)MROWS * 512;
constexpr size_t OFF_V8 = OFF_KI8 + (size_t)MROWS * 64;
static_assert(OFF_V8 + (size_t)MROWS * 128 <= OFF_BIG + SZ_BIG, "mixer tensors overlay the FFN hidden buffer");
constexpr size_t OFF_S1 = OFF_BIG, OFF_S2 = OFF_BIG + (size_t)NREAL * 1024 * 2;
static_assert(OFF_S2 + (size_t)NREAL * 1024 * 2 <= OFF_BIG + SZ_BIG, "gate buffers overlay");
constexpr size_t OFF_ATT = OFF_BIG + SZ_BIG, SZ_ATT = (size_t)NREAL * 512 * 2;
constexpr size_t OFF_YCV = OFF_ATT + SZ_ATT;
constexpr size_t WS_END = OFF_YCV + SZ_ATT;

struct Args {
    const float* x; const float* meta;
    const float* f1g; const float* f1u; const float* f1d; const float* ln1g; const float* ln1b;
    const float* win; const float* convw; const float* wao; const float* wco; const float* wo;
    const float* ln2g; const float* ln2b; const float* f2g; const float* f2u; const float* f2d; const float* ln3g; const float* ln3b;
    float* out; unsigned char* ws; int ph_lo, ph_hi;
};

__device__ __forceinline__ unsigned f2bf(float f) { unsigned u = __builtin_bit_cast(unsigned, f); return (u + 0x7fffu + ((u >> 16) & 1u)) >> 16; }
typedef float f32x2_t __attribute__((ext_vector_type(2))); typedef __bf16 bf16x2_t __attribute__((ext_vector_type(2)));
__device__ __forceinline__ unsigned pk2(float lo, float hi) { f32x2_t v = {lo, hi}; bf16x2_t b = __builtin_convertvector(v, bf16x2_t); return __builtin_bit_cast(unsigned, b); }
__device__ __forceinline__ float bf_lo(unsigned w) { return __builtin_bit_cast(float, w << 16); }
__device__ __forceinline__ float bf_hi(unsigned w) { return __builtin_bit_cast(float, w & 0xffff0000u); }
__device__ __forceinline__ unsigned pk4_fp8(float a, float b_, float c, float d) { int w = __builtin_amdgcn_cvt_pk_fp8_f32(a, b_, 0, false); w = __builtin_amdgcn_cvt_pk_fp8_f32(c, d, w, true); return (unsigned)w; }
#define LDS_WAIT() asm volatile("s_waitcnt lgkmcnt(0)" ::: "memory")
__device__ __forceinline__ float wave_sum(float v) {
#pragma unroll
    for (int o = 1; o < 64; o <<= 1) v += __shfl_xor(v, o);
    return v;
}

struct EpiSwiglu {
    static constexpr bool PERM = true, AFTER_DRAIN = false;
    bf16_t* H;
    __device__ __forceinline__ void operator()(const f32x4 (&acc)[2][2][4][2], const pg8::Unit& u, int wr, int wc, int fr, int fq) const {
        const int row0 = u.pm * 256 + wr * 64 + fr, col0 = u.pn * 128 + wc * 32 + 8 * fq;
#pragma unroll
        for (int ai = 0; ai < 2; ++ai)
#pragma unroll
            for (int m = 0; m < 4; ++m) {
                bf16_t* rowp = H + (size_t)(row0 + ai * 128 + m * 16) * FF + col0;
                float h[8];
#pragma unroll
                for (int n = 0; n < 2; ++n)
#pragma unroll
                    for (int i = 0; i < 4; ++i) {
                        const float g = acc[ai][0][m][n][i], up = acc[ai][1][m][n][i];
                        const float e = __builtin_amdgcn_exp2f(-g * 1.4426950408889634f);
                        h[4 * n + i] = g * __builtin_amdgcn_rcpf(1.0f + e) * up;
                    }
                u32x4 w; w.x = pk2(h[0], h[1]); w.y = pk2(h[2], h[3]); w.z = pk2(h[4], h[5]); w.w = pk2(h[6], h[7]);
                *(u32x4*)rowp = w;
            }
    }
};

template <int MODE> struct EpiResid {
    static constexpr bool PERM = false, AFTER_DRAIN = false;
    const float* x; const float* meta; const float* zin; const float* stats; const float* g; const float* bta; float* zout; float scale;
    __device__ __forceinline__ void operator()(const f32x4 (&acc)[2][2][4][2], const pg8::Unit& u, int wr, int wc, int fr, int fq) const {
        const int col0 = u.pn * 256 + wc * 32 + 4 * fq;
#pragma unroll
        for (int ai = 0; ai < 2; ++ai)
#pragma unroll
            for (int m = 0; m < 4; ++m) {
                const int row = u.pm * 256 + ai * 128 + wr * 64 + m * 16 + fr;
                const float* src; float mean = 0.f, rstd = 1.f; bool have = true;
                if (MODE == 0) { src = row < NREAL ? x + (size_t)row * DM : meta + (size_t)((row - NREAL) & 15) * DM; have = row < NREAL + NMETA; }
                else { src = zin + (size_t)row * DM; mean = stats[2 * row]; rstd = stats[2 * row + 1]; }
#pragma unroll
                for (int bj = 0; bj < 2; ++bj)
#pragma unroll
                    for (int n = 0; n < 2; ++n) {
                        const int c = col0 + bj * 128 + n * 16;
                        f32x4 hv = *(const f32x4*)(src + c);
                        if (MODE == 0) { if (!have) hv = (f32x4){0.f, 0.f, 0.f, 0.f}; }
                        else { const f32x4 gv = *(const f32x4*)(g + c), bv = *(const f32x4*)(bta + c); hv = (hv - mean) * rstd * gv + bv; }
                        const f32x4 o = hv * ALPHA + acc[ai][bj][m][n] * scale;
                        *(f32x4*)(zout + (size_t)row * DM + c) = o;
                    }
                asm volatile("" ::: "memory");
            }
    }
};

template <int MODE> struct EpiGate {
    static constexpr bool PERM = true, AFTER_DRAIN = false;
    bf16_t* P; const bf16_t* Q;
    __device__ __forceinline__ void operator()(const f32x4 (&acc)[2][2][4][2], const pg8::Unit& u, int wr, int wc, int fr, int fq) const {
        const int col0 = u.pn * 256 + wc * 32 + 8 * fq;
#pragma unroll
        for (int ai = 0; ai < 2; ++ai)
#pragma unroll
            for (int m = 0; m < 4; ++m) {
                const int row = u.pm * 256 + ai * 128 + wr * 64 + m * 16 + fr;
#pragma unroll
                for (int bj = 0; bj < 2; ++bj) {
                    const size_t off = (size_t)row * DM + col0 + bj * 128;
                    float v[8];
#pragma unroll
                    for (int n = 0; n < 2; ++n)
#pragma unroll
                        for (int i = 0; i < 4; ++i) v[4 * n + i] = acc[ai][bj][m][n][i];
                    if (MODE == 0) {
#pragma unroll
                        for (int i = 0; i < 8; ++i) v[i] = __builtin_amdgcn_rcpf(1.0f + __builtin_amdgcn_exp2f(-v[i] * 1.4426950408889634f));
                    } else {
                        const u32x4 pw = *(const u32x4*)(P + off);
                        float p[8] = {bf_lo(pw.x), bf_hi(pw.x), bf_lo(pw.y), bf_hi(pw.y), bf_lo(pw.z), bf_hi(pw.z), bf_lo(pw.w), bf_hi(pw.w)};
                        if (MODE == 1) {
#pragma unroll
                            for (int i = 0; i < 8; ++i) v[i] = p[i] * v[i];
                        } else {
                            const u32x4 qw = *(const u32x4*)(Q + off);
                            float q[8] = {bf_lo(qw.x), bf_hi(qw.x), bf_lo(qw.y), bf_hi(qw.y), bf_lo(qw.z), bf_hi(qw.z), bf_lo(qw.w), bf_hi(qw.w)};
#pragma unroll
                            for (int i = 0; i < 8; ++i) v[i] = p[i] + q[i] * v[i];
                        }
                    }
                    u32x4 w; w.x = pk2(v[0], v[1]); w.y = pk2(v[2], v[3]); w.z = pk2(v[4], v[5]); w.w = pk2(v[6], v[7]);
                    *(u32x4*)(P + off) = w;
                }
                asm volatile("" ::: "memory");
            }
    }
};

struct EpiY {
    static constexpr bool PERM = true, AFTER_DRAIN = false;
    bf16_t* Y; float scale;
    __device__ __forceinline__ void operator()(const f32x4 (&acc)[2][2][4][2], const pg8::Unit& u, int wr, int wc, int fr, int fq) const {
        const int col0 = u.pn * 256 + wc * 32 + 8 * fq;
#pragma unroll
        for (int ai = 0; ai < 2; ++ai)
#pragma unroll
            for (int m = 0; m < 4; ++m) {
                const int row = u.pm * 256 + ai * 128 + wr * 64 + m * 16 + fr;
#pragma unroll
                for (int bj = 0; bj < 2; ++bj) {
                    const f32x4 a0 = acc[ai][bj][m][0] * scale, a1 = acc[ai][bj][m][1] * scale;
                    u32x4 w; w.x = pk2(a0[0], a0[1]); w.y = pk2(a0[2], a0[3]); w.z = pk2(a1[0], a1[1]); w.w = pk2(a1[2], a1[3]);
                    *(u32x4*)(Y + (size_t)row * DM + col0 + bj * 128) = w;
                }
            }
    }
};

struct EpiProj {
    static constexpr bool PERM = true, AFTER_DRAIN = false;
    bf16_t *QS, *QI, *KV, *KI, *CU, *GB; float* WI; const float* cosT; const float* sinT; unsigned char* K8; unsigned char* QI8; unsigned char* KI8; unsigned char* V8;
    __device__ __forceinline__ void rope_store_k8(const f32x4 (&acc)[2][2][4][2], int ai, int m, int pos, int fq, unsigned char* dst) const {
        const f32x4 c0 = *(const f32x4*)(cosT + pos * 32 + 8 * fq), c1 = *(const f32x4*)(cosT + pos * 32 + 8 * fq + 4);
        const f32x4 s0 = *(const f32x4*)(sinT + pos * 32 + 8 * fq), s1 = *(const f32x4*)(sinT + pos * 32 + 8 * fq + 4);
        const f32x4 a0 = acc[ai][0][m][0], a1 = acc[ai][0][m][1], b0 = acc[ai][1][m][0], b1 = acc[ai][1][m][1];
        const f32x4 lo0 = a0 * c0 - b0 * s0, lo1 = a1 * c1 - b1 * s1, hi0 = b0 * c0 + a0 * s0, hi1 = b1 * c1 + a1 * s1;
        u32x2 w; w.x = pk4_fp8(lo0[0], lo0[1], lo0[2], lo0[3]); w.y = pk4_fp8(lo1[0], lo1[1], lo1[2], lo1[3]); *(u32x2*)dst = w;
        w.x = pk4_fp8(hi0[0], hi0[1], hi0[2], hi0[3]); w.y = pk4_fp8(hi1[0], hi1[1], hi1[2], hi1[3]); *(u32x2*)(dst + 32) = w;
    }
    __device__ __forceinline__ void rope_store(const f32x4 (&acc)[2][2][4][2], int ai, int m, int pos, int fq, bf16_t* dst, float sc) const {
        const f32x4 c0 = *(const f32x4*)(cosT + pos * 32 + 8 * fq), c1 = *(const f32x4*)(cosT + pos * 32 + 8 * fq + 4);
        const f32x4 s0 = *(const f32x4*)(sinT + pos * 32 + 8 * fq), s1 = *(const f32x4*)(sinT + pos * 32 + 8 * fq + 4);
        const f32x4 a0 = acc[ai][0][m][0] * sc, a1 = acc[ai][0][m][1] * sc, b0 = acc[ai][1][m][0] * sc, b1 = acc[ai][1][m][1] * sc;
        const f32x4 lo0 = a0 * c0 - b0 * s0, lo1 = a1 * c1 - b1 * s1, hi0 = b0 * c0 + a0 * s0, hi1 = b1 * c1 + a1 * s1;
        u32x4 w; w.x = pk2(lo0[0], lo0[1]); w.y = pk2(lo0[2], lo0[3]); w.z = pk2(lo1[0], lo1[1]); w.w = pk2(lo1[2], lo1[3]);
        *(u32x4*)dst = w;
        w.x = pk2(hi0[0], hi0[1]); w.y = pk2(hi0[2], hi0[3]); w.z = pk2(hi1[0], hi1[1]); w.w = pk2(hi1[2], hi1[3]);
        *(u32x4*)(dst + 32) = w;
    }
    __device__ __forceinline__ void operator()(const f32x4 (&acc)[2][2][4][2], const pg8::Unit& u, int wr, int wc, int fr, int fq) const {
        const int pn = u.pn;
#pragma unroll
        for (int ai = 0; ai < 2; ++ai)
#pragma unroll
            for (int m = 0; m < 4; ++m) {
                const int row = u.pm * 256 + ai * 128 + wr * 64 + m * 16 + fr;
                const int pos = row < NREAL ? NMETA + (row & (SEQ - 1)) : (row - NREAL);
                if (pn < 2) {
                    rope_store(acc, ai, m, pos, fq, QS + (size_t)row * 512 + (4 * pn + wc) * 64 + 8 * fq, 0.125f);
                } else if (pn == 2) {
                    if (wc < 2) rope_store_k8(acc, ai, m, pos, fq, K8 + (size_t)row * 128 + wc * 64 + 8 * fq);
                    else {
#pragma unroll
                        for (int bj = 0; bj < 2; ++bj) {
                            const f32x4 a0 = acc[ai][bj][m][0], a1 = acc[ai][bj][m][1];
                            u32x2 w; w.x = pk4_fp8(a0[0], a0[1], a0[2], a0[3]); w.y = pk4_fp8(a1[0], a1[1], a1[2], a1[3]);
                            *(u32x2*)(V8 + (size_t)row * 128 + bj * 64 + (wc - 2) * 32 + 8 * fq) = w;
                        }
                    }
                } else if (pn < 5) {
                    rope_store_k8(acc, ai, m, pos, fq, QI8 + (size_t)row * 512 + (4 * (pn - 3) + wc) * 64 + 8 * fq);
                } else if (pn == 5) {
                    if (wc == 0) rope_store_k8(acc, ai, m, pos, fq, KI8 + (size_t)row * 64 + 8 * fq);
                    else if (wc == 1 && fq == 0) {
                        const float sc = 0.04419417382415922f;
                        *(f32x4*)(WI + (size_t)row * 8) = acc[ai][0][m][0] * sc;
                        *(f32x4*)(WI + (size_t)row * 8 + 4) = acc[ai][0][m][1] * sc;
                    }
                } else if (pn < 10) {
                    const f32x4 a0 = acc[ai][0][m][0] * acc[ai][1][m][0], a1 = acc[ai][0][m][1] * acc[ai][1][m][1];
                    u32x4 w; w.x = pk2(a0[0], a0[1]); w.y = pk2(a0[2], a0[3]); w.z = pk2(a1[0], a1[1]); w.w = pk2(a1[2], a1[3]);
                    *(u32x4*)(CU + (size_t)row * 512 + (pn - 6) * 128 + wc * 32 + 8 * fq) = w;
                } else {
#pragma unroll
                    for (int bj = 0; bj < 2; ++bj) {
                        const f32x4 a0 = acc[ai][bj][m][0], a1 = acc[ai][bj][m][1];
                        u32x4 w; w.x = pk2(a0[0], a0[1]); w.y = pk2(a0[2], a0[3]); w.z = pk2(a1[0], a1[1]); w.w = pk2(a1[2], a1[3]);
                        *(u32x4*)(GB + (size_t)row * 512 + (pn - 10) * 256 + bj * 128 + wc * 32 + 8 * fq) = w;
                    }
                }
                if (m & 1) asm volatile("" ::: "memory");
            }
    }
};

__device__ __forceinline__ void tr_item(const float* W, int N, int n0, int nvalid, int k0, bf16_t* WT, int K, int drow0, LAS float* scr, int lane) {
    const int nn4 = (lane & 7) * 4;
    f32x4 tv[8];
#pragma unroll
    for (int i = 0; i < 8; ++i) { const int kk = 8 * i + (lane >> 3); tv[i] = (f32x4){0.f, 0.f, 0.f, 0.f}; if (nn4 < nvalid) tv[i] = *(const f32x4*)(W + (size_t)(k0 + kk) * N + n0 + nn4); }
#pragma unroll
    for (int i = 0; i < 8; ++i) { const int kk = 8 * i + (lane >> 3);
#pragma unroll
        for (int j = 0; j < 4; ++j) scr[kk * 33 + nn4 + j] = tv[i][j]; }
    LDS_WAIT();
    const int c = lane & 7;
#pragma unroll
    for (int j = 0; j < 4; ++j) { const int n = (lane >> 3) + 8 * j; const LAS float* s = scr + (8 * c) * 33 + n;
        u32x4 o; o.x = pk2(s[0 * 33], s[1 * 33]); o.y = pk2(s[2 * 33], s[3 * 33]); o.z = pk2(s[4 * 33], s[5 * 33]); o.w = pk2(s[6 * 33], s[7 * 33]);
        *(u32x4*)(WT + (size_t)(drow0 + n) * K + k0 + 8 * c) = o; }
    LDS_WAIT();
}
__device__ __forceinline__ void win_group(int G, int& n0, int& nvalid) {
    const int pn = G >> 3, bj = (G >> 2) & 1, xg = G & 3; nvalid = 32;
    if (pn < 2) n0 = (pn * 4 + xg) * 64 + bj * 32;
    else if (pn == 2) { if (xg < 2) n0 = 512 + xg * 64 + bj * 32; else n0 = 640 + bj * 64 + (xg - 2) * 32; }
    else if (pn < 5) n0 = 768 + ((pn - 3) * 4 + xg) * 64 + bj * 32;
    else if (pn == 5) { if (xg == 0) n0 = 1280 + bj * 32; else if (xg == 1 && bj == 0) { n0 = 1344; nvalid = 8; } else { n0 = 0; nvalid = 0; } }
    else if (pn < 10) n0 = (bj ? 2376 : 1352) + (pn - 6) * 128 + 32 * xg;
    else n0 = 1864 + (pn - 10) * 256 + bj * 128 + 32 * xg;
}
__device__ __forceinline__ void p0_prologue(const Args& a, LAS unsigned char* lds, int gw, int NGW, int wave, int lane, int parts) {
    unsigned char* ws = a.ws;
    LAS float* scr = (LAS float*)(lds + wave * 16384);
    constexpr int I_GU = 176 * 16, I_D = 32 * 44, I_IN = 96 * 16, I_1K = 32 * 16, I_512 = 32 * 8;
    constexpr int NITEMS = 2 * I_GU + 2 * I_D + I_IN + 3 * I_1K + 2 * I_512;
    if (parts & 1)
    for (int it = gw; it < NITEMS; it += NGW) {
        int r = it;
        if (r < 2 * I_GU) { const int which = r / I_GU; r -= which * I_GU; const int kb = r / 176, G = r % 176, pn = G >> 3, bj = (G >> 2) & 1, xg = G & 3;
            const float* W = which ? (bj ? a.f2u : a.f2g) : (bj ? a.f1u : a.f1g);
            tr_item(W, FF, 128 * pn + 32 * xg, 32, 64 * kb, (bf16_t*)(ws + (which ? OFF_WGU2 : OFF_WGU1)), 1024, 32 * G, scr, lane); continue; }
        r -= 2 * I_GU;
        if (r < 2 * I_D) { const int which = r / I_D; r -= which * I_D; const int kb = r / 32, G = r % 32;
            tr_item(which ? a.f2d : a.f1d, 1024, 32 * G, 32, 64 * kb, (bf16_t*)(ws + (which ? OFF_WD2 : OFF_WD1)), FF, 32 * G, scr, lane); continue; }
        r -= 2 * I_D;
        if (r < I_IN) { const int kb = r / 96, G = r % 96; int n0, nv; win_group(G, n0, nv);
            tr_item(a.win, 4936, n0, nv, 64 * kb, (bf16_t*)(ws + OFF_WIN), 1024, 32 * G, scr, lane); continue; }
        r -= I_IN;
        if (r < I_1K) { const int kb = r / 32, G = r % 32; tr_item(a.win, 4936, 2888 + 32 * G, 32, 64 * kb, (bf16_t*)(ws + OFF_WGA), 1024, 32 * G, scr, lane); continue; }
        r -= I_1K;
        if (r < I_1K) { const int kb = r / 32, G = r % 32; tr_item(a.win, 4936, 3912 + 32 * G, 32, 64 * kb, (bf16_t*)(ws + OFF_WGC), 1024, 32 * G, scr, lane); continue; }
        r -= I_1K;
        if (r < I_1K) { const int kb = r / 32, G = r % 32; tr_item(a.wo, 1024, 32 * G, 32, 64 * kb, (bf16_t*)(ws + OFF_WO), 1024, 32 * G, scr, lane); continue; }
        r -= I_1K;
        if (r < I_512) { const int kb = r / 32, G = r % 32; tr_item(a.wao, 1024, 32 * G, 32, 64 * kb, (bf16_t*)(ws + OFF_WAO), 512, 32 * G, scr, lane); continue; }
        r -= I_512;
        { const int kb = r / 32, G = r % 32; tr_item(a.wco, 1024, 32 * G, 32, 64 * kb, (bf16_t*)(ws + OFF_WCO), 512, 32 * G, scr, lane); }
    }
    bf16_t* AB = (bf16_t*)(ws + OFF_AB);
    if (parts & 2)
    for (int row0 = gw; row0 < MROWS; row0 += 4 * NGW) {
        f32x4 hv[4][4];
#pragma unroll
        for (int r = 0; r < 4; ++r) { const int row = row0 + r * NGW;
            if (row < MROWS) { const float* src = row < NREAL ? a.x + (size_t)row * DM : a.meta + (size_t)((row - NREAL) & 15) * DM;
#pragma unroll
                for (int j = 0; j < 4; ++j) hv[r][j] = *(const f32x4*)(src + 256 * j + 4 * lane); } }
#pragma unroll
        for (int r = 0; r < 4; ++r) { const int row = row0 + r * NGW;
            if (row < MROWS) { const bool have = row < NREAL + NMETA;
#pragma unroll
                for (int j = 0; j < 4; ++j) { f32x4 v = hv[r][j]; if (!have) v = (f32x4){0.f, 0.f, 0.f, 0.f};
                    u32x2 w; w.x = pk2(v[0], v[1]); w.y = pk2(v[2], v[3]);
                    *(u32x2*)(AB + (size_t)row * DM + 256 * j + 4 * lane) = w; } } }
    }
    float* cosT = (float*)(ws + OFF_COS); float* sinT = (float*)(ws + OFF_SIN);
    if (parts & 4)
    for (int idx = gw * 64 + lane; idx < 8208 * 32; idx += NGW * 64) {
        const int pos = idx >> 5, f = idx & 31;
        double fr = 1.0; for (int i = 0; i < f; ++i) fr *= 0.7498942093324559;
        const float inv = (float)fr;
        const float angf = (float)pos * inv;
        const double ang = (double)angf;
        const double k = __builtin_rint(ang * 0.6366197723675814);
        double rr = __builtin_fma(-k, 1.5707963267948966, ang); rr = __builtin_fma(-k, 6.123233995736766e-17, rr);
        const double r2 = rr * rr;
        double sp = -1.0 / 6227020800.0; sp = sp * r2 + 1.0 / 39916800.0; sp = sp * r2 - 1.0 / 362880.0; sp = sp * r2 + 1.0 / 5040.0; sp = sp * r2 - 1.0 / 120.0; sp = sp * r2 + 1.0 / 6.0;
        const double sn = rr - rr * r2 * sp;
        double cp = 1.0 / 87178291200.0; cp = cp * r2 - 1.0 / 479001600.0; cp = cp * r2 + 1.0 / 3628800.0; cp = cp * r2 - 1.0 / 40320.0; cp = cp * r2 + 1.0 / 720.0; cp = cp * r2 - 1.0 / 24.0; cp = cp * r2 + 0.5;
        const double cs = 1.0 - r2 * cp;
        const int q = ((int)k) & 3;
        const double sv = (q == 0) ? sn : (q == 1) ? cs : (q == 2) ? -sn : -cs;
        const double cv = (q == 0) ? cs : (q == 1) ? -sn : (q == 2) ? -cs : sn;
        cosT[idx] = (float)cv; sinT[idx] = (float)sv;
    }
}

template <int MODE> __device__ __forceinline__ void skinny_meta(const bf16_t* A, int lda, const bf16_t* Bt, int K, int ntask, int gw, int NGW, int lane,
                                                                bf16_t* HFF, float* Z, const float* meta, bf16_t* KV, bf16_t* KI, bf16_t* CU, const float* cosT, const float* sinT) {
    const int fr = lane & 15, fq = lane >> 4;
    for (int task = gw; task < ntask; task += NGW) {
        int pn, x0;
        if (MODE == 0) { pn = task >> 3; x0 = (task & 7) * 16; }
        else if (MODE == 1) { pn = 0; x0 = task * 16; }
        else { if (task < 8) { pn = 2; x0 = task * 16; } else if (task < 10) { pn = 5; x0 = (task - 8) * 16; } else { pn = 6 + ((task - 10) >> 3); x0 = ((task - 10) & 7) * 16; } }
        const int r0 = (MODE == 1) ? x0 + fr : 256 * pn + x0 + fr;
        const bf16_t* ap = A + (size_t)fr * lda + 8 * fq;
        const bf16_t* b0 = Bt + (size_t)r0 * K + 8 * fq;
        const bf16_t* b1 = b0 + (size_t)128 * K;
        f32x4 acc0 = {0.f, 0.f, 0.f, 0.f}, acc1 = {0.f, 0.f, 0.f, 0.f};
#pragma unroll 8
        for (int k = 0; k < K; k += 32) {
            const bf16x8 a = *(const bf16x8*)(ap + k), x = *(const bf16x8*)(b0 + k);
            acc0 = __builtin_amdgcn_mfma_f32_16x16x32_bf16(a, x, acc0, 0, 0, 0);
            if (MODE != 1) { const bf16x8 y = *(const bf16x8*)(b1 + k); acc1 = __builtin_amdgcn_mfma_f32_16x16x32_bf16(a, y, acc1, 0, 0, 0); }
        }
#pragma unroll
        for (int i = 0; i < 4; ++i) {
            const int m = 4 * fq + i; const size_t row = (size_t)(NREAL + m); const int x = x0 + fr;
            const float a0 = acc0[i], a1 = acc1[i];
            if (MODE == 0) {
                const float e = __builtin_amdgcn_exp2f(-a0 * 1.4426950408889634f);
                HFF[row * FF + 128 * pn + x] = (bf16_t)f2bf(a0 * __builtin_amdgcn_rcpf(1.0f + e) * a1);
            } else if (MODE == 1) {
                HFF[row * DM + x] = (bf16_t)f2bf(0.5f * a0);
            } else {
                if (pn == 2) {
                    if (x < 64) { const int d = x & 31; const float c = cosT[m * 32 + d], s = sinT[m * 32 + d]; unsigned char* K8m = (unsigned char*)HFF;
                        const float lo = a0 * c - a1 * s, hi = a1 * c + a0 * s;
                        K8m[row * 128 + (x >> 5) * 64 + d] = (unsigned char)(pk4_fp8(lo, lo, lo, lo) & 0xffu); K8m[row * 128 + (x >> 5) * 64 + 32 + d] = (unsigned char)(pk4_fp8(hi, hi, hi, hi) & 0xffu); }
                    else { unsigned char* V8m = (unsigned char*)KV;
                        V8m[row * 128 + (x - 64)] = (unsigned char)(pk4_fp8(a0, a0, a0, a0) & 0xffu); V8m[row * 128 + 64 + (x - 64)] = (unsigned char)(pk4_fp8(a1, a1, a1, a1) & 0xffu); }
                } else if (pn == 5) {
                    const float c = cosT[m * 32 + x], s = sinT[m * 32 + x]; unsigned char* KI8m = (unsigned char*)KI;
                    const float lo = a0 * c - a1 * s, hi = a1 * c + a0 * s;
                    KI8m[row * 64 + x] = (unsigned char)(pk4_fp8(lo, lo, lo, lo) & 0xffu); KI8m[row * 64 + 32 + x] = (unsigned char)(pk4_fp8(hi, hi, hi, hi) & 0xffu);
                } else {
                    CU[row * 512 + (pn - 6) * 128 + x] = (bf16_t)f2bf(a0 * a1);
                }
            }
        }
    }
}

template <bool FINAL> __device__ __forceinline__ void ln_phase(const float* z, const float* g, const float* bta, bf16_t* hb, float* stats, float* outf, int nrows, int gw, int NGW, int lane) {
    f32x4 gv[4], bv[4];
#pragma unroll
    for (int j = 0; j < 4; ++j) { gv[j] = *(const f32x4*)(g + 256 * j + 4 * lane); bv[j] = *(const f32x4*)(bta + 256 * j + 4 * lane); }
    f32x4 v[4], nv[4];
    if (gw < nrows) {
#pragma unroll
        for (int j = 0; j < 4; ++j) v[j] = *(const f32x4*)(z + (size_t)gw * DM + 256 * j + 4 * lane);
    }
    for (int row = gw; row < nrows; row += NGW) {
        float s = 0.f;
#pragma unroll
        for (int j = 0; j < 4; ++j) s += (v[j][0] + v[j][1]) + (v[j][2] + v[j][3]);
        const int nrow = row + NGW;
        if (nrow < nrows) {
#pragma unroll
            for (int j = 0; j < 4; ++j) nv[j] = *(const f32x4*)(z + (size_t)nrow * DM + 256 * j + 4 * lane);
        }
        const float mean = wave_sum(s) * (1.f / DM); float s2 = 0.f;
#pragma unroll
        for (int j = 0; j < 4; ++j) { v[j] = v[j] - mean; s2 += (v[j][0] * v[j][0] + v[j][1] * v[j][1]) + (v[j][2] * v[j][2] + v[j][3] * v[j][3]); }
        const float rstd = 1.f / sqrtf(wave_sum(s2) * (1.f / DM) + LN_EPS);
#pragma unroll
        for (int j = 0; j < 4; ++j) {
            const f32x4 y = v[j] * rstd * gv[j] + bv[j];
            if (FINAL) *(f32x4*)(outf + (size_t)row * DM + 256 * j + 4 * lane) = y;
            else { u32x2 w; w.x = pk2(y[0], y[1]); w.y = pk2(y[2], y[3]); *(u32x2*)(hb + (size_t)row * DM + 256 * j + 4 * lane) = w; }
        }
#pragma unroll
        for (int j = 0; j < 4; ++j) v[j] = nv[j];
        if (!FINAL && lane == 0) { stats[2 * row] = mean; stats[2 * row + 1] = rstd; }
    }
}

template <int MODE> __device__ __forceinline__ void lnres_phase(const float* x, const float* meta, const bf16_t* Y, const float* g, const float* bta, bf16_t* hb, float* outf, int nrows, int gw, int NGW, int lane) {
    f32x4 gv[4], bv[4];
#pragma unroll
    for (int j = 0; j < 4; ++j) { gv[j] = *(const f32x4*)(g + 256 * j + 4 * lane); bv[j] = *(const f32x4*)(bta + 256 * j + 4 * lane); }
    f32x4 v[4], nv[4]; u32x2 yv[4], nyv[4];
#define LNR_LOAD(dv, dy, row) do { \
        if (MODE == 0) { const float* src_ = (row) < NREAL ? x + (size_t)(row) * DM : meta + (size_t)(((row) - NREAL) & 15) * DM; \
            _Pragma("unroll") for (int j = 0; j < 4; ++j) dv[j] = *(const f32x4*)(src_ + 256 * j + 4 * lane); } \
        else { _Pragma("unroll") for (int j = 0; j < 4; ++j) { const u32x2 p_ = *(const u32x2*)(hb + (size_t)(row) * DM + 256 * j + 4 * lane); dv[j] = (f32x4){bf_lo(p_.x), bf_hi(p_.x), bf_lo(p_.y), bf_hi(p_.y)}; } } \
        _Pragma("unroll") for (int j = 0; j < 4; ++j) dy[j] = *(const u32x2*)(Y + (size_t)(row) * DM + 256 * j + 4 * lane); } while (0)
    if (gw < nrows) LNR_LOAD(v, yv, gw);
    for (int row = gw; row < nrows; row += NGW) {
        float s = 0.f;
#pragma unroll
        for (int j = 0; j < 4; ++j) { const f32x4 yy = {bf_lo(yv[j].x), bf_hi(yv[j].x), bf_lo(yv[j].y), bf_hi(yv[j].y)}; v[j] = v[j] * ALPHA + yy; s += (v[j][0] + v[j][1]) + (v[j][2] + v[j][3]); }
        const int nrow = row + NGW;
        if (nrow < nrows) LNR_LOAD(nv, nyv, nrow);
        const float mean = wave_sum(s) * (1.f / DM); float s2 = 0.f;
#pragma unroll
        for (int j = 0; j < 4; ++j) { v[j] = v[j] - mean; s2 += (v[j][0] * v[j][0] + v[j][1] * v[j][1]) + (v[j][2] * v[j][2] + v[j][3] * v[j][3]); }
        const float rstd = 1.f / sqrtf(wave_sum(s2) * (1.f / DM) + LN_EPS);
#pragma unroll
        for (int j = 0; j < 4; ++j) {
            const f32x4 y = v[j] * rstd * gv[j] + bv[j];
            if (MODE == 2) *(f32x4*)(outf + (size_t)row * DM + 256 * j + 4 * lane) = y;
            else { u32x2 w; w.x = pk2(y[0], y[1]); w.y = pk2(y[2], y[3]); *(u32x2*)(hb + (size_t)row * DM + 256 * j + 4 * lane) = w; }
        }
#pragma unroll
        for (int j = 0; j < 4; ++j) { v[j] = nv[j]; yv[j] = nyv[j]; }
    }
#undef LNR_LOAD
}

__device__ __forceinline__ void conv_phase(const bf16_t* CU, const bf16_t* GB, const float* cw, bf16_t* YCV, int gtid, int NT) {
    for (int it = gtid; it < NREAL * 64; it += NT) {
        const int row = it >> 6, c8 = (it & 63) * 8, s = row & (SEQ - 1);
        const size_t r0 = (size_t)row, r1 = s >= 1 ? (size_t)(row - 1) : (size_t)(NREAL + 15), r2 = s >= 2 ? (size_t)(row - 2) : (size_t)(NREAL + 14 + s);
        const u32x4 x0 = *(const u32x4*)(CU + r0 * 512 + c8), x1 = *(const u32x4*)(CU + r1 * 512 + c8), x2 = *(const u32x4*)(CU + r2 * 512 + c8), gb = *(const u32x4*)(GB + r0 * 512 + c8);
        float o[8];
#pragma unroll
        for (int h = 0; h < 4; ++h) {
            const unsigned a0 = h == 0 ? x0.x : h == 1 ? x0.y : h == 2 ? x0.z : x0.w, a1 = h == 0 ? x1.x : h == 1 ? x1.y : h == 2 ? x1.z : x1.w, a2 = h == 0 ? x2.x : h == 1 ? x2.y : h == 2 ? x2.z : x2.w, gg = h == 0 ? gb.x : h == 1 ? gb.y : h == 2 ? gb.z : gb.w;
            const int c = c8 + 2 * h;
            o[2 * h] = bf_lo(gg) * (cw[c] * bf_lo(a2) + cw[512 + c] * bf_lo(a1) + cw[1024 + c] * bf_lo(a0));
            o[2 * h + 1] = bf_hi(gg) * (cw[c + 1] * bf_hi(a2) + cw[512 + c + 1] * bf_hi(a1) + cw[1024 + c + 1] * bf_hi(a0));
        }
        u32x4 w; w.x = pk2(o[0], o[1]); w.y = pk2(o[2], o[3]); w.z = pk2(o[4], o[5]); w.w = pk2(o[6], o[7]);
        *(u32x4*)(YCV + r0 * 512 + c8) = w;
    }
}

__device__ __forceinline__ float relu_i(float x) { const int i = __builtin_bit_cast(int, x); return __builtin_bit_cast(float, i > 0 ? i : 0); }
__device__ __forceinline__ size_t seqrow(int b, int idx) { return idx < NMETA ? (size_t)(NREAL + idx) : (size_t)(b * SEQ + idx - NMETA); }

__device__ __forceinline__ void find_bin(LAS unsigned* hist, unsigned need, int lane, unsigned& bin, unsigned& above) {
    const u32x4 h = *(const LAS u32x4*)(hist + 252 - 4 * lane);
    const unsigned tot = h.x + h.y + h.z + h.w;
    unsigned incl = tot;
#pragma unroll
    for (int o = 1; o < 64; o <<= 1) { const unsigned t = __shfl_up(incl, o); if (lane >= o) incl += t; }
    const unsigned excl = incl - tot;
    const bool found = excl < need && need <= incl;
    unsigned a = excl, bsel = 0, asel = 0;
    if (a + h.w >= need) { bsel = 255 - 4 * lane; asel = a; }
    else { a += h.w; if (a + h.z >= need) { bsel = 254 - 4 * lane; asel = a; } else { a += h.z; if (a + h.y >= need) { bsel = 253 - 4 * lane; asel = a; } else { a += h.y; bsel = 252 - 4 * lane; asel = a; } } }
    const unsigned long long bal = __ballot(found);
    const int src = bal ? (int)__builtin_ctzll(bal) : 0;
    bin = (unsigned)__shfl((int)bsel, src); above = (unsigned)__shfl((int)asel, src);
}

__device__ __forceinline__ void attn_phase(const bf16_t* QS, const bf16_t* QI, const bf16_t* KV, const bf16_t* KI, const float* WI, bf16_t* ATT, const unsigned char* K8,
                                           LAS unsigned char* lds, int wave, int lane) {
    const int c32 = lane & 31, hi = lane >> 5, fr = lane & 15, fq = lane >> 4;
    LAS unsigned char* myreg = lds + wave * WREG;
    LAS unsigned short* myrow = (LAS unsigned short*)myreg;
    LAS unsigned* hist = (LAS unsigned*)(myreg + 16640);
    LAS unsigned short* list = (LAS unsigned short*)(myreg + 16640 + 1024);
    LAS unsigned char* vimg = myreg;
    LAS bf16_t* obuf = (LAS bf16_t*)(myreg);
    const int G = gridDim.x, cb = blockIdx.x;
    *(LAS u32x4*)(hist + 4 * lane) = (u32x4){0u, 0u, 0u, 0u};
    LDS_WAIT();
    __syncthreads();
    for (int p = cb; p < 4096; p += G) {
        const int b = p >> 9, pidx = p & 511;
#pragma unroll 1
        for (int half = 0; half < 2; ++half) {
            const int sblk = half ? 1023 - pidx : pidx, s0 = sblk * 8;
            const int rq0 = b * SEQ + s0;
            {
                const unsigned char* QI8 = (const unsigned char*)QI; const unsigned char* KI8 = (const unsigned char*)KI;
                u32x4 qa[4];
#pragma unroll
                for (int mt = 0; mt < 4; ++mt) qa[mt] = *(const u32x4*)(QI8 + (size_t)(rq0 + 2 * mt + (fr >> 3)) * 512 + (fr & 7) * 64 + 16 * fq);
                LAS float* wmisc = (LAS float*)(myreg + 18176);
                wmisc[lane] = WI[(size_t)rq0 * 8 + lane];
                LDS_WAIT();
                const LAS float* wrd = wmisc + (fq >> 1) * 8 + 4 * (fq & 1);
                const int nmax = NMETA + s0 + 8, ntile = (nmax + 15) >> 4;
                const int qa_ = 2 * (fq & 1) + (fq >> 1);
                asm volatile("" : "+v"(qa[0]), "+v"(qa[1]), "+v"(qa[2]), "+v"(qa[3]) :: "memory");
#define S1_LOAD(dst, tt) do { const int kk_ = 16 * (tt) + fr, kld_ = kk_ < nmax ? kk_ : nmax - 1; const unsigned char* kp_ = KI8 + seqrow(b, kld_) * 64 + 16 * fq; \
        asm volatile("global_load_dwordx4 %0, %1, off" : "=&v"(dst) : "v"(kp_) : "memory"); } while (0)
#define S1_WAIT(nn, dst) asm volatile("s_waitcnt vmcnt(" #nn ")" : "+v"(dst) :: "memory")
#define S1_TILE(kbv, tt) do { const int kk = 16 * (tt) + fr; float part_[4]; \
        const long kb0_ = (long)(((unsigned long long)kbv.y << 32) | kbv.x), kb1_ = (long)(((unsigned long long)kbv.w << 32) | kbv.z); \
        _Pragma("unroll") for (int mt = 0; mt < 4; ++mt) { f32x4 acc_ = {0.f, 0.f, 0.f, 0.f}; \
            acc_ = __builtin_amdgcn_mfma_f32_16x16x32_fp8_fp8((long)(((unsigned long long)qa[mt].y << 32) | qa[mt].x), kb0_, acc_, 0, 0, 0); \
            acc_ = __builtin_amdgcn_mfma_f32_16x16x32_fp8_fp8((long)(((unsigned long long)qa[mt].w << 32) | qa[mt].z), kb1_, acc_, 0, 0, 0); \
            const f32x4 w_ = *(const LAS f32x4*)(wrd + 16 * mt); float p_ = 0.f; \
            _Pragma("unroll") for (int i = 0; i < 4; ++i) p_ = __builtin_fmaf(w_[i], relu_i(acc_[i]), p_); \
            part_[mt] = p_; } \
        _Pragma("unroll") for (int pr = 0; pr < 2; ++pr) { \
            auto rr_ = __builtin_amdgcn_permlane16_swap(__builtin_bit_cast(unsigned, part_[2 * pr]), __builtin_bit_cast(unsigned, part_[2 * pr + 1]), false, false); \
            const float tot_ = __builtin_bit_cast(float, (unsigned)rr_[0]) + __builtin_bit_cast(float, (unsigned)rr_[1]); \
            const int q = 4 * pr + qa_; const _Float16 hh = (_Float16)tot_; const unsigned hb = (unsigned)__builtin_bit_cast(unsigned short, hh); \
            unsigned key = (hb & 0x8000u) ? (~hb & 0xffffu) : (hb | 0x8000u); \
            const bool valid = kk <= NMETA + s0 + q; if (!valid) key = 0u; \
            *(LAS unsigned short*)(lds + q * WREG + kk * 2) = (unsigned short)key; \
            __hip_atomic_fetch_add((LAS unsigned*)(lds + q * WREG + 16640) + (key >> 8), valid ? 1u : 0u, __ATOMIC_RELAXED, __HIP_MEMORY_SCOPE_WORKGROUP); } } while (0)
                u32x4 kr0, kr1, kr2, kr3, kr4, kr5, kr6, kr7;
                S1_LOAD(kr0, wave); S1_LOAD(kr1, wave + NWAVES); S1_LOAD(kr2, wave + 2 * NWAVES); S1_LOAD(kr3, wave + 3 * NWAVES);
                S1_LOAD(kr4, wave + 4 * NWAVES); S1_LOAD(kr5, wave + 5 * NWAVES); S1_LOAD(kr6, wave + 6 * NWAVES); S1_LOAD(kr7, wave + 7 * NWAVES);
#define S1_STEP(kr, off) do { S1_WAIT(7, kr); if (t + (off) * NWAVES < ntile) { S1_TILE(kr, t + (off) * NWAVES); } S1_LOAD(kr, t + ((off) + 8) * NWAVES); } while (0)
                for (int t = wave; t < ntile; t += 8 * NWAVES) {
                    S1_STEP(kr0, 0); S1_STEP(kr1, 1); S1_STEP(kr2, 2); S1_STEP(kr3, 3); S1_STEP(kr4, 4); S1_STEP(kr5, 5); S1_STEP(kr6, 6); S1_STEP(kr7, 7);
                }
                S1_WAIT(0, kr0); S1_WAIT(0, kr1); S1_WAIT(0, kr2); S1_WAIT(0, kr3); S1_WAIT(0, kr4); S1_WAIT(0, kr5); S1_WAIT(0, kr6); S1_WAIT(0, kr7);
#undef S1_STEP
#undef S1_LOAD
#undef S1_WAIT
#undef S1_TILE
            }
            LDS_WAIT();
            __syncthreads();
            const int n = NMETA + s0 + wave + 1;
            const int cnt = n < 256 ? n : 256;
            if (n <= 256) {
#pragma unroll
                for (int i = 0; i < 4; ++i) { const int s = i * 64 + lane; list[s] = (unsigned short)(s < n ? s : 0); }
                LDS_WAIT();
                *(LAS u32x4*)(hist + 4 * lane) = (u32x4){0u, 0u, 0u, 0u};
            } else {
                unsigned b1, ab1; find_bin(hist, 256u, lane, b1, ab1);
                const unsigned c1 = hist[b1];
                if (c1 <= (unsigned)CAND_CAP) {
                    LAS unsigned short* cand = (LAS unsigned short*)(lds + 147456 + wave * 2048);
                    const unsigned need2 = 256u - ab1;
                    LDS_WAIT();
                    *(LAS u32x4*)(hist + 4 * lane) = (u32x4){0u, 0u, 0u, 0u};
                    const int nit = (n + 255) >> 8;
                    unsigned sel_cnt = 0, cand_cnt = 0;
                    u32x2 kwm = *(const LAS u32x2*)(myrow + 4 * lane);
                    for (int it = 0; it < nit; ++it) {
                        const int i0 = 4 * (64 * it + lane);
                        const u32x2 kw = kwm;
                        kwm = *(const LAS u32x2*)(myrow + i0 + 256);
                        const unsigned k[4] = {kw.x & 0xffffu, kw.x >> 16, kw.y & 0xffffu, kw.y >> 16};
                        bool gt[4], cd[4]; unsigned cg = 0, cc = 0;
#pragma unroll
                        for (int j = 0; j < 4; ++j) { const bool in = i0 + j < n; const unsigned hj = k[j] >> 8; gt[j] = in && hj > b1; cd[j] = in && hj == b1; cg += gt[j] ? 1u : 0u; cc += cd[j] ? 1u : 0u; }
                        const unsigned v = cg | (cc << 16);
                        unsigned incl = v;
                        incl += (unsigned)__builtin_amdgcn_update_dpp(0, (int)incl, 0x111, 0xf, 0xf, false);
                        incl += (unsigned)__builtin_amdgcn_update_dpp(0, (int)incl, 0x112, 0xf, 0xf, false);
                        incl += (unsigned)__builtin_amdgcn_update_dpp(0, (int)incl, 0x114, 0xf, 0xf, false);
                        incl += (unsigned)__builtin_amdgcn_update_dpp(0, (int)incl, 0x118, 0xf, 0xf, false);
                        incl += (unsigned)__builtin_amdgcn_update_dpp(0, (int)incl, 0x142, 0xa, 0xf, false);
                        incl += (unsigned)__builtin_amdgcn_update_dpp(0, (int)incl, 0x143, 0xc, 0xf, false);
                        const unsigned excl = incl - v, tot = (unsigned)__builtin_amdgcn_readlane((int)incl, 63);
                        unsigned ps = sel_cnt + (excl & 0xffffu), pc = cand_cnt + (excl >> 16);
#pragma unroll
                        for (int j = 0; j < 4; ++j) {
                            if (gt[j] && ps < 256u) list[ps] = (unsigned short)(i0 + j);
                            if (cd[j] && pc < (unsigned)CAND_CAP) cand[pc] = (unsigned short)(i0 + j);
                            ps += gt[j] ? 1u : 0u; pc += cd[j] ? 1u : 0u;
                        }
                        sel_cnt += tot & 0xffffu; cand_cnt += tot >> 16;
                    }
                    LDS_WAIT();
                    for (unsigned i = lane; i < c1; i += 64) { const unsigned key = myrow[cand[i]]; __hip_atomic_fetch_add(hist + (key & 255u), 1u, __ATOMIC_RELAXED, __HIP_MEMORY_SCOPE_WORKGROUP); }
                    LDS_WAIT();
                    unsigned b2, ab2; find_bin(hist, need2, lane, b2, ab2);
                    const unsigned need_eq = need2 - ab2;
                    LDS_WAIT();
                    *(LAS u32x4*)(hist + 4 * lane) = (u32x4){0u, 0u, 0u, 0u};
                    unsigned out_cnt = ab1, eq_cnt = 0;
                    for (unsigned base = 0; base < c1; base += 64) {
                        const unsigned i = base + lane; const bool in = i < c1;
                        const unsigned idx = in ? (unsigned)cand[i] : 0u;
                        const unsigned lo = (unsigned)myrow[idx] & 255u;
                        const bool g2 = in && lo > b2, e2 = in && lo == b2;
                        const unsigned long long eqb = __ballot(e2);
                        const unsigned eq_rank = eq_cnt + __builtin_amdgcn_mbcnt_hi((unsigned)(eqb >> 32), __builtin_amdgcn_mbcnt_lo((unsigned)eqb, 0u));
                        const bool sel = g2 || (e2 && eq_rank < need_eq);
                        const unsigned long long sb = __ballot(sel);
                        const unsigned pos = out_cnt + __builtin_amdgcn_mbcnt_hi((unsigned)(sb >> 32), __builtin_amdgcn_mbcnt_lo((unsigned)sb, 0u));
                        if (sel && pos < 256u) list[pos] = (unsigned short)idx;
                        out_cnt += (unsigned)__popcll(sb); eq_cnt += (unsigned)__popcll(eqb);
                    }
                } else {
                const unsigned need2 = 256u - ab1;
                LDS_WAIT();
                *(LAS u32x4*)(hist + 4 * lane) = (u32x4){0u, 0u, 0u, 0u};
                LDS_WAIT();
                const int nit = (n + 255) >> 8;
                u32x2 kwn = *(const LAS u32x2*)(myrow + 4 * lane);
                for (int it = 0; it < nit; ++it) {
                    const int i0 = 4 * (64 * it + lane);
                    const u32x2 kw = kwn;
                    kwn = *(const LAS u32x2*)(myrow + i0 + 256);
                    const unsigned k0 = kw.x & 0xffffu, k1 = kw.x >> 16, k2 = kw.y & 0xffffu, k3 = kw.y >> 16;
                    if (i0 + 0 < n && (k0 >> 8) == b1) __hip_atomic_fetch_add(hist + (k0 & 255u), 1u, __ATOMIC_RELAXED, __HIP_MEMORY_SCOPE_WORKGROUP);
                    if (i0 + 1 < n && (k1 >> 8) == b1) __hip_atomic_fetch_add(hist + (k1 & 255u), 1u, __ATOMIC_RELAXED, __HIP_MEMORY_SCOPE_WORKGROUP);
                    if (i0 + 2 < n && (k2 >> 8) == b1) __hip_atomic_fetch_add(hist + (k2 & 255u), 1u, __ATOMIC_RELAXED, __HIP_MEMORY_SCOPE_WORKGROUP);
                    if (i0 + 3 < n && (k3 >> 8) == b1) __hip_atomic_fetch_add(hist + (k3 & 255u), 1u, __ATOMIC_RELAXED, __HIP_MEMORY_SCOPE_WORKGROUP);
                }
                LDS_WAIT();
                unsigned b2, ab2; find_bin(hist, need2, lane, b2, ab2);
                const unsigned T = (b1 << 8) | b2, need_eq = need2 - ab2;
                LDS_WAIT();
                *(LAS u32x4*)(hist + 4 * lane) = (u32x4){0u, 0u, 0u, 0u};
                unsigned sel_cnt = 0, eq_cnt = 0;
                u32x2 kwm = *(const LAS u32x2*)(myrow + 4 * lane);
                for (int it = 0; it < nit; ++it) {
                    const int i0 = 4 * (64 * it + lane);
                    const u32x2 kw = kwm;
                    kwm = *(const LAS u32x2*)(myrow + i0 + 256);
                    unsigned k[4] = {kw.x & 0xffffu, kw.x >> 16, kw.y & 0xffffu, kw.y >> 16};
                    unsigned cg = 0, ce = 0;
#pragma unroll
                    for (int j = 0; j < 4; ++j) { if (i0 + j >= n) k[j] = 0u; cg += (k[j] > T) ? 1u : 0u; ce += (k[j] == T) ? 1u : 0u; }
                    const unsigned v = cg | (ce << 16);
                    unsigned incl = v;
                    incl += (unsigned)__builtin_amdgcn_update_dpp(0, (int)incl, 0x111, 0xf, 0xf, false);
                    incl += (unsigned)__builtin_amdgcn_update_dpp(0, (int)incl, 0x112, 0xf, 0xf, false);
                    incl += (unsigned)__builtin_amdgcn_update_dpp(0, (int)incl, 0x114, 0xf, 0xf, false);
                    incl += (unsigned)__builtin_amdgcn_update_dpp(0, (int)incl, 0x118, 0xf, 0xf, false);
                    incl += (unsigned)__builtin_amdgcn_update_dpp(0, (int)incl, 0x142, 0xa, 0xf, false);
                    incl += (unsigned)__builtin_amdgcn_update_dpp(0, (int)incl, 0x143, 0xc, 0xf, false);
                    const unsigned excl = incl - v, tot = (unsigned)__builtin_amdgcn_readlane((int)incl, 63);
                    const unsigned pg = excl & 0xffffu, pe = excl >> 16;
                    const unsigned base_eq = eq_cnt < need_eq ? eq_cnt : need_eq;
                    unsigned r_eq = eq_cnt + pe;
                    unsigned pos = sel_cnt + pg + ((r_eq < need_eq ? r_eq : need_eq) - base_eq);
#pragma unroll
                    for (int j = 0; j < 4; ++j) {
                        const bool gt = k[j] > T, eq = k[j] == T;
                        const bool take = gt || (eq && r_eq < need_eq);
                        if (take && pos < 256u) list[pos] = (unsigned short)(i0 + j);
                        pos += take ? 1u : 0u; r_eq += eq ? 1u : 0u;
                    }
                    const unsigned tg = tot & 0xffffu, te = tot >> 16;
                    const unsigned e1 = eq_cnt + te;
                    sel_cnt += tg + ((e1 < need_eq ? e1 : need_eq) - base_eq); eq_cnt = e1;
                }
                            }
            }
            LDS_WAIT();
#ifdef PROBE_S3X2
            for (int rep3 = 0; rep3 < 2; ++rep3)
#endif
            {
                const int rq = rq0 + wave;
                long qb[4];
                {
                    const bool qv = fr < 8 && (fr >> 2) == (fq >> 1);
                    const bf16_t* qp = QS + (size_t)rq * 512 + (qv ? fr : 0) * 64 + ((32 * fq) & 63);
#pragma unroll
                    for (int s = 0; s < 4; ++s) {
                        const u32x4 w = *(const u32x4*)(qp + 8 * s);
                        const unsigned lo = pk4_fp8(bf_lo(w.x) * 8.f, bf_hi(w.x) * 8.f, bf_lo(w.y) * 8.f, bf_hi(w.y) * 8.f), hi = pk4_fp8(bf_lo(w.z) * 8.f, bf_hi(w.z) * 8.f, bf_lo(w.w) * 8.f, bf_hi(w.w) * 8.f);
                        qb[s] = qv ? (long)(((unsigned long long)hi << 32) | lo) : 0l;
                    }
                }
                const int vR = lane >> 4, vpc = lane & 15;
#define V_DMA(kk) do { _Pragma("unroll") for (int it = 0; it < 4; ++it) { const int rho_ = 8 * it + (lane >> 3), j_ = rho_ & 7, f_ = rho_ >> 3; \
        const int kidx_ = list[32 * (kk) + (j_ < 4 ? 4 * f_ + j_ : 12 + 4 * f_ + j_)]; \
        const unsigned char* gp_ = V8 + seqrow(b, kidx_) * 128 + 16 * ((lane & 7) ^ ((rho_ >> 1) & 7)); \
        __builtin_amdgcn_global_load_lds((const unsigned*)gp_, (LAS unsigned*)(vimg + ((kk) & 3) * 4096 + it * 1024), 16, 0, 0); } } while (0)
#define K_LOAD(dst, t) do { const int kidx_ = list[(t) * 16 + fr]; const unsigned char* kp_ = K8 + seqrow(b, kidx_) * 128 + 32 * fq; \
        dst[0] = *(const u32x4*)kp_; dst[1] = *(const u32x4*)(kp_ + 16); } while (0)
                const unsigned char* V8 = (const unsigned char*)KV;
                V_DMA(0); V_DMA(1); V_DMA(2); V_DMA(3);
                u32x4 ka[8][2];
#pragma unroll
                for (int t = 0; t < 8; ++t) K_LOAD(ka[t], t);
                f32x4 sc[16];
#pragma unroll
                for (int t = 0; t < 16; ++t) {
                    f32x4 acc = {0.f, 0.f, 0.f, 0.f};
#pragma unroll
                    for (int s = 0; s < 4; ++s) { const u32x4 kw_ = ka[t & 7][s >> 1]; const unsigned l_ = (s & 1) ? kw_.z : kw_.x, h_ = (s & 1) ? kw_.w : kw_.y;
                        acc = __builtin_amdgcn_mfma_f32_16x16x32_fp8_fp8((long)(((unsigned long long)h_ << 32) | l_), qb[s], acc, 0, 0, 0); }
                    sc[t] = acc * 0.125f;
                    if (t + 8 < 16) K_LOAD(ka[t & 7], t + 8);
                    __builtin_amdgcn_sched_barrier(0);
                }
#undef K_LOAD
                float mx = -INFINITY;
#pragma unroll
                for (int t = 0; t < 16; ++t)
#pragma unroll
                    for (int i = 0; i < 4; ++i) { if (16 * t + 4 * fq + i >= cnt) sc[t][i] = -INFINITY; mx = fmaxf(mx, sc[t][i]); }
                mx = fmaxf(mx, __shfl_xor(mx, 16)); mx = fmaxf(mx, __shfl_xor(mx, 32));
                float l = 0.f;
#pragma unroll
                for (int t = 0; t < 16; ++t)
#pragma unroll
                    for (int i = 0; i < 4; ++i) { const float e = __builtin_amdgcn_exp2f((sc[t][i] - mx) * 1.4426950408889634f); sc[t][i] = e; l += e; }
                l += __shfl_xor(l, 16); l += __shfl_xor(l, 32);
                long pa[8];
#pragma unroll
                for (int kk = 0; kk < 8; ++kk) { const unsigned lo_ = pk4_fp8(sc[2 * kk][0], sc[2 * kk][1], sc[2 * kk][2], sc[2 * kk][3]), hi_ = pk4_fp8(sc[2 * kk + 1][0], sc[2 * kk + 1][1], sc[2 * kk + 1][2], sc[2 * kk + 1][3]); pa[kk] = (long)(((unsigned long long)hi_ << 32) | lo_); }
                f32x4 o[8];
#pragma unroll
                for (int nt = 0; nt < 8; ++nt) o[nt] = (f32x4){0.f, 0.f, 0.f, 0.f};
                const int vrow = 8 * fq + ((lane & 15) >> 1), vswz = (vrow >> 1) & 7;
                const LAS unsigned char* vb = vimg + vrow * 128 + 8 * (lane & 1);
                typedef int v2i32_t __attribute__((ext_vector_type(2)));
#define PV_STEP(kk) do { \
        if ((kk) <= 4) asm volatile("s_waitcnt vmcnt(12)" ::: "memory"); else if ((kk) == 5) asm volatile("s_waitcnt vmcnt(8)" ::: "memory"); else if ((kk) == 6) asm volatile("s_waitcnt vmcnt(4)" ::: "memory"); else asm volatile("s_waitcnt vmcnt(0)" ::: "memory"); \
        _Pragma("unroll") for (int nt = 0; nt < 8; ++nt) { \
            const v2i32_t vv_ = __builtin_amdgcn_ds_read_tr8_b64_v2i32((LAS v2i32_t*)(vb + ((kk) & 3) * 4096 + ((nt ^ vswz) << 4))); \
            o[nt] = __builtin_amdgcn_mfma_f32_16x16x32_fp8_fp8(pa[kk], (long)(((unsigned long long)(unsigned)vv_[1] << 32) | (unsigned)vv_[0]), o[nt], 0, 0, 0); } \
        LDS_WAIT(); \
        if ((kk) + 4 < 8) V_DMA((kk) + 4); __builtin_amdgcn_sched_barrier(0); } while (0)
                PV_STEP(0); PV_STEP(1); PV_STEP(2); PV_STEP(3); PV_STEP(4); PV_STEP(5); PV_STEP(6); PV_STEP(7);
#undef PV_STEP
#undef V_DMA
                LDS_WAIT();
                float linv[4];
#pragma unroll
                for (int i = 0; i < 4; ++i) linv[i] = 1.0f / __shfl(l, (4 * fq + i) & 7);
#pragma unroll
                for (int nt = 0; nt < 8; ++nt) {
                    if (fq == (nt >> 2)) {
#pragma unroll
                        for (int i = 0; i < 4; ++i) obuf[(4 * fq + i) * 64 + (nt & 3) * 16 + fr] = (bf16_t)f2bf(o[nt][i] * linv[i]);
                    }
                }
                LDS_WAIT();
                const u32x4 ov = *(const LAS u32x4*)((LAS unsigned char*)obuf + lane * 16);
                *(u32x4*)(ATT + (size_t)rq * 512 + lane * 8) = ov;
            }
            LDS_WAIT();
            __syncthreads();
        }
    }
}


#define XB_TMO      128
#define XB_XCNT(j)  (256  + 64 * (j))
#define XB_XSUB(j)  (1280 + 64 * (j))
#define XB_XGEN(j)  (2304 + 64 * (j))
#define XB_TOP      3328
#define XB_TOPGEN   3392
#define XCD_BAR_WORDS 3456
#define XB_SPIN_CAP (1u << 18)

__device__ __forceinline__ unsigned xb_ld(unsigned* p)              { return __hip_atomic_load(p, __ATOMIC_RELAXED, __HIP_MEMORY_SCOPE_AGENT); }
__device__ __forceinline__ unsigned xb_add(unsigned* p, unsigned v) { return __hip_atomic_fetch_add(p, v, __ATOMIC_RELAXED, __HIP_MEMORY_SCOPE_AGENT); }
__device__ __forceinline__ unsigned xb_xcc_id() { return (unsigned)__builtin_amdgcn_s_getreg((3 << 11) | 20) & 0xFu; }
#define XB_SPIN(cond, bar) do { unsigned _sp = 0; while (cond) { __builtin_amdgcn_s_sleep(1); \
    if ((++_sp & 255u) == 0u) { if (xb_ld(&(bar)[XB_TMO])) break; if (_sp > XB_SPIN_CAP) { atomicAdd(&(bar)[XB_TMO], 1u); break; } } } } while (0)

struct XcdBarrier {
    unsigned* bar; unsigned x;
    volatile LAS unsigned* st;
};

__device__ __forceinline__ XcdBarrier xcd_barrier_post(unsigned* bar, volatile LAS unsigned* st) {
    XcdBarrier b; b.bar = bar; b.x = xb_xcc_id(); b.st = st;
    if (threadIdx.x == 0) (void)xb_add(&bar[XB_XCNT(b.x)], 1u);
    return b;
}
__device__ __forceinline__ void xcd_barrier_complete(unsigned* bar, unsigned x, unsigned& nloc, unsigned& nx) {
    const unsigned G = gridDim.x * gridDim.y * gridDim.z;
    unsigned sum, cnt, mine, sp = 0u;
    for (;;) {
        sum = 0u; cnt = 0u; mine = 0u;
#pragma unroll
        for (unsigned j = 0; j < 16; ++j) { const unsigned c = xb_ld(&bar[XB_XCNT(j)]); sum += c; cnt += (c > 0u) ? 1u : 0u; mine = (j == x) ? c : mine; }
        if (sum == G) break;
        __builtin_amdgcn_s_sleep(1);
        if ((++sp & 255u) == 0u) { if (xb_ld(&bar[XB_TMO])) break; if (sp > XB_SPIN_CAP) { atomicAdd(&bar[XB_TMO], 1u); break; } }
    }
    nloc = mine > 0u ? mine : 1u; nx = cnt > 0u ? cnt : 1u;
}

__device__ __forceinline__ void xcd_barrier(const XcdBarrier& b) {
    asm volatile("s_waitcnt vmcnt(0)" ::: "memory");
    __syncthreads();
    if (threadIdx.x == 0) {
        unsigned* bar = b.bar;
        __builtin_amdgcn_s_waitcnt(0);
        unsigned nloc = b.st[0], nx = b.st[1];
        if (nloc == 0u) { xcd_barrier_complete(bar, b.x, nloc, nx); b.st[0] = nloc; b.st[1] = nx; }
        const unsigned old = xb_add(&bar[XB_XSUB(b.x)], 1u);
        const unsigned gen = old / nloc;
        if (old + 1u == (gen + 1u) * nloc) {
            __builtin_amdgcn_fence(__ATOMIC_RELEASE, "agent");
            asm volatile("s_waitcnt vmcnt(0)" ::: "memory");
            const unsigned og = xb_add(&bar[XB_TOP], 1u);
            const unsigned tg = og / nx;
            if (og + 1u == (tg + 1u) * nx) xb_add(&bar[XB_TOPGEN], 1u);
            else XB_SPIN(xb_ld(&bar[XB_TOPGEN]) == tg, bar);
            __builtin_amdgcn_fence(__ATOMIC_ACQUIRE, "agent");
            xb_add(&bar[XB_XGEN(b.x)], 1u);
            asm volatile("s_waitcnt vmcnt(0)" ::: "memory");
        } else {
            XB_SPIN(xb_ld(&bar[XB_XGEN(b.x)]) == gen, bar);
            __builtin_amdgcn_fence(__ATOMIC_ACQUIRE, "agent");
            asm volatile("s_waitcnt vmcnt(0)" ::: "memory");
        }
    }
    __syncthreads();
}

__global__ void __launch_bounds__(NWAVES * 64, 2) mk_fwd(Args a) {
    extern __shared__ __attribute__((aligned(16))) unsigned char lds_raw[];
    LAS unsigned char* lds = (LAS unsigned char*)lds_raw;
    const int tid = threadIdx.x, lane = tid & 63, wave = __builtin_amdgcn_readfirstlane(tid >> 6);
    const int G = gridDim.x, gw = blockIdx.x * NWAVES + wave, NGW = G * NWAVES;
    unsigned char* ws = a.ws;
    bf16_t* AB = (bf16_t*)(ws + OFF_AB); float* Z = (float*)(ws + OFF_Z); bf16_t* HFF = (bf16_t*)(ws + OFF_BIG);
    float* ST1 = (float*)(ws + OFF_ST1); float* ST2 = (float*)(ws + OFF_ST2);
    const int lo = a.ph_lo, hi = a.ph_hi;
    volatile LAS unsigned* bst = (volatile LAS unsigned*)(lds + LDS_BST);
    if (tid < 2) bst[tid] = 0u;
    __syncthreads();
    XcdBarrier gbar = xcd_barrier_post((unsigned*)(ws + OFF_CTL), bst);
#define IN(k) (lo <= (k) && (k) < hi)
#define SEAM(k) do { if (IN(k) && IN((k) + 1)) { if ((k) == 0) cooperative_groups::this_grid().sync(); else xcd_barrier(gbar); } } while (0)

    if (IN(0)) { p0_prologue(a, lds, gw, NGW, wave, lane, 7);
#ifdef PROBE_P0_PARTS
        p0_prologue(a, lds, gw, NGW, wave, lane, PROBE_P0_PARTS);
#endif
 }
    SEAM(0);
#ifdef PROBE_SYNC10
    for (int r_ = 0; r_ < 10; ++r_) cooperative_groups::this_grid().sync();
#endif
    if (IN(1)) { pg8::Gemm g{AB, (const bf16_t*)(ws + OFF_WGU1), NREAL, 5632, 1024}; pg8::StaticOrder S; S.init(NREAL, 5632, G, (int)blockIdx.x);
        EpiSwiglu E{HFF}; pg8::gemm_phase<EpiSwiglu, pg8::StaticOrder, true, true>(lds, g, S, E);
        skinny_meta<0>(AB + (size_t)NREAL * DM, DM, (const bf16_t*)(ws + OFF_WGU1), 1024, 22 * 8, gw, NGW, lane, HFF, nullptr, nullptr, nullptr, nullptr, nullptr, nullptr, nullptr); }
    SEAM(1);
    bf16_t* Y12 = (bf16_t*)a.out;
    bf16_t* Y3 = (bf16_t*)(ws + OFF_ATT);
    if (IN(2)) { pg8::Gemm g{HFF, (const bf16_t*)(ws + OFF_WD1), NREAL, 1024, FF}; pg8::StaticOrder S; S.init(NREAL, 1024, G, (int)blockIdx.x);
        EpiY E{Y12, 0.5f}; pg8::gemm_phase<EpiY, pg8::StaticOrder, true, true>(lds, g, S, E);
        skinny_meta<1>(HFF + (size_t)NREAL * FF, FF, (const bf16_t*)(ws + OFF_WD1), FF, 64, gw, NGW, lane, Y12, nullptr, nullptr, nullptr, nullptr, nullptr, nullptr, nullptr); }
    SEAM(2);
    if (IN(3)) { lnres_phase<0>(a.x, a.meta, Y12, a.ln1g, a.ln1b, AB, nullptr, NREAL + NMETA, gw, NGW, lane); }
    SEAM(3);
    if (IN(4)) { pg8::Gemm g{AB, (const bf16_t*)(ws + OFF_WIN), NREAL, 3072, 1024}; pg8::StaticOrder S; S.init(NREAL, 3072, G, (int)blockIdx.x);
        skinny_meta<2>(AB + (size_t)NREAL * DM, DM, (const bf16_t*)(ws + OFF_WIN), 1024, 42, gw, NGW, lane, (bf16_t*)(ws + OFF_K8), nullptr, nullptr, (bf16_t*)(ws + OFF_V8), (bf16_t*)(ws + OFF_KI8), (bf16_t*)(ws + OFF_CU), (const float*)(ws + OFF_COS), (const float*)(ws + OFF_SIN));
        EpiProj E{(bf16_t*)(ws + OFF_QS), (bf16_t*)(ws + OFF_QI), (bf16_t*)(ws + OFF_KV), (bf16_t*)(ws + OFF_KI), (bf16_t*)(ws + OFF_CU), (bf16_t*)(ws + OFF_GB), (float*)(ws + OFF_WI), (const float*)(ws + OFF_COS), (const float*)(ws + OFF_SIN), (unsigned char*)(ws + OFF_K8), (unsigned char*)(ws + OFF_QI8), (unsigned char*)(ws + OFF_KI8), (unsigned char*)(ws + OFF_V8)};
        pg8::gemm_phase<EpiProj, pg8::StaticOrder, true, true>(lds, g, S, E); }
    SEAM(4);
    if (IN(5)) {
        conv_phase((const bf16_t*)(ws + OFF_CU), (const bf16_t*)(ws + OFF_GB), a.convw, (bf16_t*)(ws + OFF_YCV), blockIdx.x * 512 + tid, G * 512);
#ifdef DBG_SKIP_ATTN
        for (int it = blockIdx.x * 512 + tid; it < NREAL * 64; it += G * 512) *(u32x4*)((bf16_t*)(ws + OFF_ATT) + (size_t)it * 8) = (u32x4){0u, 0u, 0u, 0u};
#else
        attn_phase((const bf16_t*)(ws + OFF_QS), (const bf16_t*)(ws + OFF_QI8), (const bf16_t*)(ws + OFF_V8), (const bf16_t*)(ws + OFF_KI8), (const float*)(ws + OFF_WI), (bf16_t*)(ws + OFF_ATT), (const unsigned char*)(ws + OFF_K8), lds, wave, lane);
#ifdef PROBE_ATTN2
        attn_phase((const bf16_t*)(ws + OFF_QS), (const bf16_t*)(ws + OFF_QI8), (const bf16_t*)(ws + OFF_V8), (const bf16_t*)(ws + OFF_KI8), (const float*)(ws + OFF_WI), (bf16_t*)(ws + OFF_ATT), (const unsigned char*)(ws + OFF_K8), lds, wave, lane);
#endif
#endif
    }
    SEAM(5);
    if (IN(6)) {
        bf16_t* S1 = (bf16_t*)(ws + OFF_S1); bf16_t* S2 = (bf16_t*)(ws + OFF_S2);
#ifdef DBG_E1_M
        pg8::StaticOrder S; S.init(DBG_E1_M, 1024, G, (int)blockIdx.x);
        { pg8::Gemm g{AB, (const bf16_t*)(ws + OFF_WGA), DBG_E1_M, 1024, 1024};
#else
        pg8::StaticOrder S; S.init(NREAL, 1024, G, (int)blockIdx.x);
        { pg8::Gemm g{AB, (const bf16_t*)(ws + OFF_WGA), NREAL, 1024, 1024};
#endif
 EpiGate<0> E{S1, nullptr}; pg8::gemm_phase<EpiGate<0>, pg8::StaticOrder, true, true>(lds, g, S, E); }
#ifndef DBG_NO_E3
        { pg8::Gemm g{AB, (const bf16_t*)(ws + OFF_WGC), NREAL, 1024, 1024}; EpiGate<0> E{S2, nullptr}; pg8::gemm_phase<EpiGate<0>, pg8::StaticOrder, true, true>(lds, g, S, E); }
#endif
    }
    if (IN(6)) {
        bf16_t* S1 = (bf16_t*)(ws + OFF_S1);
        pg8::StaticOrder S; S.init(NREAL, 1024, G, (int)blockIdx.x);
        pg8::Gemm g{(const bf16_t*)(ws + OFF_ATT), (const bf16_t*)(ws + OFF_WAO), NREAL, 1024, 512}; EpiGate<1> E{S1, nullptr}; pg8::gemm_phase<EpiGate<1>, pg8::StaticOrder, true, true>(lds, g, S, E);
    }
    if (IN(6)) {
        bf16_t* S1 = (bf16_t*)(ws + OFF_S1); bf16_t* S2 = (bf16_t*)(ws + OFF_S2);
        pg8::StaticOrder S; S.init(NREAL, 1024, G, (int)blockIdx.x);
        pg8::Gemm g{(const bf16_t*)(ws + OFF_YCV), (const bf16_t*)(ws + OFF_WCO), NREAL, 1024, 512}; EpiGate<2> E{S1, S2}; pg8::gemm_phase<EpiGate<2>, pg8::StaticOrder, true, true>(lds, g, S, E);
    }
    SEAM(8);
    if (IN(9)) { pg8::Gemm g{(const bf16_t*)(ws + OFF_S1), (const bf16_t*)(ws + OFF_WO), NREAL, 1024, 1024}; pg8::StaticOrder S; S.init(NREAL, 1024, G, (int)blockIdx.x);
        EpiY E{Y12, 1.0f}; pg8::gemm_phase<EpiY, pg8::StaticOrder, true, true>(lds, g, S, E); }
    SEAM(9);
    if (IN(10)) { lnres_phase<1>(nullptr, nullptr, Y12, a.ln2g, a.ln2b, AB, nullptr, NREAL, gw, NGW, lane); }
    SEAM(10);
    if (IN(11)) { pg8::Gemm g{AB, (const bf16_t*)(ws + OFF_WGU2), NREAL, 5632, 1024}; pg8::StaticOrder S; S.init(NREAL, 5632, G, (int)blockIdx.x);
        EpiSwiglu E{HFF}; pg8::gemm_phase<EpiSwiglu, pg8::StaticOrder, true, true>(lds, g, S, E); }
    SEAM(11);
    if (IN(12)) { pg8::Gemm g{HFF, (const bf16_t*)(ws + OFF_WD2), NREAL, 1024, FF}; pg8::StaticOrder S; S.init(NREAL, 1024, G, (int)blockIdx.x);
        EpiY E{Y3, 0.5f}; pg8::gemm_phase<EpiY, pg8::StaticOrder, true, true>(lds, g, S, E); }
    SEAM(12);
    if (IN(13)) { lnres_phase<2>(nullptr, nullptr, Y3, a.ln3g, a.ln3b, AB, a.out, NREAL, gw, NGW, lane); }
#ifdef DBG_STOP
    if (lo == 100) {
        const int gt = blockIdx.x * 512 + tid, NT = G * 512;
        for (int it = gt; it < NREAL * 256; it += NT) {
            const int row = it >> 8, c4 = (it & 255) * 4; f32x4 v;
#ifdef DBG_DUMP_INPUTS
            if (c4 < 512) { const u32x2 w = *(const u32x2*)(AB + (size_t)row * DM + c4); v = (f32x4){bf_lo(w.x), bf_hi(w.x), bf_lo(w.y), bf_hi(w.y)}; }
            else if (row < 2048) { const u32x2 w = *(const u32x2*)((const bf16_t*)(ws + OFF_WGA) + (size_t)row * 512 + (c4 - 512)); v = (f32x4){bf_lo(w.x), bf_hi(w.x), bf_lo(w.y), bf_hi(w.y)}; }
            else v = (f32x4){0.f, 0.f, 0.f, 0.f};
#else
            if (DBG_STOP == 2 || DBG_STOP == 9) v = *(const f32x4*)(Z + (size_t)row * DM + c4);
            else if (DBG_STOP == 3 || DBG_STOP == 10) { const u32x2 w = *(const u32x2*)(AB + (size_t)row * DM + c4); v = (f32x4){bf_lo(w.x), bf_hi(w.x), bf_lo(w.y), bf_hi(w.y)}; }
            else if (DBG_STOP == 1 || DBG_STOP == 11) { const u32x2 w = *(const u32x2*)(HFF + (size_t)row * FF + c4); v = (f32x4){bf_lo(w.x), bf_hi(w.x), bf_lo(w.y), bf_hi(w.y)}; }
            else if (DBG_STOP == 4) { const bf16_t* src = c4 < 512 ? (const bf16_t*)(ws + OFF_QS) + (size_t)row * 512 + c4 : (const bf16_t*)(ws + OFF_CU) + (size_t)row * 512 + (c4 - 512); const u32x2 w = *(const u32x2*)src; v = (f32x4){bf_lo(w.x), bf_hi(w.x), bf_lo(w.y), bf_hi(w.y)}; }
            else if (DBG_STOP == 5) { const bf16_t* src = c4 < 512 ? (const bf16_t*)(ws + OFF_ATT) + (size_t)row * 512 + c4 : (const bf16_t*)(ws + OFF_YCV) + (size_t)row * 512 + (c4 - 512); const u32x2 w = *(const u32x2*)src; v = (f32x4){bf_lo(w.x), bf_hi(w.x), bf_lo(w.y), bf_hi(w.y)}; }
            else { const u32x2 w = *(const u32x2*)((const bf16_t*)(ws + OFF_S1) + (size_t)row * DM + c4); v = (f32x4){bf_lo(w.x), bf_hi(w.x), bf_lo(w.y), bf_hi(w.y)}; }
#endif
            *(f32x4*)(a.out + (size_t)row * DM + c4) = v;
        }
    }
#endif
#undef IN
#undef SEAM
}

extern "C" void kernel_launch(void* const* d_in, const int* in_sizes, int n_in, void* d_out, int out_size, void* d_ws, size_t ws_size, hipStream_t stream) {
    static int grid = 0;
    if (grid == 0) {
        if (n_in != 19 || in_sizes[0] != NREAL * DM || out_size != NREAL * DM || ws_size < WS_END) {
            fprintf(stderr, "kernel_launch: unexpected shapes (n_in %d, in0 %d, out %d, ws %zu, need %zu); nothing launched\n", n_in, n_in > 0 ? in_sizes[0] : -1, out_size, ws_size, (size_t)WS_END);
            grid = -1; return; }
        int dev = 0, cus = 0, per_cu = 0;
        (void)hipGetDevice(&dev); (void)hipDeviceGetAttribute(&cus, hipDeviceAttributeMultiprocessorCount, dev);
        (void)hipFuncSetAttribute((const void*)mk_fwd, hipFuncAttributeMaxDynamicSharedMemorySize, LDS_BYTES);
        (void)hipOccupancyMaxActiveBlocksPerMultiprocessor(&per_cu, (const void*)mk_fwd, NWAVES * 64, LDS_BYTES);
        if (per_cu < 1) { fprintf(stderr, "kernel_launch: occupancy query says %d blocks per CU\n", per_cu); per_cu = 1; }
        (void)hipGetLastError();
        grid = cus;
    }
    if (grid < 0) return;
    Args a{};
    a.x = (const float*)d_in[0]; a.meta = (const float*)d_in[1];
    a.f1g = (const float*)d_in[2]; a.f1u = (const float*)d_in[3]; a.f1d = (const float*)d_in[4]; a.ln1g = (const float*)d_in[5]; a.ln1b = (const float*)d_in[6];
    a.win = (const float*)d_in[7]; a.convw = (const float*)d_in[8]; a.wao = (const float*)d_in[9]; a.wco = (const float*)d_in[10]; a.wo = (const float*)d_in[11];
    a.ln2g = (const float*)d_in[12]; a.ln2b = (const float*)d_in[13]; a.f2g = (const float*)d_in[14]; a.f2u = (const float*)d_in[15]; a.f2d = (const float*)d_in[16];
    a.ln3g = (const float*)d_in[17]; a.ln3b = (const float*)d_in[18];
    a.out = (float*)d_out; a.ws = (unsigned char*)d_ws;
    (void)hipMemsetAsync((char*)d_ws + OFF_CTL, 0, SZ_CTL, stream);
#if ONE_LAUNCH
    a.ph_lo = 0; a.ph_hi = NPH;
    void* kargs[] = {&a};
    hipError_t e = hipLaunchCooperativeKernel((const void*)mk_fwd, dim3(grid), dim3(NWAVES * 64), kargs, LDS_BYTES, stream);
    if (e != hipSuccess) fprintf(stderr, "cooperative launch failed: %s (grid %d)\n", hipGetErrorString(e), grid);
#else
#ifdef DBG_STOP
    for (int ph = 0; ph <= DBG_STOP; ++ph) {
        a.ph_lo = ph; a.ph_hi = ph + 1;
        hipLaunchKernelGGL(mk_fwd, dim3(grid), dim3(NWAVES * 64), LDS_BYTES, stream, a);
    }
    a.ph_lo = 100; a.ph_hi = 101;
    hipLaunchKernelGGL(mk_fwd, dim3(grid), dim3(NWAVES * 64), LDS_BYTES, stream, a);
#else
    for (int ph = 0; ph < NPH; ++ph) {
        a.ph_lo = ph; a.ph_hi = ph + 1;
        hipLaunchKernelGGL(mk_fwd, dim3(grid), dim3(NWAVES * 64), LDS_BYTES, stream, a);
    }
#endif
#endif
}
```

```cpp
#define ONE_LAUNCH 1
#include <hip/hip_runtime.h>
#include <hip/hip_cooperative_groups.h>
#include <cstdio>
#include <cstdint>
#include <cmath>
namespace pg8 {
#define PG8_LAS __attribute__((address_space(3)))
typedef unsigned short bf16_t;
typedef short bf16x8 __attribute__((ext_vector_type(8)));
typedef float f32x4 __attribute__((ext_vector_type(4)));
typedef unsigned u32x4 __attribute__((ext_vector_type(4)));
constexpr int BM = 256, BK = 64, HALF = 128, HTB = HALF * BK * 2  , STAGE_BYTES = 8 * HTB, NXCD = 8, WGM = 8;

__host__ __device__ __forceinline__ int lds_byte(int r, int c) { const int st = (r >> 4) * 2 + (c >> 5), rr = r & 15, cc = c & 31, ob = rr * 64 + cc * 2; return st * 1024 + (ob ^ (((ob >> 9) & 1) << 5)); }
__host__ __device__ __forceinline__ void stage_rc(int b, int& R, int& C) { const int st = b / 1024, sb = b % 1024, swz = sb ^ (((sb >> 9) & 1) << 5); R = (st >> 1) * 16 + swz / 64; C = (st & 1) * 32 + (swz % 64) / 2; }
__host__ __device__ __forceinline__ int perm32(int rho) { const int n = rho >> 4, i = rho & 15; return 8 * (i >> 2) + 4 * n + (i & 3); }

struct Unit { int pm, pn; };
struct Gemm { const bf16_t* A; const bf16_t* Bt; int M, N, K; };

struct StaticOrder {
    int nM, nN, nwg, G, c;
    __host__ __device__ void init(int M, int N, int G_, int c_) { nM = M / BM; nN = N / BM; nwg = nM * nN; G = G_; c = c_; }
    __host__ __device__ bool next(int i, Unit& u) const {
        const long L = (long)i * G + c; if (L >= nwg) return false;
        int wgid = (int)L; { const int q = nwg / NXCD, r = nwg % NXCD, xcd = wgid % NXCD, off = wgid / NXCD; wgid = (xcd < r ? xcd * (q + 1) : r * (q + 1) + (xcd - r) * q) + off; }
        const int nig = WGM * nN, gid = wgid / nig, fm = gid * WGM, gsz = (nM - fm) < WGM ? (nM - fm) : WGM;
        u.pm = fm + ((wgid % nig) % gsz); u.pn = (wgid % nig) / gsz; return true;
    }
    __device__ __forceinline__ void a_ready(const Unit&) const {}
    __device__ __forceinline__ void done(const Unit&) const {}
};

__device__ __forceinline__ unsigned cvt_pk_bf16(float lo, float hi) { unsigned r; asm volatile("v_cvt_pk_bf16_f32 %0, %1, %2" : "=v"(r) : "v"(lo), "v"(hi)); return r; }
template <class Epi, class Sched, bool ALIGN_EPI = false, bool SP2 = false>
__device__ __forceinline__ void gemm_phase(PG8_LAS unsigned char* lds, const Gemm g, const Sched& S, const Epi& E) {
    const int tid = threadIdx.x, wid = __builtin_amdgcn_readfirstlane(tid >> 6), lane = tid & 63, wr = wid >> 2, wc = wid & 3, fr = lane & 15, fq = lane >> 4;
    const int K = g.K, nt = K / BK;
    unsigned voffA[2], voffB[2];
#pragma unroll
    for (int i = 0; i < 2; ++i) { int R, C; stage_rc(tid * 16 + i * 8192, R, C); const int Rb = Epi::PERM ? ((R & ~31) + perm32(R & 31)) : R;
        voffA[i] = (unsigned)(R * K + C) * 2u; voffB[i] = (unsigned)(Rb * K + C) * 2u; }
    const size_t kstep = (size_t)(BK * 2);
    const size_t hstep = (size_t)HALF * K * 2;
    const size_t tstep = 2 * hstep;
    const unsigned ldsw = (unsigned)wid * 1024u;
    const int aoff = lds_byte(wr * 64 + fr, fq * 8), boff = lds_byte(wc * 32 + fr, fq * 8);
#define PG8_SA(b, h) (((b) * 2 + (h)) * HTB)
#define PG8_SB(b, h) ((4 + (b) * 2 + (h)) * HTB)
#define PG8_STAGE(bufoff, gbase, voff) do { _Pragma("unroll") for (int _i = 0; _i < 2; ++_i) \
        __builtin_amdgcn_global_load_lds((const unsigned*)((const char*)(gbase) + (voff)[_i]), (PG8_LAS unsigned*)(lds + (bufoff) + ldsw + _i * 8192), 16, 0, 0); } while (0)
#define PG8_LDA(dst, b, h) do { _Pragma("unroll") for (int m = 0; m < 4; ++m) _Pragma("unroll") for (int k = 0; k < 2; ++k) dst[m][k] = *(const PG8_LAS bf16x8*)(lds + PG8_SA(b, h) + aoff + m * 2048 + k * 1024); } while (0)
#define PG8_LDB(dst, b, h) do { _Pragma("unroll") for (int n = 0; n < 2; ++n) _Pragma("unroll") for (int k = 0; k < 2; ++k) dst[n][k] = *(const PG8_LAS bf16x8*)(lds + PG8_SB(b, h) + boff + n * 2048 + k * 1024); } while (0)
#define PG8_MMA(ai, bj, At, Bt) do { __builtin_amdgcn_s_setprio(1); _Pragma("unroll") for (int m = 0; m < 4; ++m) _Pragma("unroll") for (int n = 0; n < 2; ++n) _Pragma("unroll") for (int k = 0; k < 2; ++k) \
        acc[ai][bj][m][n] = __builtin_amdgcn_mfma_f32_16x16x32_bf16(Bt[n][k], At[m][k], acc[ai][bj][m][n], 0, 0, 0); __builtin_amdgcn_s_setprio(0); } while (0)
#define PG8_WAIT_V(n) asm volatile("s_waitcnt vmcnt(" #n ")" ::: "memory")
#define PG8_WAIT_L(n) asm volatile("s_waitcnt lgkmcnt(" #n ")" ::: "memory")
#define PG8_BAR __builtin_amdgcn_s_barrier()
#define PG8_SCHED __builtin_amdgcn_sched_barrier(0)
    Unit cur, nxt; int ui = 0;
    if (!S.next(0, cur)) return;
    f32x4 acc[2][2][4][2];
#pragma unroll
    for (int a = 0; a < 2; ++a)
#pragma unroll
        for (int b = 0; b < 2; ++b)
#pragma unroll
            for (int m = 0; m < 4; ++m)
#pragma unroll
                for (int n = 0; n < 2; ++n) acc[a][b][m][n] = (f32x4){0.f, 0.f, 0.f, 0.f};
    bf16x8 At[4][2], B0[2][2], B1[2][2];
    const char* cA = (const char*)g.A + (size_t)cur.pm * tstep; const char* cB = (const char*)g.Bt + (size_t)cur.pn * tstep;
    S.a_ready(cur);
    if constexpr (SP2) {
        PG8_STAGE(PG8_SB(0, 0), cB, voffB); PG8_STAGE(PG8_SB(0, 1), cB + hstep, voffB); PG8_STAGE(PG8_SA(0, 0), cA, voffA); PG8_STAGE(PG8_SA(0, 1), cA + hstep, voffA);
        if (wr == 1) PG8_BAR;
        PG8_WAIT_V(2); PG8_BAR;
        PG8_STAGE(PG8_SB(1, 0), cB + kstep, voffB); PG8_STAGE(PG8_SA(1, 0), cA + kstep, voffA); PG8_STAGE(PG8_SB(1, 1), cB + hstep + kstep, voffB);
        PG8_WAIT_V(6); PG8_BAR;
    } else {
        PG8_STAGE(PG8_SB(0, 0), cB, voffB); PG8_STAGE(PG8_SA(0, 0), cA, voffA); PG8_STAGE(PG8_SB(0, 1), cB + hstep, voffB); PG8_STAGE(PG8_SA(0, 1), cA + hstep, voffA);
        if (wr == 1) PG8_BAR;
        PG8_WAIT_V(4); PG8_BAR;
        PG8_STAGE(PG8_SB(1, 0), cB + kstep, voffB); PG8_STAGE(PG8_SA(1, 0), cA + kstep, voffA); PG8_STAGE(PG8_SB(1, 1), cB + hstep + kstep, voffB);
        PG8_WAIT_V(6); PG8_BAR;
    }
    for (;;) {
        const bool has_next = S.next(ui + 1, nxt);
        const char* nA = has_next ? (const char*)g.A + (size_t)nxt.pm * tstep : cA; const char* nB = has_next ? (const char*)g.Bt + (size_t)nxt.pn * tstep : cB;
        for (int t = 0; t < nt; t += 2) {
            const bool last = (t == nt - 2);
            const char* a1 = cA + (size_t)(t + 1) * kstep;
            const char* a2 = last ? nA : cA + (size_t)(t + 2) * kstep; const char* b2 = last ? nB : cB + (size_t)(t + 2) * kstep;
            const char* a3 = a2 + kstep; const char* b3 = b2 + kstep;
            if (last && has_next) S.a_ready(nxt);
            if constexpr (SP2) {
            PG8_LDB(B0, 0, 0); PG8_LDB(B1, 0, 1); PG8_SCHED; PG8_LDA(At, 0, 0); PG8_STAGE(PG8_SA(1, 1), a1 + hstep, voffA);
            PG8_WAIT_V(8); PG8_WAIT_L(0); PG8_BAR; PG8_MMA(0, 0, At, B0); PG8_MMA(0, 1, At, B1); PG8_BAR; PG8_SCHED;
            PG8_LDA(At, 0, 1); PG8_STAGE(PG8_SB(0, 0), b2, voffB); PG8_STAGE(PG8_SB(0, 1), b2 + hstep, voffB); PG8_STAGE(PG8_SA(0, 0), a2, voffA);
            PG8_WAIT_V(8); PG8_WAIT_L(0); PG8_BAR; PG8_MMA(1, 0, At, B0); PG8_MMA(1, 1, At, B1); PG8_BAR; PG8_SCHED;
            PG8_LDB(B0, 1, 0); PG8_LDB(B1, 1, 1); PG8_SCHED; PG8_LDA(At, 1, 0); PG8_STAGE(PG8_SA(0, 1), a2 + hstep, voffA);
            PG8_WAIT_V(8); PG8_WAIT_L(0); PG8_BAR; PG8_MMA(0, 0, At, B0); PG8_MMA(0, 1, At, B1); PG8_BAR; PG8_SCHED;
            PG8_LDA(At, 1, 1); PG8_STAGE(PG8_SB(1, 0), b3, voffB); PG8_STAGE(PG8_SB(1, 1), b3 + hstep, voffB); PG8_STAGE(PG8_SA(1, 0), a3, voffA);
            PG8_WAIT_V(8); PG8_WAIT_L(0); PG8_BAR; PG8_MMA(1, 0, At, B0); PG8_MMA(1, 1, At, B1); PG8_BAR; PG8_SCHED;
            } else {
            PG8_LDB(B0, 0, 0); PG8_SCHED; PG8_LDA(At, 0, 0); PG8_STAGE(PG8_SA(1, 1), a1 + hstep, voffA);
            PG8_WAIT_L(8); PG8_BAR; PG8_WAIT_L(0); PG8_MMA(0, 0, At, B0); PG8_BAR; PG8_SCHED;
            PG8_LDB(B1, 0, 1); PG8_STAGE(PG8_SB(0, 0), b2, voffB);
            PG8_BAR; PG8_WAIT_L(0); PG8_MMA(0, 1, At, B1); PG8_BAR;
            PG8_LDA(At, 0, 1); PG8_STAGE(PG8_SA(0, 0), a2, voffA);
            PG8_BAR; PG8_WAIT_L(0); PG8_MMA(1, 0, At, B0); PG8_BAR; PG8_SCHED;
            PG8_STAGE(PG8_SB(0, 1), b2 + hstep, voffB);
            PG8_WAIT_V(6); PG8_BAR; PG8_MMA(1, 1, At, B1); PG8_BAR;
            PG8_LDB(B0, 1, 0); PG8_SCHED; PG8_LDA(At, 1, 0); PG8_STAGE(PG8_SA(0, 1), a2 + hstep, voffA);
            PG8_WAIT_L(8); PG8_BAR; PG8_WAIT_L(0); PG8_MMA(0, 0, At, B0); PG8_BAR; PG8_SCHED;
            PG8_LDB(B1, 1, 1); PG8_STAGE(PG8_SB(1, 0), b3, voffB);
            PG8_BAR; PG8_WAIT_L(0); PG8_MMA(0, 1, At, B1); PG8_BAR;
            PG8_LDA(At, 1, 1); PG8_STAGE(PG8_SA(1, 0), a3, voffA);
            PG8_BAR; PG8_WAIT_L(0); PG8_MMA(1, 0, At, B0); PG8_BAR; PG8_SCHED;
            PG8_STAGE(PG8_SB(1, 1), b3 + hstep, voffB);
            PG8_WAIT_V(6); PG8_BAR; PG8_MMA(1, 1, At, B1); PG8_BAR;
            }
        }
        if constexpr (ALIGN_EPI) { if (wr == 0) PG8_BAR; }
        if constexpr (!Epi::AFTER_DRAIN) { E(acc, cur, wr, wc, fr, fq); S.done(cur); }
        if (!has_next) break;
#pragma unroll
        for (int a = 0; a < 2; ++a)
#pragma unroll
            for (int b = 0; b < 2; ++b)
#pragma unroll
                for (int m = 0; m < 4; ++m)
#pragma unroll
                    for (int n = 0; n < 2; ++n) acc[a][b][m][n] = (f32x4){0.f, 0.f, 0.f, 0.f};
        cur = nxt; cA = nA; cB = nB; ++ui;
        if constexpr (ALIGN_EPI) { if (wr == 1) PG8_BAR; }
    }
    PG8_WAIT_V(0);
    if constexpr (!ALIGN_EPI) { if (wr == 0) PG8_BAR; }
    PG8_BAR;
    if constexpr (Epi::AFTER_DRAIN) { E.fused(acc, cur, wr, wc, fr, fq, lds, wid, lane); S.done(cur); }
#undef PG8_SA
#undef PG8_SB
#undef PG8_STAGE
#undef PG8_LDA
#undef PG8_LDB
#undef PG8_MMA
#undef PG8_WAIT_V
#undef PG8_WAIT_L
#undef PG8_BAR
#undef PG8_SCHED
}
}

#define LAS __attribute__((address_space(3)))
typedef unsigned short bf16_t;
typedef short bf16x8 __attribute__((ext_vector_type(8)));
typedef short s16x4 __attribute__((ext_vector_type(4)));
typedef float f32x4 __attribute__((ext_vector_type(4)));
typedef float f32x16 __attribute__((ext_vector_type(16)));
typedef unsigned u32x4 __attribute__((ext_vector_type(4)));
typedef unsigned u32x2 __attribute__((ext_vector_type(2)));

constexpr int NB = 8, SEQ = 8192, NMETA = 16, DM = 1024, FF = 2816;
constexpr int NREAL = NB * SEQ;
constexpr int MROWS = NREAL + 256;
constexpr float ALPHA = 1.189207115002721f;
constexpr float LN_EPS = 1e-5f;
constexpr int NWAVES = 8;
constexpr int LDS_BYTES = 147456 + 16384;
constexpr int LDS_BST = 7 * 18432 + 16512;
constexpr int CAND_CAP = 1024;
constexpr int WREG = 18432;
constexpr int NPH = 14;
#ifndef ONE_LAUNCH
#define ONE_LAUNCH 1
#endif

constexpr size_t SZ_ROPE = (size_t)8208 * 32 * 4;
constexpr size_t OFF_CTL = 0, SZ_CTL = 16384;
constexpr size_t OFF_COS = SZ_CTL, OFF_SIN = OFF_COS + SZ_ROPE;
constexpr size_t OFF_ST1 = OFF_SIN + SZ_ROPE, SZ_ST = (size_t)MROWS * 8;
constexpr size_t OFF_ST2 = OFF_ST1 + SZ_ST;
constexpr size_t OFF_WGU1 = OFF_ST2 + SZ_ST, SZ_WGU = (size_t)5632 * 1024 * 2;
constexpr size_t OFF_WD1 = OFF_WGU1 + SZ_WGU, SZ_WD = (size_t)1024 * 2816 * 2;
constexpr size_t OFF_WGU2 = OFF_WD1 + SZ_WD;
constexpr size_t OFF_WD2 = OFF_WGU2 + SZ_WGU;
constexpr size_t OFF_WIN = OFF_WD2 + SZ_WD, SZ_WIN = (size_t)3072 * 1024 * 2;
constexpr size_t OFF_WGA = OFF_WIN + SZ_WIN, SZ_W1K = (size_t)1024 * 1024 * 2;
constexpr size_t OFF_WGC = OFF_WGA + SZ_W1K;
constexpr size_t OFF_WO = OFF_WGC + SZ_W1K;
constexpr size_t OFF_WAO = OFF_WO + SZ_W1K, SZ_W512 = (size_t)1024 * 512 * 2;
constexpr size_t OFF_WCO = OFF_WAO + SZ_W512;
constexpr size_t OFF_AB = OFF_WCO + SZ_W512, SZ_AB = (size_t)MROWS * 1024 * 2;
constexpr size_t OFF_Z = OFF_AB + SZ_AB, SZ_Z = (size_t)MROWS * 1024 * 4;
constexpr size_t OFF_BIG = OFF_Z + SZ_Z, SZ_BIG = (size_t)MROWS * 2816 * 2;
constexpr size_t OFF_QS = OFF_BIG, SZ_R512 = (size_t)MROWS * 512 * 2;
constexpr size_t OFF_QI = OFF_QS + SZ_R512;
constexpr size_t OFF_KV = OFF_QI + SZ_R512;
constexpr size_t OFF_KI = OFF_KV + (size_t)MROWS * 256 * 2;
constexpr size_t OFF_WI = OFF_KI + (size_t)MROWS * 64 * 2;
constexpr size_t OFF_CU = OFF_WI + (size_t)MROWS * 8 * 4;
constexpr size_t OFF_GB = OFF_CU + SZ_R512;
constexpr size_t OFF_K8 = OFF_GB + SZ_R512;
constexpr size_t OFF_QI8 = OFF_K8 + (size_t)MROWS * 128;
constexpr size_t OFF_KI8 = OFF_QI8 + (size_t)MROWS * 512;
constexpr size_t OFF_V8 = OFF_KI8 + (size_t)MROWS * 64;
static_assert(OFF_V8 + (size_t)MROWS * 128 <= OFF_BIG + SZ_BIG, "mixer tensors overlay the FFN hidden buffer");
constexpr size_t OFF_S1 = OFF_BIG, OFF_S2 = OFF_BIG + (size_t)NREAL * 1024 * 2;
static_assert(OFF_S2 + (size_t)NREAL * 1024 * 2 <= OFF_BIG + SZ_BIG, "gate buffers overlay");
constexpr size_t OFF_ATT = OFF_BIG + SZ_BIG, SZ_ATT = (size_t)NREAL * 512 * 2;
constexpr size_t OFF_YCV = OFF_ATT + SZ_ATT;
constexpr size_t WS_END = OFF_YCV + SZ_ATT;

struct Args {
    const float* x; const float* meta;
    const float* f1g; const float* f1u; const float* f1d; const float* ln1g; const float* ln1b;
    const float* win; const float* convw; const float* wao; const float* wco; const float* wo;
    const float* ln2g; const float* ln2b; const float* f2g; const float* f2u; const float* f2d; const float* ln3g; const float* ln3b;
    float* out; unsigned char* ws; int ph_lo, ph_hi;
};

__device__ __forceinline__ unsigned f2bf(float f) { unsigned u = __builtin_bit_cast(unsigned, f); return (u + 0x7fffu + ((u >> 16) & 1u)) >> 16; }
typedef float f32x2_t __attribute__((ext_vector_type(2))); typedef __bf16 bf16x2_t __attribute__((ext_vector_type(2)));
__device__ __forceinline__ unsigned pk2(float lo, float hi) { f32x2_t v = {lo, hi}; bf16x2_t b = __builtin_convertvector(v, bf16x2_t); return __builtin_bit_cast(unsigned, b); }
__device__ __forceinline__ float bf_lo(unsigned w) { return __builtin_bit_cast(float, w << 16); }
__device__ __forceinline__ float bf_hi(unsigned w) { return __builtin_bit_cast(float, w & 0xffff0000u); }
__device__ __forceinline__ unsigned pk4_fp8(float a, float b_, float c, float d) { int w = __builtin_amdgcn_cvt_pk_fp8_f32(a, b_, 0, false); w = __builtin_amdgcn_cvt_pk_fp8_f32(c, d, w, true); return (unsigned)w; }
#define LDS_WAIT() asm volatile("s_waitcnt lgkmcnt(0)" ::: "memory")
__device__ __forceinline__ float wave_sum(float v) {
#pragma unroll
    for (int o = 1; o < 64; o <<= 1) v += __shfl_xor(v, o);
    return v;
}

struct EpiSwiglu {
    static constexpr bool PERM = true, AFTER_DRAIN = false;
    bf16_t* H;
    __device__ __forceinline__ void operator()(const f32x4 (&acc)[2][2][4][2], const pg8::Unit& u, int wr, int wc, int fr, int fq) const {
        const int row0 = u.pm * 256 + wr * 64 + fr, col0 = u.pn * 128 + wc * 32 + 8 * fq;
#pragma unroll
        for (int ai = 0; ai < 2; ++ai)
#pragma unroll
            for (int m = 0; m < 4; ++m) {
                bf16_t* rowp = H + (size_t)(row0 + ai * 128 + m * 16) * FF + col0;
                float h[8];
#pragma unroll
                for (int n = 0; n < 2; ++n)
#pragma unroll
                    for (int i = 0; i < 4; ++i) {
                        const float g = acc[ai][0][m][n][i], up = acc[ai][1][m][n][i];
                        const float e = __builtin_amdgcn_exp2f(-g * 1.4426950408889634f);
                        h[4 * n + i] = g * __builtin_amdgcn_rcpf(1.0f + e) * up;
                    }
                u32x4 w; w.x = pk2(h[0], h[1]); w.y = pk2(h[2], h[3]); w.z = pk2(h[4], h[5]); w.w = pk2(h[6], h[7]);
                *(u32x4*)rowp = w;
            }
    }
};

template <int MODE> struct EpiResid {
    static constexpr bool PERM = false, AFTER_DRAIN = false;
    const float* x; const float* meta; const float* zin; const float* stats; const float* g; const float* bta; float* zout; float scale;
    __device__ __forceinline__ void operator()(const f32x4 (&acc)[2][2][4][2], const pg8::Unit& u, int wr, int wc, int fr, int fq) const {
        const int col0 = u.pn * 256 + wc * 32 + 4 * fq;
#pragma unroll
        for (int ai = 0; ai < 2; ++ai)
#pragma unroll
            for (int m = 0; m < 4; ++m) {
                const int row = u.pm * 256 + ai * 128 + wr * 64 + m * 16 + fr;
                const float* src; float mean = 0.f, rstd = 1.f; bool have = true;
                if (MODE == 0) { src = row < NREAL ? x + (size_t)row * DM : meta + (size_t)((row - NREAL) & 15) * DM; have = row < NREAL + NMETA; }
                else { src = zin + (size_t)row * DM; mean = stats[2 * row]; rstd = stats[2 * row + 1]; }
#pragma unroll
                for (int bj = 0; bj < 2; ++bj)
#pragma unroll
                    for (int n = 0; n < 2; ++n) {
                        const int c = col0 + bj * 128 + n * 16;
                        f32x4 hv = *(const f32x4*)(src + c);
                        if (MODE == 0) { if (!have) hv = (f32x4){0.f, 0.f, 0.f, 0.f}; }
                        else { const f32x4 gv = *(const f32x4*)(g + c), bv = *(const f32x4*)(bta + c); hv = (hv - mean) * rstd * gv + bv; }
                        const f32x4 o = hv * ALPHA + acc[ai][bj][m][n] * scale;
                        *(f32x4*)(zout + (size_t)row * DM + c) = o;
                    }
                asm volatile("" ::: "memory");
            }
    }
};

template <int MODE> struct EpiGate {
    static constexpr bool PERM = true, AFTER_DRAIN = false;
    bf16_t* P; const bf16_t* Q;
    __device__ __forceinline__ void operator()(const f32x4 (&acc)[2][2][4][2], const pg8::Unit& u, int wr, int wc, int fr, int fq) const {
        const int col0 = u.pn * 256 + wc * 32 + 8 * fq;
#pragma unroll
        for (int ai = 0; ai < 2; ++ai)
#pragma unroll
            for (int m = 0; m < 4; ++m) {
                const int row = u.pm * 256 + ai * 128 + wr * 64 + m * 16 + fr;
#pragma unroll
                for (int bj = 0; bj < 2; ++bj) {
                    const size_t off = (size_t)row * DM + col0 + bj * 128;
                    float v[8];
#pragma unroll
                    for (int n = 0; n < 2; ++n)
#pragma unroll
                        for (int i = 0; i < 4; ++i) v[4 * n + i] = acc[ai][bj][m][n][i];
                    if (MODE == 0) {
#pragma unroll
                        for (int i = 0; i < 8; ++i) v[i] = __builtin_amdgcn_rcpf(1.0f + __builtin_amdgcn_exp2f(-v[i] * 1.4426950408889634f));
                    } else {
                        const u32x4 pw = *(const u32x4*)(P + off);
                        float p[8] = {bf_lo(pw.x), bf_hi(pw.x), bf_lo(pw.y), bf_hi(pw.y), bf_lo(pw.z), bf_hi(pw.z), bf_lo(pw.w), bf_hi(pw.w)};
                        if (MODE == 1) {
#pragma unroll
                            for (int i = 0; i < 8; ++i) v[i] = p[i] * v[i];
                        } else {
                            const u32x4 qw = *(const u32x4*)(Q + off);
                            float q[8] = {bf_lo(qw.x), bf_hi(qw.x), bf_lo(qw.y), bf_hi(qw.y), bf_lo(qw.z), bf_hi(qw.z), bf_lo(qw.w), bf_hi(qw.w)};
#pragma unroll
                            for (int i = 0; i < 8; ++i) v[i] = p[i] + q[i] * v[i];
                        }
                    }
                    u32x4 w; w.x = pk2(v[0], v[1]); w.y = pk2(v[2], v[3]); w.z = pk2(v[4], v[5]); w.w = pk2(v[6], v[7]);
                    *(u32x4*)(P + off) = w;
                }
                asm volatile("" ::: "memory");
            }
    }
};

struct EpiY {
    static constexpr bool PERM = true, AFTER_DRAIN = false;
    bf16_t* Y; float scale;
    __device__ __forceinline__ void operator()(const f32x4 (&acc)[2][2][4][2], const pg8::Unit& u, int wr, int wc, int fr, int fq) const {
        const int col0 = u.pn * 256 + wc * 32 + 8 * fq;
#pragma unroll
        for (int ai = 0; ai < 2; ++ai)
#pragma unroll
            for (int m = 0; m < 4; ++m) {
                const int row = u.pm * 256 + ai * 128 + wr * 64 + m * 16 + fr;
#pragma unroll
                for (int bj = 0; bj < 2; ++bj) {
                    const f32x4 a0 = acc[ai][bj][m][0] * scale, a1 = acc[ai][bj][m][1] * scale;
                    u32x4 w; w.x = pk2(a0[0], a0[1]); w.y = pk2(a0[2], a0[3]); w.z = pk2(a1[0], a1[1]); w.w = pk2(a1[2], a1[3]);
                    *(u32x4*)(Y + (size_t)row * DM + col0 + bj * 128) = w;
                }
            }
    }
};

struct EpiProj {
    static constexpr bool PERM = true, AFTER_DRAIN = false;
    bf16_t *QS, *QI, *KV, *KI, *CU, *GB; float* WI; const float* cosT; const float* sinT; unsigned char* K8; unsigned char* QI8; unsigned char* KI8; unsigned char* V8;
    __device__ __forceinline__ void rope_store_k8(const f32x4 (&acc)[2][2][4][2], int ai, int m, int pos, int fq, unsigned char* dst) const {
        const f32x4 c0 = *(const f32x4*)(cosT + pos * 32 + 8 * fq), c1 = *(const f32x4*)(cosT + pos * 32 + 8 * fq + 4);
        const f32x4 s0 = *(const f32x4*)(sinT + pos * 32 + 8 * fq), s1 = *(const f32x4*)(sinT + pos * 32 + 8 * fq + 4);
        const f32x4 a0 = acc[ai][0][m][0], a1 = acc[ai][0][m][1], b0 = acc[ai][1][m][0], b1 = acc[ai][1][m][1];
        const f32x4 lo0 = a0 * c0 - b0 * s0, lo1 = a1 * c1 - b1 * s1, hi0 = b0 * c0 + a0 * s0, hi1 = b1 * c1 + a1 * s1;
        u32x2 w; w.x = pk4_fp8(lo0[0], lo0[1], lo0[2], lo0[3]); w.y = pk4_fp8(lo1[0], lo1[1], lo1[2], lo1[3]); *(u32x2*)dst = w;
        w.x = pk4_fp8(hi0[0], hi0[1], hi0[2], hi0[3]); w.y = pk4_fp8(hi1[0], hi1[1], hi1[2], hi1[3]); *(u32x2*)(dst + 32) = w;
    }
    __device__ __forceinline__ void rope_store(const f32x4 (&acc)[2][2][4][2], int ai, int m, int pos, int fq, bf16_t* dst, float sc) const {
        const f32x4 c0 = *(const f32x4*)(cosT + pos * 32 + 8 * fq), c1 = *(const f32x4*)(cosT + pos * 32 + 8 * fq + 4);
        const f32x4 s0 = *(const f32x4*)(sinT + pos * 32 + 8 * fq), s1 = *(const f32x4*)(sinT + pos * 32 + 8 * fq + 4);
        const f32x4 a0 = acc[ai][0][m][0] * sc, a1 = acc[ai][0][m][1] * sc, b0 = acc[ai][1][m][0] * sc, b1 = acc[ai][1][m][1] * sc;
        const f32x4 lo0 = a0 * c0 - b0 * s0, lo1 = a1 * c1 - b1 * s1, hi0 = b0 * c0 + a0 * s0, hi1 = b1 * c1 + a1 * s1;
        u32x4 w; w.x = pk2(lo0[0], lo0[1]); w.y = pk2(lo0[2], lo0[3]); w.z = pk2(lo1[0], lo1[1]); w.w = pk2(lo1[2], lo1[3]);
        *(u32x4*)dst = w;
        w.x = pk2(hi0[0], hi0[1]); w.y = pk2(hi0[2], hi0[3]); w.z = pk2(hi1[0], hi1[1]); w.w = pk2(hi1[2], hi1[3]);
        *(u32x4*)(dst + 32) = w;
    }
    __device__ __forceinline__ void operator()(const f32x4 (&acc)[2][2][4][2], const pg8::Unit& u, int wr, int wc, int fr, int fq) const {
        const int pn = u.pn;
#pragma unroll
        for (int ai = 0; ai < 2; ++ai)
#pragma unroll
            for (int m = 0; m < 4; ++m) {
                const int row = u.pm * 256 + ai * 128 + wr * 64 + m * 16 + fr;
                const int pos = row < NREAL ? NMETA + (row & (SEQ - 1)) : (row - NREAL);
                if (pn < 2) {
                    rope_store(acc, ai, m, pos, fq, QS + (size_t)row * 512 + (4 * pn + wc) * 64 + 8 * fq, 0.125f);
                } else if (pn == 2) {
                    if (wc < 2) rope_store_k8(acc, ai, m, pos, fq, K8 + (size_t)row * 128 + wc * 64 + 8 * fq);
                    else {
#pragma unroll
                        for (int bj = 0; bj < 2; ++bj) {
                            const f32x4 a0 = acc[ai][bj][m][0], a1 = acc[ai][bj][m][1];
                            u32x2 w; w.x = pk4_fp8(a0[0], a0[1], a0[2], a0[3]); w.y = pk4_fp8(a1[0], a1[1], a1[2], a1[3]);
                            *(u32x2*)(V8 + (size_t)row * 128 + bj * 64 + (wc - 2) * 32 + 8 * fq) = w;
                        }
                    }
                } else if (pn < 5) {
                    rope_store_k8(acc, ai, m, pos, fq, QI8 + (size_t)row * 512 + (4 * (pn - 3) + wc) * 64 + 8 * fq);
                } else if (pn == 5) {
                    if (wc == 0) rope_store_k8(acc, ai, m, pos, fq, KI8 + (size_t)row * 64 + 8 * fq);
                    else if (wc == 1 && fq == 0) {
                        const float sc = 0.04419417382415922f;
                        *(f32x4*)(WI + (size_t)row * 8) = acc[ai][0][m][0] * sc;
                        *(f32x4*)(WI + (size_t)row * 8 + 4) = acc[ai][0][m][1] * sc;
                    }
                } else if (pn < 10) {
                    const f32x4 a0 = acc[ai][0][m][0] * acc[ai][1][m][0], a1 = acc[ai][0][m][1] * acc[ai][1][m][1];
                    u32x4 w; w.x = pk2(a0[0], a0[1]); w.y = pk2(a0[2], a0[3]); w.z = pk2(a1[0], a1[1]); w.w = pk2(a1[2], a1[3]);
                    *(u32x4*)(CU + (size_t)row * 512 + (pn - 6) * 128 + wc * 32 + 8 * fq) = w;
                } else {
#pragma unroll
                    for (int bj = 0; bj < 2; ++bj) {
                        const f32x4 a0 = acc[ai][bj][m][0], a1 = acc[ai][bj][m][1];
                        u32x4 w; w.x = pk2(a0[0], a0[1]); w.y = pk2(a0[2], a0[3]); w.z = pk2(a1[0], a1[1]); w.w = pk2(a1[2], a1[3]);
                        *(u32x4*)(GB + (size_t)row * 512 + (pn - 10) * 256 + bj * 128 + wc * 32 + 8 * fq) = w;
                    }
                }
                if (m & 1) asm volatile("" ::: "memory");
            }
    }
};

__device__ __forceinline__ void tr_item(const float* W, int N, int n0, int nvalid, int k0, bf16_t* WT, int K, int drow0, LAS float* scr, int lane) {
    const int nn4 = (lane & 7) * 4;
    f32x4 tv[8];
#pragma unroll
    for (int i = 0; i < 8; ++i) { const int kk = 8 * i + (lane >> 3); tv[i] = (f32x4){0.f, 0.f, 0.f, 0.f}; if (nn4 < nvalid) tv[i] = *(const f32x4*)(W + (size_t)(k0 + kk) * N + n0 + nn4); }
#pragma unroll
    for (int i = 0; i < 8; ++i) { const int kk = 8 * i + (lane >> 3);
#pragma unroll
        for (int j = 0; j < 4; ++j) scr[kk * 33 + nn4 + j] = tv[i][j]; }
    LDS_WAIT();
    const int c = lane & 7;
#pragma unroll
    for (int j = 0; j < 4; ++j) { const int n = (lane >> 3) + 8 * j; const LAS float* s = scr + (8 * c) * 33 + n;
        u32x4 o; o.x = pk2(s[0 * 33], s[1 * 33]); o.y = pk2(s[2 * 33], s[3 * 33]); o.z = pk2(s[4 * 33], s[5 * 33]); o.w = pk2(s[6 * 33], s[7 * 33]);
        *(u32x4*)(WT + (size_t)(drow0 + n) * K + k0 + 8 * c) = o; }
    LDS_WAIT();
}
__device__ __forceinline__ void win_group(int G, int& n0, int& nvalid) {
    const int pn = G >> 3, bj = (G >> 2) & 1, xg = G & 3; nvalid = 32;
    if (pn < 2) n0 = (pn * 4 + xg) * 64 + bj * 32;
    else if (pn == 2) { if (xg < 2) n0 = 512 + xg * 64 + bj * 32; else n0 = 640 + bj * 64 + (xg - 2) * 32; }
    else if (pn < 5) n0 = 768 + ((pn - 3) * 4 + xg) * 64 + bj * 32;
    else if (pn == 5) { if (xg == 0) n0 = 1280 + bj * 32; else if (xg == 1 && bj == 0) { n0 = 1344; nvalid = 8; } else { n0 = 0; nvalid = 0; } }
    else if (pn < 10) n0 = (bj ? 2376 : 1352) + (pn - 6) * 128 + 32 * xg;
    else n0 = 1864 + (pn - 10) * 256 + bj * 128 + 32 * xg;
}
__device__ __forceinline__ void p0_prologue(const Args& a, LAS unsigned char* lds, int gw, int NGW, int wave, int lane, int parts) {
    unsigned char* ws = a.ws;
    LAS float* scr = (LAS float*)(lds + wave * 16384);
    constexpr int I_GU = 176 * 16, I_D = 32 * 44, I_IN = 96 * 16, I_1K = 32 * 16, I_512 = 32 * 8;
    constexpr int NITEMS = 2 * I_GU + 2 * I_D + I_IN + 3 * I_1K + 2 * I_512;
    if (parts & 1)
    for (int it = gw; it < NITEMS; it += NGW) {
        int r = it;
        if (r < 2 * I_GU) { const int which = r / I_GU; r -= which * I_GU; const int kb = r / 176, G = r % 176, pn = G >> 3, bj = (G >> 2) & 1, xg = G & 3;
            const float* W = which ? (bj ? a.f2u : a.f2g) : (bj ? a.f1u : a.f1g);
            tr_item(W, FF, 128 * pn + 32 * xg, 32, 64 * kb, (bf16_t*)(ws + (which ? OFF_WGU2 : OFF_WGU1)), 1024, 32 * G, scr, lane); continue; }
        r -= 2 * I_GU;
        if (r < 2 * I_D) { const int which = r / I_D; r -= which * I_D; const int kb = r / 32, G = r % 32;
            tr_item(which ? a.f2d : a.f1d, 1024, 32 * G, 32, 64 * kb, (bf16_t*)(ws + (which ? OFF_WD2 : OFF_WD1)), FF, 32 * G, scr, lane); continue; }
        r -= 2 * I_D;
        if (r < I_IN) { const int kb = r / 96, G = r % 96; int n0, nv; win_group(G, n0, nv);
            tr_item(a.win, 4936, n0, nv, 64 * kb, (bf16_t*)(ws + OFF_WIN), 1024, 32 * G, scr, lane); continue; }
        r -= I_IN;
        if (r < I_1K) { const int kb = r / 32, G = r % 32; tr_item(a.win, 4936, 2888 + 32 * G, 32, 64 * kb, (bf16_t*)(ws + OFF_WGA), 1024, 32 * G, scr, lane); continue; }
        r -= I_1K;
        if (r < I_1K) { const int kb = r / 32, G = r % 32; tr_item(a.win, 4936, 3912 + 32 * G, 32, 64 * kb, (bf16_t*)(ws + OFF_WGC), 1024, 32 * G, scr, lane); continue; }
        r -= I_1K;
        if (r < I_1K) { const int kb = r / 32, G = r % 32; tr_item(a.wo, 1024, 32 * G, 32, 64 * kb, (bf16_t*)(ws + OFF_WO), 1024, 32 * G, scr, lane); continue; }
        r -= I_1K;
        if (r < I_512) { const int kb = r / 32, G = r % 32; tr_item(a.wao, 1024, 32 * G, 32, 64 * kb, (bf16_t*)(ws + OFF_WAO), 512, 32 * G, scr, lane); continue; }
        r -= I_512;
        { const int kb = r / 32, G = r % 32; tr_item(a.wco, 1024, 32 * G, 32, 64 * kb, (bf16_t*)(ws + OFF_WCO), 512, 32 * G, scr, lane); }
    }
    bf16_t* AB = (bf16_t*)(ws + OFF_AB);
    if (parts & 2)
    for (int row0 = gw; row0 < MROWS; row0 += 4 * NGW) {
        f32x4 hv[4][4];
#pragma unroll
        for (int r = 0; r < 4; ++r) { const int row = row0 + r * NGW;
            if (row < MROWS) { const float* src = row < NREAL ? a.x + (size_t)row * DM : a.meta + (size_t)((row - NREAL) & 15) * DM;
#pragma unroll
                for (int j = 0; j < 4; ++j) hv[r][j] = *(const f32x4*)(src + 256 * j + 4 * lane); } }
#pragma unroll
        for (int r = 0; r < 4; ++r) { const int row = row0 + r * NGW;
            if (row < MROWS) { const bool have = row < NREAL + NMETA;
#pragma unroll
                for (int j = 0; j < 4; ++j) { f32x4 v = hv[r][j]; if (!have) v = (f32x4){0.f, 0.f, 0.f, 0.f};
                    u32x2 w; w.x = pk2(v[0], v[1]); w.y = pk2(v[2], v[3]);
                    *(u32x2*)(AB + (size_t)row * DM + 256 * j + 4 * lane) = w; } } }
    }
    float* cosT = (float*)(ws + OFF_COS); float* sinT = (float*)(ws + OFF_SIN);
    if (parts & 4)
    for (int idx = gw * 64 + lane; idx < 8208 * 32; idx += NGW * 64) {
        const int pos = idx >> 5, f = idx & 31;
        double fr = 1.0; for (int i = 0; i < f; ++i) fr *= 0.7498942093324559;
        const float inv = (float)fr;
        const float angf = (float)pos * inv;
        const double ang = (double)angf;
        const double k = __builtin_rint(ang * 0.6366197723675814);
        double rr = __builtin_fma(-k, 1.5707963267948966, ang); rr = __builtin_fma(-k, 6.123233995736766e-17, rr);
        const double r2 = rr * rr;
        double sp = -1.0 / 6227020800.0; sp = sp * r2 + 1.0 / 39916800.0; sp = sp * r2 - 1.0 / 362880.0; sp = sp * r2 + 1.0 / 5040.0; sp = sp * r2 - 1.0 / 120.0; sp = sp * r2 + 1.0 / 6.0;
        const double sn = rr - rr * r2 * sp;
        double cp = 1.0 / 87178291200.0; cp = cp * r2 - 1.0 / 479001600.0; cp = cp * r2 + 1.0 / 3628800.0; cp = cp * r2 - 1.0 / 40320.0; cp = cp * r2 + 1.0 / 720.0; cp = cp * r2 - 1.0 / 24.0; cp = cp * r2 + 0.5;
        const double cs = 1.0 - r2 * cp;
        const int q = ((int)k) & 3;
        const double sv = (q == 0) ? sn : (q == 1) ? cs : (q == 2) ? -sn : -cs;
        const double cv = (q == 0) ? cs : (q == 1) ? -sn : (q == 2) ? -cs : sn;
        cosT[idx] = (float)cv; sinT[idx] = (float)sv;
    }
}

template <int MODE> __device__ __forceinline__ void skinny_meta(const bf16_t* A, int lda, const bf16_t* Bt, int K, int ntask, int gw, int NGW, int lane,
                                                                bf16_t* HFF, float* Z, const float* meta, bf16_t* KV, bf16_t* KI, bf16_t* CU, const float* cosT, const float* sinT) {
    const int fr = lane & 15, fq = lane >> 4;
    for (int task = gw; task < ntask; task += NGW) {
        int pn, x0;
        if (MODE == 0) { pn = task >> 3; x0 = (task & 7) * 16; }
        else if (MODE == 1) { pn = 0; x0 = task * 16; }
        else { if (task < 8) { pn = 2; x0 = task * 16; } else if (task < 10) { pn = 5; x0 = (task - 8) * 16; } else { pn = 6 + ((task - 10) >> 3); x0 = ((task - 10) & 7) * 16; } }
        const int r0 = (MODE == 1) ? x0 + fr : 256 * pn + x0 + fr;
        const bf16_t* ap = A + (size_t)fr * lda + 8 * fq;
        const bf16_t* b0 = Bt + (size_t)r0 * K + 8 * fq;
        const bf16_t* b1 = b0 + (size_t)128 * K;
        f32x4 acc0 = {0.f, 0.f, 0.f, 0.f}, acc1 = {0.f, 0.f, 0.f, 0.f};
#pragma unroll 8
        for (int k = 0; k < K; k += 32) {
            const bf16x8 a = *(const bf16x8*)(ap + k), x = *(const bf16x8*)(b0 + k);
            acc0 = __builtin_amdgcn_mfma_f32_16x16x32_bf16(a, x, acc0, 0, 0, 0);
            if (MODE != 1) { const bf16x8 y = *(const bf16x8*)(b1 + k); acc1 = __builtin_amdgcn_mfma_f32_16x16x32_bf16(a, y, acc1, 0, 0, 0); }
        }
#pragma unroll
        for (int i = 0; i < 4; ++i) {
            const int m = 4 * fq + i; const size_t row = (size_t)(NREAL + m); const int x = x0 + fr;
            const float a0 = acc0[i], a1 = acc1[i];
            if (MODE == 0) {
                const float e = __builtin_amdgcn_exp2f(-a0 * 1.4426950408889634f);
                HFF[row * FF + 128 * pn + x] = (bf16_t)f2bf(a0 * __builtin_amdgcn_rcpf(1.0f + e) * a1);
            } else if (MODE == 1) {
                HFF[row * DM + x] = (bf16_t)f2bf(0.5f * a0);
            } else {
                if (pn == 2) {
                    if (x < 64) { const int d = x & 31; const float c = cosT[m * 32 + d], s = sinT[m * 32 + d]; unsigned char* K8m = (unsigned char*)HFF;
                        const float lo = a0 * c - a1 * s, hi = a1 * c + a0 * s;
                        K8m[row * 128 + (x >> 5) * 64 + d] = (unsigned char)(pk4_fp8(lo, lo, lo, lo) & 0xffu); K8m[row * 128 + (x >> 5) * 64 + 32 + d] = (unsigned char)(pk4_fp8(hi, hi, hi, hi) & 0xffu); }
                    else { unsigned char* V8m = (unsigned char*)KV;
                        V8m[row * 128 + (x - 64)] = (unsigned char)(pk4_fp8(a0, a0, a0, a0) & 0xffu); V8m[row * 128 + 64 + (x - 64)] = (unsigned char)(pk4_fp8(a1, a1, a1, a1) & 0xffu); }
                } else if (pn == 5) {
                    const float c = cosT[m * 32 + x], s = sinT[m * 32 + x]; unsigned char* KI8m = (unsigned char*)KI;
                    const float lo = a0 * c - a1 * s, hi = a1 * c + a0 * s;
                    KI8m[row * 64 + x] = (unsigned char)(pk4_fp8(lo, lo, lo, lo) & 0xffu); KI8m[row * 64 + 32 + x] = (unsigned char)(pk4_fp8(hi, hi, hi, hi) & 0xffu);
                } else {
                    CU[row * 512 + (pn - 6) * 128 + x] = (bf16_t)f2bf(a0 * a1);
                }
            }
        }
    }
}

template <bool FINAL> __device__ __forceinline__ void ln_phase(const float* z, const float* g, const float* bta, bf16_t* hb, float* stats, float* outf, int nrows, int gw, int NGW, int lane) {
    f32x4 gv[4], bv[4];
#pragma unroll
    for (int j = 0; j < 4; ++j) { gv[j] = *(const f32x4*)(g + 256 * j + 4 * lane); bv[j] = *(const f32x4*)(bta + 256 * j + 4 * lane); }
    f32x4 v[4], nv[4];
    if (gw < nrows) {
#pragma unroll
        for (int j = 0; j < 4; ++j) v[j] = *(const f32x4*)(z + (size_t)gw * DM + 256 * j + 4 * lane);
    }
    for (int row = gw; row < nrows; row += NGW) {
        float s = 0.f;
#pragma unroll
        for (int j = 0; j < 4; ++j) s += (v[j][0] + v[j][1]) + (v[j][2] + v[j][3]);
        const int nrow = row + NGW;
        if (nrow < nrows) {
#pragma unroll
            for (int j = 0; j < 4; ++j) nv[j] = *(const f32x4*)(z + (size_t)nrow * DM + 256 * j + 4 * lane);
        }
        const float mean = wave_sum(s) * (1.f / DM); float s2 = 0.f;
#pragma unroll
        for (int j = 0; j < 4; ++j) { v[j] = v[j] - mean; s2 += (v[j][0] * v[j][0] + v[j][1] * v[j][1]) + (v[j][2] * v[j][2] + v[j][3] * v[j][3]); }
        const float rstd = 1.f / sqrtf(wave_sum(s2) * (1.f / DM) + LN_EPS);
#pragma unroll
        for (int j = 0; j < 4; ++j) {
            const f32x4 y = v[j] * rstd * gv[j] + bv[j];
            if (FINAL) *(f32x4*)(outf + (size_t)row * DM + 256 * j + 4 * lane) = y;
            else { u32x2 w; w.x = pk2(y[0], y[1]); w.y = pk2(y[2], y[3]); *(u32x2*)(hb + (size_t)row * DM + 256 * j + 4 * lane) = w; }
        }
#pragma unroll
        for (int j = 0; j < 4; ++j) v[j] = nv[j];
        if (!FINAL && lane == 0) { stats[2 * row] = mean; stats[2 * row + 1] = rstd; }
    }
}

template <int MODE> __device__ __forceinline__ void lnres_phase(const float* x, const float* meta, const bf16_t* Y, const float* g, const float* bta, bf16_t* hb, float* outf, int nrows, int gw, int NGW, int lane) {
    f32x4 gv[4], bv[4];
#pragma unroll
    for (int j = 0; j < 4; ++j) { gv[j] = *(const f32x4*)(g + 256 * j + 4 * lane); bv[j] = *(const f32x4*)(bta + 256 * j + 4 * lane); }
    f32x4 v[4], nv[4]; u32x2 yv[4], nyv[4];
#define LNR_LOAD(dv, dy, row) do { \
        if (MODE == 0) { const float* src_ = (row) < NREAL ? x + (size_t)(row) * DM : meta + (size_t)(((row) - NREAL) & 15) * DM; \
            _Pragma("unroll") for (int j = 0; j < 4; ++j) dv[j] = *(const f32x4*)(src_ + 256 * j + 4 * lane); } \
        else { _Pragma("unroll") for (int j = 0; j < 4; ++j) { const u32x2 p_ = *(const u32x2*)(hb + (size_t)(row) * DM + 256 * j + 4 * lane); dv[j] = (f32x4){bf_lo(p_.x), bf_hi(p_.x), bf_lo(p_.y), bf_hi(p_.y)}; } } \
        _Pragma("unroll") for (int j = 0; j < 4; ++j) dy[j] = *(const u32x2*)(Y + (size_t)(row) * DM + 256 * j + 4 * lane); } while (0)
    if (gw < nrows) LNR_LOAD(v, yv, gw);
    for (int row = gw; row < nrows; row += NGW) {
        float s = 0.f;
#pragma unroll
        for (int j = 0; j < 4; ++j) { const f32x4 yy = {bf_lo(yv[j].x), bf_hi(yv[j].x), bf_lo(yv[j].y), bf_hi(yv[j].y)}; v[j] = v[j] * ALPHA + yy; s += (v[j][0] + v[j][1]) + (v[j][2] + v[j][3]); }
        const int nrow = row + NGW;
        if (nrow < nrows) LNR_LOAD(nv, nyv, nrow);
        const float mean = wave_sum(s) * (1.f / DM); float s2 = 0.f;
#pragma unroll
        for (int j = 0; j < 4; ++j) { v[j] = v[j] - mean; s2 += (v[j][0] * v[j][0] + v[j][1] * v[j][1]) + (v[j][2] * v[j][2] + v[j][3] * v[j][3]); }
        const float rstd = 1.f / sqrtf(wave_sum(s2) * (1.f / DM) + LN_EPS);
#pragma unroll
        for (int j = 0; j < 4; ++j) {
            const f32x4 y = v[j] * rstd * gv[j] + bv[j];
            if (MODE == 2) *(f32x4*)(outf + (size_t)row * DM + 256 * j + 4 * lane) = y;
            else { u32x2 w; w.x = pk2(y[0], y[1]); w.y = pk2(y[2], y[3]); *(u32x2*)(hb + (size_t)row * DM + 256 * j + 4 * lane) = w; }
        }
#pragma unroll
        for (int j = 0; j < 4; ++j) { v[j] = nv[j]; yv[j] = nyv[j]; }
    }
#undef LNR_LOAD
}

__device__ __forceinline__ void conv_phase(const bf16_t* CU, const bf16_t* GB, const float* cw, bf16_t* YCV, int gtid, int NT) {
    for (int it = gtid; it < NREAL * 64; it += NT) {
        const int row = it >> 6, c8 = (it & 63) * 8, s = row & (SEQ - 1);
        const size_t r0 = (size_t)row, r1 = s >= 1 ? (size_t)(row - 1) : (size_t)(NREAL + 15), r2 = s >= 2 ? (size_t)(row - 2) : (size_t)(NREAL + 14 + s);
        const u32x4 x0 = *(const u32x4*)(CU + r0 * 512 + c8), x1 = *(const u32x4*)(CU + r1 * 512 + c8), x2 = *(const u32x4*)(CU + r2 * 512 + c8), gb = *(const u32x4*)(GB + r0 * 512 + c8);
        float o[8];
#pragma unroll
        for (int h = 0; h < 4; ++h) {
            const unsigned a0 = h == 0 ? x0.x : h == 1 ? x0.y : h == 2 ? x0.z : x0.w, a1 = h == 0 ? x1.x : h == 1 ? x1.y : h == 2 ? x1.z : x1.w, a2 = h == 0 ? x2.x : h == 1 ? x2.y : h == 2 ? x2.z : x2.w, gg = h == 0 ? gb.x : h == 1 ? gb.y : h == 2 ? gb.z : gb.w;
            const int c = c8 + 2 * h;
            o[2 * h] = bf_lo(gg) * (cw[c] * bf_lo(a2) + cw[512 + c] * bf_lo(a1) + cw[1024 + c] * bf_lo(a0));
            o[2 * h + 1] = bf_hi(gg) * (cw[c + 1] * bf_hi(a2) + cw[512 + c + 1] * bf_hi(a1) + cw[1024 + c + 1] * bf_hi(a0));
        }
        u32x4 w; w.x = pk2(o[0], o[1]); w.y = pk2(o[2], o[3]); w.z = pk2(o[4], o[5]); w.w = pk2(o[6], o[7]);
        *(u32x4*)(YCV + r0 * 512 + c8) = w;
    }
}

__device__ __forceinline__ float relu_i(float x) { const int i = __builtin_bit_cast(int, x); return __builtin_bit_cast(float, i > 0 ? i : 0); }
__device__ __forceinline__ size_t seqrow(int b, int idx) { return idx < NMETA ? (size_t)(NREAL + idx) : (size_t)(b * SEQ + idx - NMETA); }

__device__ __forceinline__ void find_bin(LAS unsigned* hist, unsigned need, int lane, unsigned& bin, unsigned& above) {
    const u32x4 h = *(const LAS u32x4*)(hist + 252 - 4 * lane);
    const unsigned tot = h.x + h.y + h.z + h.w;
    unsigned incl = tot;
#pragma unroll
    for (int o = 1; o < 64; o <<= 1) { const unsigned t = __shfl_up(incl, o); if (lane >= o) incl += t; }
    const unsigned excl = incl - tot;
    const bool found = excl < need && need <= incl;
    unsigned a = excl, bsel = 0, asel = 0;
    if (a + h.w >= need) { bsel = 255 - 4 * lane; asel = a; }
    else { a += h.w; if (a + h.z >= need) { bsel = 254 - 4 * lane; asel = a; } else { a += h.z; if (a + h.y >= need) { bsel = 253 - 4 * lane; asel = a; } else { a += h.y; bsel = 252 - 4 * lane; asel = a; } } }
    const unsigned long long bal = __ballot(found);
    const int src = bal ? (int)__builtin_ctzll(bal) : 0;
    bin = (unsigned)__shfl((int)bsel, src); above = (unsigned)__shfl((int)asel, src);
}

__device__ __forceinline__ void attn_phase(const bf16_t* QS, const bf16_t* QI, const bf16_t* KV, const bf16_t* KI, const float* WI, bf16_t* ATT, const unsigned char* K8,
                                           LAS unsigned char* lds, int wave, int lane) {
    const int c32 = lane & 31, hi = lane >> 5, fr = lane & 15, fq = lane >> 4;
    LAS unsigned char* myreg = lds + wave * WREG;
    LAS unsigned short* myrow = (LAS unsigned short*)myreg;
    LAS unsigned* hist = (LAS unsigned*)(myreg + 16640);
    LAS unsigned short* list = (LAS unsigned short*)(myreg + 16640 + 1024);
    LAS unsigned char* vimg = myreg;
    LAS bf16_t* obuf = (LAS bf16_t*)(myreg);
    const int G = gridDim.x, cb = blockIdx.x;
    *(LAS u32x4*)(hist + 4 * lane) = (u32x4){0u, 0u, 0u, 0u};
    LDS_WAIT();
    __syncthreads();
    for (int p = cb; p < 4096; p += G) {
        const int b = p >> 9, pidx = p & 511;
#pragma unroll 1
        for (int half = 0; half < 2; ++half) {
            const int sblk = half ? 1023 - pidx : pidx, s0 = sblk * 8;
            const int rq0 = b * SEQ + s0;
            {
                const unsigned char* QI8 = (const unsigned char*)QI; const unsigned char* KI8 = (const unsigned char*)KI;
                u32x4 qa[4];
#pragma unroll
                for (int mt = 0; mt < 4; ++mt) qa[mt] = *(const u32x4*)(QI8 + (size_t)(rq0 + 2 * mt + (fr >> 3)) * 512 + (fr & 7) * 64 + 16 * fq);
                LAS float* wmisc = (LAS float*)(myreg + 18176);
                wmisc[lane] = WI[(size_t)rq0 * 8 + lane];
                LDS_WAIT();
                const LAS float* wrd = wmisc + (fq >> 1) * 8 + 4 * (fq & 1);
                const int nmax = NMETA + s0 + 8, ntile = (nmax + 15) >> 4;
                const int qa_ = 2 * (fq & 1) + (fq >> 1);
                asm volatile("" : "+v"(qa[0]), "+v"(qa[1]), "+v"(qa[2]), "+v"(qa[3]) :: "memory");
#define S1_LOAD(dst, tt) do { const int kk_ = 16 * (tt) + fr, kld_ = kk_ < nmax ? kk_ : nmax - 1; const unsigned char* kp_ = KI8 + seqrow(b, kld_) * 64 + 16 * fq; \
        asm volatile("global_load_dwordx4 %0, %1, off" : "=&v"(dst) : "v"(kp_) : "memory"); } while (0)
#define S1_WAIT(nn, dst) asm volatile("s_waitcnt vmcnt(" #nn ")" : "+v"(dst) :: "memory")
#define S1_TILE(kbv, tt) do { const int kk = 16 * (tt) + fr; float part_[4]; \
        const long kb0_ = (long)(((unsigned long long)kbv.y << 32) | kbv.x), kb1_ = (long)(((unsigned long long)kbv.w << 32) | kbv.z); \
        _Pragma("unroll") for (int mt = 0; mt < 4; ++mt) { f32x4 acc_ = {0.f, 0.f, 0.f, 0.f}; \
            acc_ = __builtin_amdgcn_mfma_f32_16x16x32_fp8_fp8((long)(((unsigned long long)qa[mt].y << 32) | qa[mt].x), kb0_, acc_, 0, 0, 0); \
            acc_ = __builtin_amdgcn_mfma_f32_16x16x32_fp8_fp8((long)(((unsigned long long)qa[mt].w << 32) | qa[mt].z), kb1_, acc_, 0, 0, 0); \
            const f32x4 w_ = *(const LAS f32x4*)(wrd + 16 * mt); float p_ = 0.f; \
            _Pragma("unroll") for (int i = 0; i < 4; ++i) p_ = __builtin_fmaf(w_[i], relu_i(acc_[i]), p_); \
            part_[mt] = p_; } \
        _Pragma("unroll") for (int pr = 0; pr < 2; ++pr) { \
            auto rr_ = __builtin_amdgcn_permlane16_swap(__builtin_bit_cast(unsigned, part_[2 * pr]), __builtin_bit_cast(unsigned, part_[2 * pr + 1]), false, false); \
            const float tot_ = __builtin_bit_cast(float, (unsigned)rr_[0]) + __builtin_bit_cast(float, (unsigned)rr_[1]); \
            const int q = 4 * pr + qa_; const _Float16 hh = (_Float16)tot_; const unsigned hb = (unsigned)__builtin_bit_cast(unsigned short, hh); \
            unsigned key = (hb & 0x8000u) ? (~hb & 0xffffu) : (hb | 0x8000u); \
            const bool valid = kk <= NMETA + s0 + q; if (!valid) key = 0u; \
            *(LAS unsigned short*)(lds + q * WREG + kk * 2) = (unsigned short)key; \
            __hip_atomic_fetch_add((LAS unsigned*)(lds + q * WREG + 16640) + (key >> 8), valid ? 1u : 0u, __ATOMIC_RELAXED, __HIP_MEMORY_SCOPE_WORKGROUP); } } while (0)
                u32x4 kr0, kr1, kr2, kr3, kr4, kr5, kr6, kr7;
                S1_LOAD(kr0, wave); S1_LOAD(kr1, wave + NWAVES); S1_LOAD(kr2, wave + 2 * NWAVES); S1_LOAD(kr3, wave + 3 * NWAVES);
                S1_LOAD(kr4, wave + 4 * NWAVES); S1_LOAD(kr5, wave + 5 * NWAVES); S1_LOAD(kr6, wave + 6 * NWAVES); S1_LOAD(kr7, wave + 7 * NWAVES);
#define S1_STEP(kr, off) do { S1_WAIT(7, kr); if (t + (off) * NWAVES < ntile) { S1_TILE(kr, t + (off) * NWAVES); } S1_LOAD(kr, t + ((off) + 8) * NWAVES); } while (0)
                for (int t = wave; t < ntile; t += 8 * NWAVES) {
                    S1_STEP(kr0, 0); S1_STEP(kr1, 1); S1_STEP(kr2, 2); S1_STEP(kr3, 3); S1_STEP(kr4, 4); S1_STEP(kr5, 5); S1_STEP(kr6, 6); S1_STEP(kr7, 7);
                }
                S1_WAIT(0, kr0); S1_WAIT(0, kr1); S1_WAIT(0, kr2); S1_WAIT(0, kr3); S1_WAIT(0, kr4); S1_WAIT(0, kr5); S1_WAIT(0, kr6); S1_WAIT(0, kr7);
#undef S1_STEP
#undef S1_LOAD
#undef S1_WAIT
#undef S1_TILE
            }
            LDS_WAIT();
            __syncthreads();
            const int n = NMETA + s0 + wave + 1;
            const int cnt = n < 256 ? n : 256;
            if (n <= 256) {
#pragma unroll
                for (int i = 0; i < 4; ++i) { const int s = i * 64 + lane; list[s] = (unsigned short)(s < n ? s : 0); }
                LDS_WAIT();
                *(LAS u32x4*)(hist + 4 * lane) = (u32x4){0u, 0u, 0u, 0u};
            } else {
                unsigned b1, ab1; find_bin(hist, 256u, lane, b1, ab1);
                const unsigned c1 = hist[b1];
                if (c1 <= (unsigned)CAND_CAP) {
                    LAS unsigned short* cand = (LAS unsigned short*)(lds + 147456 + wave * 2048);
                    const unsigned need2 = 256u - ab1;
                    LDS_WAIT();
                    *(LAS u32x4*)(hist + 4 * lane) = (u32x4){0u, 0u, 0u, 0u};
                    const int nit8 = (n + 511) >> 9;
                    unsigned sel_cnt = 0, cand_cnt = 0;
                    u32x4 kwm = *(const LAS u32x4*)(myrow + 8 * lane);
                    for (int it = 0; it < nit8; ++it) {
                        const int i0 = 8 * (64 * it + lane);
                        const u32x4 kw = kwm;
                        kwm = *(const LAS u32x4*)(myrow + i0 + 512);
                        const unsigned k[8] = {kw.x & 0xffffu, kw.x >> 16, kw.y & 0xffffu, kw.y >> 16, kw.z & 0xffffu, kw.z >> 16, kw.w & 0xffffu, kw.w >> 16};
                        bool gt[8], cd[8]; unsigned cg = 0, cc = 0;
#pragma unroll
                        for (int j = 0; j < 8; ++j) { const bool in = i0 + j < n; const unsigned hj = k[j] >> 8; gt[j] = in && hj > b1; cd[j] = in && hj == b1; cg += gt[j] ? 1u : 0u; cc += cd[j] ? 1u : 0u; }
                        const unsigned v = cg | (cc << 16);
                        unsigned incl = v;
                        incl += (unsigned)__builtin_amdgcn_update_dpp(0, (int)incl, 0x111, 0xf, 0xf, false);
                        incl += (unsigned)__builtin_amdgcn_update_dpp(0, (int)incl, 0x112, 0xf, 0xf, false);
                        incl += (unsigned)__builtin_amdgcn_update_dpp(0, (int)incl, 0x114, 0xf, 0xf, false);
                        incl += (unsigned)__builtin_amdgcn_update_dpp(0, (int)incl, 0x118, 0xf, 0xf, false);
                        incl += (unsigned)__builtin_amdgcn_update_dpp(0, (int)incl, 0x142, 0xa, 0xf, false);
                        incl += (unsigned)__builtin_amdgcn_update_dpp(0, (int)incl, 0x143, 0xc, 0xf, false);
                        const unsigned excl = incl - v, tot = (unsigned)__builtin_amdgcn_readlane((int)incl, 63);
                        unsigned ps = sel_cnt + (excl & 0xffffu), pc = cand_cnt + (excl >> 16);
                        if (v != 0u) {
#pragma unroll
                            for (int j = 0; j < 8; ++j) {
                                if (gt[j] && ps < 256u) list[ps] = (unsigned short)(i0 + j);
                                if (cd[j] && pc < (unsigned)CAND_CAP) cand[pc] = (unsigned short)(i0 + j);
                                ps += gt[j] ? 1u : 0u; pc += cd[j] ? 1u : 0u;
                            }
                        }
                        sel_cnt += tot & 0xffffu; cand_cnt += tot >> 16;
                    }
                    LDS_WAIT();
                    for (unsigned i = lane; i < c1; i += 64) { const unsigned key = myrow[cand[i]]; __hip_atomic_fetch_add(hist + (key & 255u), 1u, __ATOMIC_RELAXED, __HIP_MEMORY_SCOPE_WORKGROUP); }
                    LDS_WAIT();
                    unsigned b2, ab2; find_bin(hist, need2, lane, b2, ab2);
                    const unsigned need_eq = need2 - ab2;
                    LDS_WAIT();
                    *(LAS u32x4*)(hist + 4 * lane) = (u32x4){0u, 0u, 0u, 0u};
                    unsigned out_cnt = ab1, eq_cnt = 0;
                    for (unsigned base = 0; base < c1; base += 64) {
                        const unsigned i = base + lane; const bool in = i < c1;
                        const unsigned idx = in ? (unsigned)cand[i] : 0u;
                        const unsigned lo = (unsigned)myrow[idx] & 255u;
                        const bool g2 = in && lo > b2, e2 = in && lo == b2;
                        const unsigned long long eqb = __ballot(e2);
                        const unsigned eq_rank = eq_cnt + __builtin_amdgcn_mbcnt_hi((unsigned)(eqb >> 32), __builtin_amdgcn_mbcnt_lo((unsigned)eqb, 0u));
                        const bool sel = g2 || (e2 && eq_rank < need_eq);
                        const unsigned long long sb = __ballot(sel);
                        const unsigned pos = out_cnt + __builtin_amdgcn_mbcnt_hi((unsigned)(sb >> 32), __builtin_amdgcn_mbcnt_lo((unsigned)sb, 0u));
                        if (sel && pos < 256u) list[pos] = (unsigned short)idx;
                        out_cnt += (unsigned)__popcll(sb); eq_cnt += (unsigned)__popcll(eqb);
                    }
                } else {
                const unsigned need2 = 256u - ab1;
                LDS_WAIT();
                *(LAS u32x4*)(hist + 4 * lane) = (u32x4){0u, 0u, 0u, 0u};
                LDS_WAIT();
                const int nit = (n + 255) >> 8;
                u32x2 kwn = *(const LAS u32x2*)(myrow + 4 * lane);
                for (int it = 0; it < nit; ++it) {
                    const int i0 = 4 * (64 * it + lane);
                    const u32x2 kw = kwn;
                    kwn = *(const LAS u32x2*)(myrow + i0 + 256);
                    const unsigned k0 = kw.x & 0xffffu, k1 = kw.x >> 16, k2 = kw.y & 0xffffu, k3 = kw.y >> 16;
                    if (i0 + 0 < n && (k0 >> 8) == b1) __hip_atomic_fetch_add(hist + (k0 & 255u), 1u, __ATOMIC_RELAXED, __HIP_MEMORY_SCOPE_WORKGROUP);
                    if (i0 + 1 < n && (k1 >> 8) == b1) __hip_atomic_fetch_add(hist + (k1 & 255u), 1u, __ATOMIC_RELAXED, __HIP_MEMORY_SCOPE_WORKGROUP);
                    if (i0 + 2 < n && (k2 >> 8) == b1) __hip_atomic_fetch_add(hist + (k2 & 255u), 1u, __ATOMIC_RELAXED, __HIP_MEMORY_SCOPE_WORKGROUP);
                    if (i0 + 3 < n && (k3 >> 8) == b1) __hip_atomic_fetch_add(hist + (k3 & 255u), 1u, __ATOMIC_RELAXED, __HIP_MEMORY_SCOPE_WORKGROUP);
                }
                LDS_WAIT();
                unsigned b2, ab2; find_bin(hist, need2, lane, b2, ab2);
                const unsigned T = (b1 << 8) | b2, need_eq = need2 - ab2;
                LDS_WAIT();
                *(LAS u32x4*)(hist + 4 * lane) = (u32x4){0u, 0u, 0u, 0u};
                unsigned sel_cnt = 0, eq_cnt = 0;
                u32x2 kwm = *(const LAS u32x2*)(myrow + 4 * lane);
                for (int it = 0; it < nit; ++it) {
                    const int i0 = 4 * (64 * it + lane);
                    const u32x2 kw = kwm;
                    kwm = *(const LAS u32x2*)(myrow + i0 + 256);
                    unsigned k[4] = {kw.x & 0xffffu, kw.x >> 16, kw.y & 0xffffu, kw.y >> 16};
                    unsigned cg = 0, ce = 0;
#pragma unroll
                    for (int j = 0; j < 4; ++j) { if (i0 + j >= n) k[j] = 0u; cg += (k[j] > T) ? 1u : 0u; ce += (k[j] == T) ? 1u : 0u; }
                    const unsigned v = cg | (ce << 16);
                    unsigned incl = v;
                    incl += (unsigned)__builtin_amdgcn_update_dpp(0, (int)incl, 0x111, 0xf, 0xf, false);
                    incl += (unsigned)__builtin_amdgcn_update_dpp(0, (int)incl, 0x112, 0xf, 0xf, false);
                    incl += (unsigned)__builtin_amdgcn_update_dpp(0, (int)incl, 0x114, 0xf, 0xf, false);
                    incl += (unsigned)__builtin_amdgcn_update_dpp(0, (int)incl, 0x118, 0xf, 0xf, false);
                    incl += (unsigned)__builtin_amdgcn_update_dpp(0, (int)incl, 0x142, 0xa, 0xf, false);
                    incl += (unsigned)__builtin_amdgcn_update_dpp(0, (int)incl, 0x143, 0xc, 0xf, false);
                    const unsigned excl = incl - v, tot = (unsigned)__builtin_amdgcn_readlane((int)incl, 63);
                    const unsigned pg = excl & 0xffffu, pe = excl >> 16;
                    const unsigned base_eq = eq_cnt < need_eq ? eq_cnt : need_eq;
                    unsigned r_eq = eq_cnt + pe;
                    unsigned pos = sel_cnt + pg + ((r_eq < need_eq ? r_eq : need_eq) - base_eq);
#pragma unroll
                    for (int j = 0; j < 4; ++j) {
                        const bool gt = k[j] > T, eq = k[j] == T;
                        const bool take = gt || (eq && r_eq < need_eq);
                        if (take && pos < 256u) list[pos] = (unsigned short)(i0 + j);
                        pos += take ? 1u : 0u; r_eq += eq ? 1u : 0u;
                    }
                    const unsigned tg = tot & 0xffffu, te = tot >> 16;
                    const unsigned e1 = eq_cnt + te;
                    sel_cnt += tg + ((e1 < need_eq ? e1 : need_eq) - base_eq); eq_cnt = e1;
                }
                            }
            }
            LDS_WAIT();
#ifdef PROBE_S3X2
            for (int rep3 = 0; rep3 < 2; ++rep3)
#endif
            {
                const int rq = rq0 + wave;
                long qb[4];
                {
                    const bool qv = fr < 8 && (fr >> 2) == (fq >> 1);
                    const bf16_t* qp = QS + (size_t)rq * 512 + (qv ? fr : 0) * 64 + ((32 * fq) & 63);
#pragma unroll
                    for (int s = 0; s < 4; ++s) {
                        const u32x4 w = *(const u32x4*)(qp + 8 * s);
                        const unsigned lo = pk4_fp8(bf_lo(w.x) * 8.f, bf_hi(w.x) * 8.f, bf_lo(w.y) * 8.f, bf_hi(w.y) * 8.f), hi = pk4_fp8(bf_lo(w.z) * 8.f, bf_hi(w.z) * 8.f, bf_lo(w.w) * 8.f, bf_hi(w.w) * 8.f);
                        qb[s] = qv ? (long)(((unsigned long long)hi << 32) | lo) : 0l;
                    }
                }
                const int vR = lane >> 4, vpc = lane & 15;
#define V_DMA(kk) do { _Pragma("unroll") for (int it = 0; it < 4; ++it) { const int rho_ = 8 * it + (lane >> 3), j_ = rho_ & 7, f_ = rho_ >> 3; \
        const int kidx_ = list[32 * (kk) + (j_ < 4 ? 4 * f_ + j_ : 12 + 4 * f_ + j_)]; \
        const unsigned char* gp_ = V8 + seqrow(b, kidx_) * 128 + 16 * ((lane & 7) ^ ((rho_ >> 1) & 7)); \
        __builtin_amdgcn_global_load_lds((const unsigned*)gp_, (LAS unsigned*)(vimg + ((kk) & 3) * 4096 + it * 1024), 16, 0, 0); } } while (0)
#define K_LOAD(dst, t) do { const int kidx_ = list[(t) * 16 + fr]; const unsigned char* kp_ = K8 + seqrow(b, kidx_) * 128 + 32 * fq; \
        dst[0] = *(const u32x4*)kp_; dst[1] = *(const u32x4*)(kp_ + 16); } while (0)
                const unsigned char* V8 = (const unsigned char*)KV;
                V_DMA(0); V_DMA(1); V_DMA(2); V_DMA(3);
                u32x4 ka[8][2];
#pragma unroll
                for (int t = 0; t < 8; ++t) K_LOAD(ka[t], t);
                f32x4 sc[16];
#pragma unroll
                for (int t = 0; t < 16; ++t) {
                    f32x4 acc = {0.f, 0.f, 0.f, 0.f};
#pragma unroll
                    for (int s = 0; s < 4; ++s) { const u32x4 kw_ = ka[t & 7][s >> 1]; const unsigned l_ = (s & 1) ? kw_.z : kw_.x, h_ = (s & 1) ? kw_.w : kw_.y;
                        acc = __builtin_amdgcn_mfma_f32_16x16x32_fp8_fp8((long)(((unsigned long long)h_ << 32) | l_), qb[s], acc, 0, 0, 0); }
                    sc[t] = acc * 0.125f;
                    if (t + 8 < 16) K_LOAD(ka[t & 7], t + 8);
                    __builtin_amdgcn_sched_barrier(0);
                }
#undef K_LOAD
                float mx = -INFINITY;
#pragma unroll
                for (int t = 0; t < 16; ++t)
#pragma unroll
                    for (int i = 0; i < 4; ++i) { if (16 * t + 4 * fq + i >= cnt) sc[t][i] = -INFINITY; mx = fmaxf(mx, sc[t][i]); }
                mx = fmaxf(mx, __shfl_xor(mx, 16)); mx = fmaxf(mx, __shfl_xor(mx, 32));
                float l = 0.f;
#pragma unroll
                for (int t = 0; t < 16; ++t)
#pragma unroll
                    for (int i = 0; i < 4; ++i) { const float e = __builtin_amdgcn_exp2f((sc[t][i] - mx) * 1.4426950408889634f); sc[t][i] = e; l += e; }
                l += __shfl_xor(l, 16); l += __shfl_xor(l, 32);
                long pa[8];
#pragma unroll
                for (int kk = 0; kk < 8; ++kk) { const unsigned lo_ = pk4_fp8(sc[2 * kk][0], sc[2 * kk][1], sc[2 * kk][2], sc[2 * kk][3]), hi_ = pk4_fp8(sc[2 * kk + 1][0], sc[2 * kk + 1][1], sc[2 * kk + 1][2], sc[2 * kk + 1][3]); pa[kk] = (long)(((unsigned long long)hi_ << 32) | lo_); }
                f32x4 o[8];
#pragma unroll
                for (int nt = 0; nt < 8; ++nt) o[nt] = (f32x4){0.f, 0.f, 0.f, 0.f};
                const int vrow = 8 * fq + ((lane & 15) >> 1), vswz = (vrow >> 1) & 7;
                const LAS unsigned char* vb = vimg + vrow * 128 + 8 * (lane & 1);
                typedef int v2i32_t __attribute__((ext_vector_type(2)));
#define PV_STEP(kk) do { \
        if ((kk) <= 4) asm volatile("s_waitcnt vmcnt(12)" ::: "memory"); else if ((kk) == 5) asm volatile("s_waitcnt vmcnt(8)" ::: "memory"); else if ((kk) == 6) asm volatile("s_waitcnt vmcnt(4)" ::: "memory"); else asm volatile("s_waitcnt vmcnt(0)" ::: "memory"); \
        _Pragma("unroll") for (int nt = 0; nt < 8; ++nt) { \
            const v2i32_t vv_ = __builtin_amdgcn_ds_read_tr8_b64_v2i32((LAS v2i32_t*)(vb + ((kk) & 3) * 4096 + ((nt ^ vswz) << 4))); \
            o[nt] = __builtin_amdgcn_mfma_f32_16x16x32_fp8_fp8(pa[kk], (long)(((unsigned long long)(unsigned)vv_[1] << 32) | (unsigned)vv_[0]), o[nt], 0, 0, 0); } \
        LDS_WAIT(); \
        if ((kk) + 4 < 8) V_DMA((kk) + 4); __builtin_amdgcn_sched_barrier(0); } while (0)
                PV_STEP(0); PV_STEP(1); PV_STEP(2); PV_STEP(3); PV_STEP(4); PV_STEP(5); PV_STEP(6); PV_STEP(7);
#undef PV_STEP
#undef V_DMA
                LDS_WAIT();
                float linv[4];
#pragma unroll
                for (int i = 0; i < 4; ++i) linv[i] = 1.0f / __shfl(l, (4 * fq + i) & 7);
#pragma unroll
                for (int nt = 0; nt < 8; ++nt) {
                    if (fq == (nt >> 2)) {
#pragma unroll
                        for (int i = 0; i < 4; ++i) obuf[(4 * fq + i) * 64 + (nt & 3) * 16 + fr] = (bf16_t)f2bf(o[nt][i] * linv[i]);
                    }
                }
                LDS_WAIT();
                const u32x4 ov = *(const LAS u32x4*)((LAS unsigned char*)obuf + lane * 16);
                *(u32x4*)(ATT + (size_t)rq * 512 + lane * 8) = ov;
            }
            LDS_WAIT();
            __syncthreads();
        }
    }
}


#define XB_TMO      128
#define XB_XCNT(j)  (256  + 64 * (j))
#define XB_XSUB(j)  (1280 + 64 * (j))
#define XB_XGEN(j)  (2304 + 64 * (j))
#define XB_TOP      3328
#define XB_TOPGEN   3392
#define XCD_BAR_WORDS 3456
#define XB_SPIN_CAP (1u << 18)

__device__ __forceinline__ unsigned xb_ld(unsigned* p)              { return __hip_atomic_load(p, __ATOMIC_RELAXED, __HIP_MEMORY_SCOPE_AGENT); }
__device__ __forceinline__ unsigned xb_add(unsigned* p, unsigned v) { return __hip_atomic_fetch_add(p, v, __ATOMIC_RELAXED, __HIP_MEMORY_SCOPE_AGENT); }
__device__ __forceinline__ unsigned xb_xcc_id() { return (unsigned)__builtin_amdgcn_s_getreg((3 << 11) | 20) & 0xFu; }
#define XB_SPIN(cond, bar) do { unsigned _sp = 0; while (cond) { __builtin_amdgcn_s_sleep(1); \
    if ((++_sp & 255u) == 0u) { if (xb_ld(&(bar)[XB_TMO])) break; if (_sp > XB_SPIN_CAP) { atomicAdd(&(bar)[XB_TMO], 1u); break; } } } } while (0)

struct XcdBarrier {
    unsigned* bar; unsigned x;
    volatile LAS unsigned* st;
};

__device__ __forceinline__ XcdBarrier xcd_barrier_post(unsigned* bar, volatile LAS unsigned* st) {
    XcdBarrier b; b.bar = bar; b.x = xb_xcc_id(); b.st = st;
    if (threadIdx.x == 0) (void)xb_add(&bar[XB_XCNT(b.x)], 1u);
    return b;
}
__device__ __forceinline__ void xcd_barrier_complete(unsigned* bar, unsigned x, unsigned& nloc, unsigned& nx) {
    const unsigned G = gridDim.x * gridDim.y * gridDim.z;
    unsigned sum, cnt, mine, sp = 0u;
    for (;;) {
        sum = 0u; cnt = 0u; mine = 0u;
#pragma unroll
        for (unsigned j = 0; j < 16; ++j) { const unsigned c = xb_ld(&bar[XB_XCNT(j)]); sum += c; cnt += (c > 0u) ? 1u : 0u; mine = (j == x) ? c : mine; }
        if (sum == G) break;
        __builtin_amdgcn_s_sleep(1);
        if ((++sp & 255u) == 0u) { if (xb_ld(&bar[XB_TMO])) break; if (sp > XB_SPIN_CAP) { atomicAdd(&bar[XB_TMO], 1u); break; } }
    }
    nloc = mine > 0u ? mine : 1u; nx = cnt > 0u ? cnt : 1u;
}

__device__ __forceinline__ void xcd_barrier(const XcdBarrier& b) {
    asm volatile("s_waitcnt vmcnt(0)" ::: "memory");
    __syncthreads();
    if (threadIdx.x == 0) {
        unsigned* bar = b.bar;
        __builtin_amdgcn_s_waitcnt(0);
        unsigned nloc = b.st[0], nx = b.st[1];
        if (nloc == 0u) { xcd_barrier_complete(bar, b.x, nloc, nx); b.st[0] = nloc; b.st[1] = nx; }
        const unsigned old = xb_add(&bar[XB_XSUB(b.x)], 1u);
        const unsigned gen = old / nloc;
        if (old + 1u == (gen + 1u) * nloc) {
            __builtin_amdgcn_fence(__ATOMIC_RELEASE, "agent");
            asm volatile("s_waitcnt vmcnt(0)" ::: "memory");
            const unsigned og = xb_add(&bar[XB_TOP], 1u);
            const unsigned tg = og / nx;
            if (og + 1u == (tg + 1u) * nx) xb_add(&bar[XB_TOPGEN], 1u);
            else XB_SPIN(xb_ld(&bar[XB_TOPGEN]) == tg, bar);
            __builtin_amdgcn_fence(__ATOMIC_ACQUIRE, "agent");
            xb_add(&bar[XB_XGEN(b.x)], 1u);
            asm volatile("s_waitcnt vmcnt(0)" ::: "memory");
        } else {
            XB_SPIN(xb_ld(&bar[XB_XGEN(b.x)]) == gen, bar);
            __builtin_amdgcn_fence(__ATOMIC_ACQUIRE, "agent");
            asm volatile("s_waitcnt vmcnt(0)" ::: "memory");
        }
    }
    __syncthreads();
}

__global__ void __launch_bounds__(NWAVES * 64, 2) mk_fwd(Args a) {
    extern __shared__ __attribute__((aligned(16))) unsigned char lds_raw[];
    LAS unsigned char* lds = (LAS unsigned char*)lds_raw;
    const int tid = threadIdx.x, lane = tid & 63, wave = __builtin_amdgcn_readfirstlane(tid >> 6);
    const int G = gridDim.x, gw = blockIdx.x * NWAVES + wave, NGW = G * NWAVES;
    unsigned char* ws = a.ws;
    bf16_t* AB = (bf16_t*)(ws + OFF_AB); float* Z = (float*)(ws + OFF_Z); bf16_t* HFF = (bf16_t*)(ws + OFF_BIG);
    float* ST1 = (float*)(ws + OFF_ST1); float* ST2 = (float*)(ws + OFF_ST2);
    const int lo = a.ph_lo, hi = a.ph_hi;
    volatile LAS unsigned* bst = (volatile LAS unsigned*)(lds + LDS_BST);
    if (tid < 2) bst[tid] = 0u;
    __syncthreads();
    XcdBarrier gbar = xcd_barrier_post((unsigned*)(ws + OFF_CTL), bst);
#define IN(k) (lo <= (k) && (k) < hi)
#define SEAM(k) do { if (IN(k) && IN((k) + 1)) { if ((k) == 0) cooperative_groups::this_grid().sync(); else xcd_barrier(gbar); } } while (0)

    if (IN(0)) { p0_prologue(a, lds, gw, NGW, wave, lane, 7);
#ifdef PROBE_P0_PARTS
        p0_prologue(a, lds, gw, NGW, wave, lane, PROBE_P0_PARTS);
#endif
 }
    SEAM(0);
#ifdef PROBE_SYNC10
    for (int r_ = 0; r_ < 10; ++r_) cooperative_groups::this_grid().sync();
#endif
    if (IN(1)) { pg8::Gemm g{AB, (const bf16_t*)(ws + OFF_WGU1), NREAL, 5632, 1024}; pg8::StaticOrder S; S.init(NREAL, 5632, G, (int)blockIdx.x);
        EpiSwiglu E{HFF}; pg8::gemm_phase<EpiSwiglu, pg8::StaticOrder, true, true>(lds, g, S, E);
        skinny_meta<0>(AB + (size_t)NREAL * DM, DM, (const bf16_t*)(ws + OFF_WGU1), 1024, 22 * 8, gw, NGW, lane, HFF, nullptr, nullptr, nullptr, nullptr, nullptr, nullptr, nullptr); }
    SEAM(1);
    bf16_t* Y12 = (bf16_t*)a.out;
    bf16_t* Y3 = (bf16_t*)(ws + OFF_ATT);
    if (IN(2)) { pg8::Gemm g{HFF, (const bf16_t*)(ws + OFF_WD1), NREAL, 1024, FF}; pg8::StaticOrder S; S.init(NREAL, 1024, G, (int)blockIdx.x);
        EpiY E{Y12, 0.5f}; pg8::gemm_phase<EpiY, pg8::StaticOrder, true, true>(lds, g, S, E);
        skinny_meta<1>(HFF + (size_t)NREAL * FF, FF, (const bf16_t*)(ws + OFF_WD1), FF, 64, gw, NGW, lane, Y12, nullptr, nullptr, nullptr, nullptr, nullptr, nullptr, nullptr); }
    SEAM(2);
    if (IN(3)) { lnres_phase<0>(a.x, a.meta, Y12, a.ln1g, a.ln1b, AB, nullptr, NREAL + NMETA, gw, NGW, lane); }
    SEAM(3);
    if (IN(4)) { pg8::Gemm g{AB, (const bf16_t*)(ws + OFF_WIN), NREAL, 3072, 1024}; pg8::StaticOrder S; S.init(NREAL, 3072, G, (int)blockIdx.x);
        skinny_meta<2>(AB + (size_t)NREAL * DM, DM, (const bf16_t*)(ws + OFF_WIN), 1024, 42, gw, NGW, lane, (bf16_t*)(ws + OFF_K8), nullptr, nullptr, (bf16_t*)(ws + OFF_V8), (bf16_t*)(ws + OFF_KI8), (bf16_t*)(ws + OFF_CU), (const float*)(ws + OFF_COS), (const float*)(ws + OFF_SIN));
        EpiProj E{(bf16_t*)(ws + OFF_QS), (bf16_t*)(ws + OFF_QI), (bf16_t*)(ws + OFF_KV), (bf16_t*)(ws + OFF_KI), (bf16_t*)(ws + OFF_CU), (bf16_t*)(ws + OFF_GB), (float*)(ws + OFF_WI), (const float*)(ws + OFF_COS), (const float*)(ws + OFF_SIN), (unsigned char*)(ws + OFF_K8), (unsigned char*)(ws + OFF_QI8), (unsigned char*)(ws + OFF_KI8), (unsigned char*)(ws + OFF_V8)};
        pg8::gemm_phase<EpiProj, pg8::StaticOrder, true, true>(lds, g, S, E); }
    SEAM(4);
    if (IN(5)) {
        conv_phase((const bf16_t*)(ws + OFF_CU), (const bf16_t*)(ws + OFF_GB), a.convw, (bf16_t*)(ws + OFF_YCV), blockIdx.x * 512 + tid, G * 512);
#ifdef DBG_SKIP_ATTN
        for (int it = blockIdx.x * 512 + tid; it < NREAL * 64; it += G * 512) *(u32x4*)((bf16_t*)(ws + OFF_ATT) + (size_t)it * 8) = (u32x4){0u, 0u, 0u, 0u};
#else
        attn_phase((const bf16_t*)(ws + OFF_QS), (const bf16_t*)(ws + OFF_QI8), (const bf16_t*)(ws + OFF_V8), (const bf16_t*)(ws + OFF_KI8), (const float*)(ws + OFF_WI), (bf16_t*)(ws + OFF_ATT), (const unsigned char*)(ws + OFF_K8), lds, wave, lane);
#ifdef PROBE_ATTN2
        attn_phase((const bf16_t*)(ws + OFF_QS), (const bf16_t*)(ws + OFF_QI8), (const bf16_t*)(ws + OFF_V8), (const bf16_t*)(ws + OFF_KI8), (const float*)(ws + OFF_WI), (bf16_t*)(ws + OFF_ATT), (const unsigned char*)(ws + OFF_K8), lds, wave, lane);
#endif
#endif
    }
    SEAM(5);
    if (IN(6)) {
        bf16_t* S1 = (bf16_t*)(ws + OFF_S1); bf16_t* S2 = (bf16_t*)(ws + OFF_S2);
#ifdef DBG_E1_M
        pg8::StaticOrder S; S.init(DBG_E1_M, 1024, G, (int)blockIdx.x);
        { pg8::Gemm g{AB, (const bf16_t*)(ws + OFF_WGA), DBG_E1_M, 1024, 1024};
#else
        pg8::StaticOrder S; S.init(NREAL, 1024, G, (int)blockIdx.x);
        { pg8::Gemm g{AB, (const bf16_t*)(ws + OFF_WGA), NREAL, 1024, 1024};
#endif
 EpiGate<0> E{S1, nullptr}; pg8::gemm_phase<EpiGate<0>, pg8::StaticOrder, true, true>(lds, g, S, E); }
#ifndef DBG_NO_E3
        { pg8::Gemm g{AB, (const bf16_t*)(ws + OFF_WGC), NREAL, 1024, 1024}; EpiGate<0> E{S2, nullptr}; pg8::gemm_phase<EpiGate<0>, pg8::StaticOrder, true, true>(lds, g, S, E); }
#endif
    }
    if (IN(6)) {
        bf16_t* S1 = (bf16_t*)(ws + OFF_S1);
        pg8::StaticOrder S; S.init(NREAL, 1024, G, (int)blockIdx.x);
        pg8::Gemm g{(const bf16_t*)(ws + OFF_ATT), (const bf16_t*)(ws + OFF_WAO), NREAL, 1024, 512}; EpiGate<1> E{S1, nullptr}; pg8::gemm_phase<EpiGate<1>, pg8::StaticOrder, true, true>(lds, g, S, E);
    }
    if (IN(6)) {
        bf16_t* S1 = (bf16_t*)(ws + OFF_S1); bf16_t* S2 = (bf16_t*)(ws + OFF_S2);
        pg8::StaticOrder S; S.init(NREAL, 1024, G, (int)blockIdx.x);
        pg8::Gemm g{(const bf16_t*)(ws + OFF_YCV), (const bf16_t*)(ws + OFF_WCO), NREAL, 1024, 512}; EpiGate<2> E{S1, S2}; pg8::gemm_phase<EpiGate<2>, pg8::StaticOrder, true, true>(lds, g, S, E);
    }
    SEAM(8);
    if (IN(9)) { pg8::Gemm g{(const bf16_t*)(ws + OFF_S1), (const bf16_t*)(ws + OFF_WO), NREAL, 1024, 1024}; pg8::StaticOrder S; S.init(NREAL, 1024, G, (int)blockIdx.x);
        EpiY E{Y12, 1.0f}; pg8::gemm_phase<EpiY, pg8::StaticOrder, true, true>(lds, g, S, E); }
    SEAM(9);
    if (IN(10)) { lnres_phase<1>(nullptr, nullptr, Y12, a.ln2g, a.ln2b, AB, nullptr, NREAL, gw, NGW, lane); }
    SEAM(10);
    if (IN(11)) { pg8::Gemm g{AB, (const bf16_t*)(ws + OFF_WGU2), NREAL, 5632, 1024}; pg8::StaticOrder S; S.init(NREAL, 5632, G, (int)blockIdx.x);
        EpiSwiglu E{HFF}; pg8::gemm_phase<EpiSwiglu, pg8::StaticOrder, true, true>(lds, g, S, E); }
    SEAM(11);
    if (IN(12)) { pg8::Gemm g{HFF, (const bf16_t*)(ws + OFF_WD2), NREAL, 1024, FF}; pg8::StaticOrder S; S.init(NREAL, 1024, G, (int)blockIdx.x);
        EpiY E{Y3, 0.5f}; pg8::gemm_phase<EpiY, pg8::StaticOrder, true, true>(lds, g, S, E); }
    SEAM(12);
    if (IN(13)) { lnres_phase<2>(nullptr, nullptr, Y3, a.ln3g, a.ln3b, AB, a.out, NREAL, gw, NGW, lane); }
#ifdef DBG_STOP
    if (lo == 100) {
        const int gt = blockIdx.x * 512 + tid, NT = G * 512;
        for (int it = gt; it < NREAL * 256; it += NT) {
            const int row = it >> 8, c4 = (it & 255) * 4; f32x4 v;
#ifdef DBG_DUMP_INPUTS
            if (c4 < 512) { const u32x2 w = *(const u32x2*)(AB + (size_t)row * DM + c4); v = (f32x4){bf_lo(w.x), bf_hi(w.x), bf_lo(w.y), bf_hi(w.y)}; }
            else if (row < 2048) { const u32x2 w = *(const u32x2*)((const bf16_t*)(ws + OFF_WGA) + (size_t)row * 512 + (c4 - 512)); v = (f32x4){bf_lo(w.x), bf_hi(w.x), bf_lo(w.y), bf_hi(w.y)}; }
            else v = (f32x4){0.f, 0.f, 0.f, 0.f};
#else
            if (DBG_STOP == 2 || DBG_STOP == 9) v = *(const f32x4*)(Z + (size_t)row * DM + c4);
            else if (DBG_STOP == 3 || DBG_STOP == 10) { const u32x2 w = *(const u32x2*)(AB + (size_t)row * DM + c4); v = (f32x4){bf_lo(w.x), bf_hi(w.x), bf_lo(w.y), bf_hi(w.y)}; }
            else if (DBG_STOP == 1 || DBG_STOP == 11) { const u32x2 w = *(const u32x2*)(HFF + (size_t)row * FF + c4); v = (f32x4){bf_lo(w.x), bf_hi(w.x), bf_lo(w.y), bf_hi(w.y)}; }
            else if (DBG_STOP == 4) { const bf16_t* src = c4 < 512 ? (const bf16_t*)(ws + OFF_QS) + (size_t)row * 512 + c4 : (const bf16_t*)(ws + OFF_CU) + (size_t)row * 512 + (c4 - 512); const u32x2 w = *(const u32x2*)src; v = (f32x4){bf_lo(w.x), bf_hi(w.x), bf_lo(w.y), bf_hi(w.y)}; }
            else if (DBG_STOP == 5) { const bf16_t* src = c4 < 512 ? (const bf16_t*)(ws + OFF_ATT) + (size_t)row * 512 + c4 : (const bf16_t*)(ws + OFF_YCV) + (size_t)row * 512 + (c4 - 512); const u32x2 w = *(const u32x2*)src; v = (f32x4){bf_lo(w.x), bf_hi(w.x), bf_lo(w.y), bf_hi(w.y)}; }
            else { const u32x2 w = *(const u32x2*)((const bf16_t*)(ws + OFF_S1) + (size_t)row * DM + c4); v = (f32x4){bf_lo(w.x), bf_hi(w.x), bf_lo(w.y), bf_hi(w.y)}; }
#endif
            *(f32x4*)(a.out + (size_t)row * DM + c4) = v;
        }
    }
#endif
#undef IN
#undef SEAM
}

extern "C" void kernel_launch(void* const* d_in, const int* in_sizes, int n_in, void* d_out, int out_size, void* d_ws, size_t ws_size, hipStream_t stream) {
    static int grid = 0;
    if (grid == 0) {
        if (n_in != 19 || in_sizes[0] != NREAL * DM || out_size != NREAL * DM || ws_size < WS_END) {
            fprintf(stderr, "kernel_launch: unexpected shapes (n_in %d, in0 %d, out %d, ws %zu, need %zu); nothing launched\n", n_in, n_in > 0 ? in_sizes[0] : -1, out_size, ws_size, (size_t)WS_END);
            grid = -1; return; }
        int dev = 0, cus = 0, per_cu = 0;
        (void)hipGetDevice(&dev); (void)hipDeviceGetAttribute(&cus, hipDeviceAttributeMultiprocessorCount, dev);
        (void)hipFuncSetAttribute((const void*)mk_fwd, hipFuncAttributeMaxDynamicSharedMemorySize, LDS_BYTES);
        (void)hipOccupancyMaxActiveBlocksPerMultiprocessor(&per_cu, (const void*)mk_fwd, NWAVES * 64, LDS_BYTES);
        if (per_cu < 1) { fprintf(stderr, "kernel_launch: occupancy query says %d blocks per CU\n", per_cu); per_cu = 1; }
        (void)hipGetLastError();
        grid = cus;
    }
    if (grid < 0) return;
    Args a{};
    a.x = (const float*)d_in[0]; a.meta = (const float*)d_in[1];
    a.f1g = (const float*)d_in[2]; a.f1u = (const float*)d_in[3]; a.f1d = (const float*)d_in[4]; a.ln1g = (const float*)d_in[5]; a.ln1b = (const float*)d_in[6];
    a.win = (const float*)d_in[7]; a.convw = (const float*)d_in[8]; a.wao = (const float*)d_in[9]; a.wco = (const float*)d_in[10]; a.wo = (const float*)d_in[11];
    a.ln2g = (const float*)d_in[12]; a.ln2b = (const float*)d_in[13]; a.f2g = (const float*)d_in[14]; a.f2u = (const float*)d_in[15]; a.f2d = (const float*)d_in[16];
    a.ln3g = (const float*)d_in[17]; a.ln3b = (const float*)d_in[18];
    a.out = (float*)d_out; a.ws = (unsigned char*)d_ws;
    (void)hipMemsetAsync((char*)d_ws + OFF_CTL, 0, SZ_CTL, stream);
#if ONE_LAUNCH
    a.ph_lo = 0; a.ph_hi = NPH;
    void* kargs[] = {&a};
    hipError_t e = hipLaunchCooperativeKernel((const void*)mk_fwd, dim3(grid), dim3(NWAVES * 64), kargs, LDS_BYTES, stream);
    if (e != hipSuccess) fprintf(stderr, "cooperative launch failed: %s (grid %d)\n", hipGetErrorString(e), grid);
#else
#ifdef DBG_STOP
    for (int ph = 0; ph <= DBG_STOP; ++ph) {
        a.ph_lo = ph; a.ph_hi = ph + 1;
        hipLaunchKernelGGL(mk_fwd, dim3(grid), dim3(NWAVES * 64), LDS_BYTES, stream, a);
    }
    a.ph_lo = 100; a.ph_hi = 101;
    hipLaunchKernelGGL(mk_fwd, dim3(grid), dim3(NWAVES * 64), LDS_BYTES, stream, a);
#else
    for (int ph = 0; ph < NPH; ++ph) {
        a.ph_lo = ph; a.ph_hi = ph + 1;
        hipLaunchKernelGGL(mk_fwd, dim3(grid), dim3(NWAVES * 64), LDS_BYTES, stream, a);
    }
#endif
#endif
}
```

```cpp
#define ONE_LAUNCH 1
#include <hip/hip_runtime.h>
#include <hip/hip_cooperative_groups.h>
#include <cstdio>
#include <cstdint>
#include <cmath>
namespace pg8 {
#define PG8_LAS __attribute__((address_space(3)))
typedef unsigned short bf16_t;
typedef short bf16x8 __attribute__((ext_vector_type(8)));
typedef float f32x4 __attribute__((ext_vector_type(4)));
typedef unsigned u32x4 __attribute__((ext_vector_type(4)));
constexpr int BM = 256, BK = 64, HALF = 128, HTB = HALF * BK * 2  , STAGE_BYTES = 8 * HTB, NXCD = 8, WGM = 8;

__host__ __device__ __forceinline__ int lds_byte(int r, int c) { const int st = (r >> 4) * 2 + (c >> 5), rr = r & 15, cc = c & 31, ob = rr * 64 + cc * 2; return st * 1024 + (ob ^ (((ob >> 9) & 1) << 5)); }
__host__ __device__ __forceinline__ void stage_rc(int b, int& R, int& C) { const int st = b / 1024, sb = b % 1024, swz = sb ^ (((sb >> 9) & 1) << 5); R = (st >> 1) * 16 + swz / 64; C = (st & 1) * 32 + (swz % 64) / 2; }
__host__ __device__ __forceinline__ int perm32(int rho) { const int n = rho >> 4, i = rho & 15; return 8 * (i >> 2) + 4 * n + (i & 3); }

struct Unit { int pm, pn; };
struct Gemm { const bf16_t* A; const bf16_t* Bt; int M, N, K; };

struct StaticOrder {
    int nM, nN, nwg, G, c;
    __host__ __device__ void init(int M, int N, int G_, int c_) { nM = M / BM; nN = N / BM; nwg = nM * nN; G = G_; c = c_; }
    __host__ __device__ bool next(int i, Unit& u) const {
        const long L = (long)i * G + c; if (L >= nwg) return false;
        int wgid = (int)L; { const int q = nwg / NXCD, r = nwg % NXCD, xcd = wgid % NXCD, off = wgid / NXCD; wgid = (xcd < r ? xcd * (q + 1) : r * (q + 1) + (xcd - r) * q) + off; }
        const int nig = WGM * nN, gid = wgid / nig, fm = gid * WGM, gsz = (nM - fm) < WGM ? (nM - fm) : WGM;
        u.pm = fm + ((wgid % nig) % gsz); u.pn = (wgid % nig) / gsz; return true;
    }
    __device__ __forceinline__ void a_ready(const Unit&) const {}
    __device__ __forceinline__ void done(const Unit&) const {}
};

__device__ __forceinline__ unsigned cvt_pk_bf16(float lo, float hi) { unsigned r; asm volatile("v_cvt_pk_bf16_f32 %0, %1, %2" : "=v"(r) : "v"(lo), "v"(hi)); return r; }
template <class Epi, class Sched, bool ALIGN_EPI = false, bool SP2 = false>
__device__ __forceinline__ void gemm_phase(PG8_LAS unsigned char* lds, const Gemm g, const Sched& S, const Epi& E) {
    const int tid = threadIdx.x, wid = __builtin_amdgcn_readfirstlane(tid >> 6), lane = tid & 63, wr = wid >> 2, wc = wid & 3, fr = lane & 15, fq = lane >> 4;
    const int K = g.K, nt = K / BK;
    unsigned voffA[2], voffB[2];
#pragma unroll
    for (int i = 0; i < 2; ++i) { int R, C; stage_rc(tid * 16 + i * 8192, R, C); const int Rb = Epi::PERM ? ((R & ~31) + perm32(R & 31)) : R;
        voffA[i] = (unsigned)(R * K + C) * 2u; voffB[i] = (unsigned)(Rb * K + C) * 2u; }
    const size_t kstep = (size_t)(BK * 2);
    const size_t hstep = (size_t)HALF * K * 2;
    const size_t tstep = 2 * hstep;
    const unsigned ldsw = (unsigned)wid * 1024u;
    const int aoff = lds_byte(wr * 64 + fr, fq * 8), boff = lds_byte(wc * 32 + fr, fq * 8);
#define PG8_SA(b, h) (((b) * 2 + (h)) * HTB)
#define PG8_SB(b, h) ((4 + (b) * 2 + (h)) * HTB)
#define PG8_STAGE(bufoff, gbase, voff) do { _Pragma("unroll") for (int _i = 0; _i < 2; ++_i) \
        __builtin_amdgcn_global_load_lds((const unsigned*)((const char*)(gbase) + (voff)[_i]), (PG8_LAS unsigned*)(lds + (bufoff) + ldsw + _i * 8192), 16, 0, 0); } while (0)
#define PG8_LDA(dst, b, h) do { _Pragma("unroll") for (int m = 0; m < 4; ++m) _Pragma("unroll") for (int k = 0; k < 2; ++k) dst[m][k] = *(const PG8_LAS bf16x8*)(lds + PG8_SA(b, h) + aoff + m * 2048 + k * 1024); } while (0)
#define PG8_LDB(dst, b, h) do { _Pragma("unroll") for (int n = 0; n < 2; ++n) _Pragma("unroll") for (int k = 0; k < 2; ++k) dst[n][k] = *(const PG8_LAS bf16x8*)(lds + PG8_SB(b, h) + boff + n * 2048 + k * 1024); } while (0)
#define PG8_MMA(ai, bj, At, Bt) do { __builtin_amdgcn_s_setprio(1); _Pragma("unroll") for (int m = 0; m < 4; ++m) _Pragma("unroll") for (int n = 0; n < 2; ++n) _Pragma("unroll") for (int k = 0; k < 2; ++k) \
        acc[ai][bj][m][n] = __builtin_amdgcn_mfma_f32_16x16x32_bf16(Bt[n][k], At[m][k], acc[ai][bj][m][n], 0, 0, 0); __builtin_amdgcn_s_setprio(0); } while (0)
#define PG8_WAIT_V(n) asm volatile("s_waitcnt vmcnt(" #n ")" ::: "memory")
#define PG8_WAIT_L(n) asm volatile("s_waitcnt lgkmcnt(" #n ")" ::: "memory")
#define PG8_BAR __builtin_amdgcn_s_barrier()
#define PG8_SCHED __builtin_amdgcn_sched_barrier(0)
    Unit cur, nxt; int ui = 0;
    if (!S.next(0, cur)) return;
    f32x4 acc[2][2][4][2];
#pragma unroll
    for (int a = 0; a < 2; ++a)
#pragma unroll
        for (int b = 0; b < 2; ++b)
#pragma unroll
            for (int m = 0; m < 4; ++m)
#pragma unroll
                for (int n = 0; n < 2; ++n) acc[a][b][m][n] = (f32x4){0.f, 0.f, 0.f, 0.f};
    bf16x8 At[4][2], B0[2][2], B1[2][2];
    const char* cA = (const char*)g.A + (size_t)cur.pm * tstep; const char* cB = (const char*)g.Bt + (size_t)cur.pn * tstep;
    S.a_ready(cur);
    if constexpr (SP2) {
        PG8_STAGE(PG8_SB(0, 0), cB, voffB); PG8_STAGE(PG8_SB(0, 1), cB + hstep, voffB); PG8_STAGE(PG8_SA(0, 0), cA, voffA); PG8_STAGE(PG8_SA(0, 1), cA + hstep, voffA);
        if (wr == 1) PG8_BAR;
        PG8_WAIT_V(2); PG8_BAR;
        PG8_STAGE(PG8_SB(1, 0), cB + kstep, voffB); PG8_STAGE(PG8_SA(1, 0), cA + kstep, voffA); PG8_STAGE(PG8_SB(1, 1), cB + hstep + kstep, voffB);
        PG8_WAIT_V(6); PG8_BAR;
    } else {
        PG8_STAGE(PG8_SB(0, 0), cB, voffB); PG8_STAGE(PG8_SA(0, 0), cA, voffA); PG8_STAGE(PG8_SB(0, 1), cB + hstep, voffB); PG8_STAGE(PG8_SA(0, 1), cA + hstep, voffA);
        if (wr == 1) PG8_BAR;
        PG8_WAIT_V(4); PG8_BAR;
        PG8_STAGE(PG8_SB(1, 0), cB + kstep, voffB); PG8_STAGE(PG8_SA(1, 0), cA + kstep, voffA); PG8_STAGE(PG8_SB(1, 1), cB + hstep + kstep, voffB);
        PG8_WAIT_V(6); PG8_BAR;
    }
    for (;;) {
        const bool has_next = S.next(ui + 1, nxt);
        const char* nA = has_next ? (const char*)g.A + (size_t)nxt.pm * tstep : cA; const char* nB = has_next ? (const char*)g.Bt + (size_t)nxt.pn * tstep : cB;
        for (int t = 0; t < nt; t += 2) {
            const bool last = (t == nt - 2);
            const char* a1 = cA + (size_t)(t + 1) * kstep;
            const char* a2 = last ? nA : cA + (size_t)(t + 2) * kstep; const char* b2 = last ? nB : cB + (size_t)(t + 2) * kstep;
            const char* a3 = a2 + kstep; const char* b3 = b2 + kstep;
            if (last && has_next) S.a_ready(nxt);
            if constexpr (SP2) {
            PG8_LDB(B0, 0, 0); PG8_LDB(B1, 0, 1); PG8_SCHED; PG8_LDA(At, 0, 0); PG8_STAGE(PG8_SA(1, 1), a1 + hstep, voffA);
            PG8_WAIT_V(8); PG8_WAIT_L(0); PG8_BAR; PG8_MMA(0, 0, At, B0); PG8_MMA(0, 1, At, B1); PG8_BAR; PG8_SCHED;
            PG8_LDA(At, 0, 1); PG8_STAGE(PG8_SB(0, 0), b2, voffB); PG8_STAGE(PG8_SB(0, 1), b2 + hstep, voffB); PG8_STAGE(PG8_SA(0, 0), a2, voffA);
            PG8_WAIT_V(8); PG8_WAIT_L(0); PG8_BAR; PG8_MMA(1, 0, At, B0); PG8_MMA(1, 1, At, B1); PG8_BAR; PG8_SCHED;
            PG8_LDB(B0, 1, 0); PG8_LDB(B1, 1, 1); PG8_SCHED; PG8_LDA(At, 1, 0); PG8_STAGE(PG8_SA(0, 1), a2 + hstep, voffA);
            PG8_WAIT_V(8); PG8_WAIT_L(0); PG8_BAR; PG8_MMA(0, 0, At, B0); PG8_MMA(0, 1, At, B1); PG8_BAR; PG8_SCHED;
            PG8_LDA(At, 1, 1); PG8_STAGE(PG8_SB(1, 0), b3, voffB); PG8_STAGE(PG8_SB(1, 1), b3 + hstep, voffB); PG8_STAGE(PG8_SA(1, 0), a3, voffA);
            PG8_WAIT_V(8); PG8_WAIT_L(0); PG8_BAR; PG8_MMA(1, 0, At, B0); PG8_MMA(1, 1, At, B1); PG8_BAR; PG8_SCHED;
            } else {
            PG8_LDB(B0, 0, 0); PG8_SCHED; PG8_LDA(At, 0, 0); PG8_STAGE(PG8_SA(1, 1), a1 + hstep, voffA);
            PG8_WAIT_L(8); PG8_BAR; PG8_WAIT_L(0); PG8_MMA(0, 0, At, B0); PG8_BAR; PG8_SCHED;
            PG8_LDB(B1, 0, 1); PG8_STAGE(PG8_SB(0, 0), b2, voffB);
            PG8_BAR; PG8_WAIT_L(0); PG8_MMA(0, 1, At, B1); PG8_BAR;
            PG8_LDA(At, 0, 1); PG8_STAGE(PG8_SA(0, 0), a2, voffA);
            PG8_BAR; PG8_WAIT_L(0); PG8_MMA(1, 0, At, B0); PG8_BAR; PG8_SCHED;
            PG8_STAGE(PG8_SB(0, 1), b2 + hstep, voffB);
            PG8_WAIT_V(6); PG8_BAR; PG8_MMA(1, 1, At, B1); PG8_BAR;
            PG8_LDB(B0, 1, 0); PG8_SCHED; PG8_LDA(At, 1, 0); PG8_STAGE(PG8_SA(0, 1), a2 + hstep, voffA);
            PG8_WAIT_L(8); PG8_BAR; PG8_WAIT_L(0); PG8_MMA(0, 0, At, B0); PG8_BAR; PG8_SCHED;
            PG8_LDB(B1, 1, 1); PG8_STAGE(PG8_SB(1, 0), b3, voffB);
            PG8_BAR; PG8_WAIT_L(0); PG8_MMA(0, 1, At, B1); PG8_BAR;
            PG8_LDA(At, 1, 1); PG8_STAGE(PG8_SA(1, 0), a3, voffA);
            PG8_BAR; PG8_WAIT_L(0); PG8_MMA(1, 0, At, B0); PG8_BAR; PG8_SCHED;
            PG8_STAGE(PG8_SB(1, 1), b3 + hstep, voffB);
            PG8_WAIT_V(6); PG8_BAR; PG8_MMA(1, 1, At, B1); PG8_BAR;
            }
        }
        if constexpr (ALIGN_EPI) { if (wr == 0) PG8_BAR; }
        if constexpr (!Epi::AFTER_DRAIN) { E(acc, cur, wr, wc, fr, fq); S.done(cur); }
        if (!has_next) break;
#pragma unroll
        for (int a = 0; a < 2; ++a)
#pragma unroll
            for (int b = 0; b < 2; ++b)
#pragma unroll
                for (int m = 0; m < 4; ++m)
#pragma unroll
                    for (int n = 0; n < 2; ++n) acc[a][b][m][n] = (f32x4){0.f, 0.f, 0.f, 0.f};
        cur = nxt; cA = nA; cB = nB; ++ui;
        if constexpr (ALIGN_EPI) { if (wr == 1) PG8_BAR; }
    }
    PG8_WAIT_V(0);
    if constexpr (!ALIGN_EPI) { if (wr == 0) PG8_BAR; }
    PG8_BAR;
    if constexpr (Epi::AFTER_DRAIN) { E.fused(acc, cur, wr, wc, fr, fq, lds, wid, lane); S.done(cur); }
#undef PG8_SA
#undef PG8_SB
#undef PG8_STAGE
#undef PG8_LDA
#undef PG8_LDB
#undef PG8_MMA
#undef PG8_WAIT_V
#undef PG8_WAIT_L
#undef PG8_BAR
#undef PG8_SCHED
}
}

#define LAS __attribute__((address_space(3)))
typedef unsigned short bf16_t;
typedef short bf16x8 __attribute__((ext_vector_type(8)));
typedef short s16x4 __attribute__((ext_vector_type(4)));
typedef float f32x4 __attribute__((ext_vector_type(4)));
typedef float f32x16 __attribute__((ext_vector_type(16)));
typedef unsigned u32x4 __attribute__((ext_vector_type(4)));
typedef unsigned u32x2 __attribute__((ext_vector_type(2)));

constexpr int NB = 8, SEQ = 8192, NMETA = 16, DM = 1024, FF = 2816;
constexpr int NREAL = NB * SEQ;
constexpr int MROWS = NREAL + 256;
constexpr float ALPHA = 1.189207115002721f;
constexpr float LN_EPS = 1e-5f;
constexpr int NWAVES = 8;
constexpr int LDS_BYTES = 147456 + 16384;
constexpr int LDS_BST = 7 * 18432 + 16512;
constexpr int CAND_CAP = 1024;
constexpr int WREG = 18432;
constexpr int NPH = 14;
#ifndef ONE_LAUNCH
#define ONE_LAUNCH 1
#endif

constexpr size_t SZ_ROPE = (size_t)8208 * 32 * 4;
constexpr size_t OFF_CTL = 0, SZ_CTL = 16384;
constexpr size_t OFF_COS = SZ_CTL, OFF_SIN = OFF_COS + SZ_ROPE;
constexpr size_t OFF_ST1 = OFF_SIN + SZ_ROPE, SZ_ST = (size_t)MROWS * 8;
constexpr size_t OFF_ST2 = OFF_ST1 + SZ_ST;
constexpr size_t OFF_WGU1 = OFF_ST2 + SZ_ST, SZ_WGU = (size_t)5632 * 1024 * 2;
constexpr size_t OFF_WD1 = OFF_WGU1 + SZ_WGU, SZ_WD = (size_t)1024 * 2816 * 2;
constexpr size_t OFF_WGU2 = OFF_WD1 + SZ_WD;
constexpr size_t OFF_WD2 = OFF_WGU2 + SZ_WGU;
constexpr size_t OFF_WIN = OFF_WD2 + SZ_WD, SZ_WIN = (size_t)3072 * 1024 * 2;
constexpr size_t OFF_WGA = OFF_WIN + SZ_WIN, SZ_W1K = (size_t)1024 * 1024 * 2;
constexpr size_t OFF_WGC = OFF_WGA + SZ_W1K;
constexpr size_t OFF_WO = OFF_WGC + SZ_W1K;
constexpr size_t OFF_WAO = OFF_WO + SZ_W1K, SZ_W512 = (size_t)1024 * 512 * 2;
constexpr size_t OFF_WCO = OFF_WAO + SZ_W512;
constexpr size_t OFF_AB = OFF_WCO + SZ_W512, SZ_AB = (size_t)MROWS * 1024 * 2;
constexpr size_t OFF_Z = OFF_AB + SZ_AB, SZ_Z = (size_t)MROWS * 1024 * 4;
constexpr size_t OFF_BIG = OFF_Z + SZ_Z, SZ_BIG = (size_t)MROWS * 2816 * 2;
constexpr size_t OFF_QS = OFF_BIG, SZ_R512 = (size_t)MROWS * 512 * 2;
constexpr size_t OFF_QI = OFF_QS + SZ_R512;
constexpr size_t OFF_KV = OFF_QI + SZ_R512;
constexpr size_t OFF_KI = OFF_KV + (size_t)MROWS * 256 * 2;
constexpr size_t OFF_WI = OFF_KI + (size_t)MROWS * 64 * 2;
constexpr size_t OFF_CU = OFF_WI + (size_t)MROWS * 8 * 4;
constexpr size_t OFF_GB = OFF_CU + SZ_R512;
constexpr size_t OFF_K8 = OFF_GB + SZ_R512;
constexpr size_t OFF_QI8 = OFF_K8 + (size_t)MROWS * 128;
constexpr size_t OFF_KI8 = OFF_QI8 + (size_t)MROWS * 512;
constexpr size_t OFF_V8 = OFF_KI8 + (size_t)MROWS * 64;
static_assert(OFF_V8 + (size_t)MROWS * 128 <= OFF_BIG + SZ_BIG, "mixer tensors overlay the FFN hidden buffer");
constexpr size_t OFF_S1 = OFF_BIG, OFF_S2 = OFF_BIG + (size_t)NREAL * 1024 * 2;
static_assert(OFF_S2 + (size_t)NREAL * 1024 * 2 <= OFF_BIG + SZ_BIG, "gate buffers overlay");
constexpr size_t OFF_ATT = OFF_BIG + SZ_BIG, SZ_ATT = (size_t)NREAL * 512 * 2;
constexpr size_t OFF_YCV = OFF_ATT + SZ_ATT;
constexpr size_t WS_END = OFF_YCV + SZ_ATT;

struct Args {
    const float* x; const float* meta;
    const float* f1g; const float* f1u; const float* f1d; const float* ln1g; const float* ln1b;
    const float* win; const float* convw; const float* wao; const float* wco; const float* wo;
    const float* ln2g; const float* ln2b; const float* f2g; const float* f2u; const float* f2d; const float* ln3g; const float* ln3b;
    float* out; unsigned char* ws; int ph_lo, ph_hi;
};

__device__ __forceinline__ unsigned f2bf(float f) { unsigned u = __builtin_bit_cast(unsigned, f); return (u + 0x7fffu + ((u >> 16) & 1u)) >> 16; }
typedef float f32x2_t __attribute__((ext_vector_type(2))); typedef __bf16 bf16x2_t __attribute__((ext_vector_type(2)));
__device__ __forceinline__ unsigned pk2(float lo, float hi) { f32x2_t v = {lo, hi}; bf16x2_t b = __builtin_convertvector(v, bf16x2_t); return __builtin_bit_cast(unsigned, b); }
__device__ __forceinline__ float bf_lo(unsigned w) { return __builtin_bit_cast(float, w << 16); }
__device__ __forceinline__ float bf_hi(unsigned w) { return __builtin_bit_cast(float, w & 0xffff0000u); }
__device__ __forceinline__ unsigned pk4_fp8(float a, float b_, float c, float d) { int w = __builtin_amdgcn_cvt_pk_fp8_f32(a, b_, 0, false); w = __builtin_amdgcn_cvt_pk_fp8_f32(c, d, w, true); return (unsigned)w; }
#define LDS_WAIT() asm volatile("s_waitcnt lgkmcnt(0)" ::: "memory")
__device__ __forceinline__ float wave_sum(float v) {
#pragma unroll
    for (int o = 1; o < 64; o <<= 1) v += __shfl_xor(v, o);
    return v;
}

struct EpiSwiglu {
    static constexpr bool PERM = true, AFTER_DRAIN = false;
    bf16_t* H;
    __device__ __forceinline__ void operator()(const f32x4 (&acc)[2][2][4][2], const pg8::Unit& u, int wr, int wc, int fr, int fq) const {
        const int row0 = u.pm * 256 + wr * 64 + fr, col0 = u.pn * 128 + wc * 32 + 8 * fq;
#pragma unroll
        for (int ai = 0; ai < 2; ++ai)
#pragma unroll
            for (int m = 0; m < 4; ++m) {
                bf16_t* rowp = H + (size_t)(row0 + ai * 128 + m * 16) * FF + col0;
                float h[8];
#pragma unroll
                for (int n = 0; n < 2; ++n)
#pragma unroll
                    for (int i = 0; i < 4; ++i) {
                        const float g = acc[ai][0][m][n][i], up = acc[ai][1][m][n][i];
                        const float e = __builtin_amdgcn_exp2f(-g * 1.4426950408889634f);
                        h[4 * n + i] = g * __builtin_amdgcn_rcpf(1.0f + e) * up;
                    }
                u32x4 w; w.x = pk2(h[0], h[1]); w.y = pk2(h[2], h[3]); w.z = pk2(h[4], h[5]); w.w = pk2(h[6], h[7]);
                *(u32x4*)rowp = w;
            }
    }
};

template <int MODE> struct EpiResid {
    static constexpr bool PERM = false, AFTER_DRAIN = false;
    const float* x; const float* meta; const float* zin; const float* stats; const float* g; const float* bta; float* zout; float scale;
    __device__ __forceinline__ void operator()(const f32x4 (&acc)[2][2][4][2], const pg8::Unit& u, int wr, int wc, int fr, int fq) const {
        const int col0 = u.pn * 256 + wc * 32 + 4 * fq;
#pragma unroll
        for (int ai = 0; ai < 2; ++ai)
#pragma unroll
            for (int m = 0; m < 4; ++m) {
                const int row = u.pm * 256 + ai * 128 + wr * 64 + m * 16 + fr;
                const float* src; float mean = 0.f, rstd = 1.f; bool have = true;
                if (MODE == 0) { src = row < NREAL ? x + (size_t)row * DM : meta + (size_t)((row - NREAL) & 15) * DM; have = row < NREAL + NMETA; }
                else { src = zin + (size_t)row * DM; mean = stats[2 * row]; rstd = stats[2 * row + 1]; }
#pragma unroll
                for (int bj = 0; bj < 2; ++bj)
#pragma unroll
                    for (int n = 0; n < 2; ++n) {
                        const int c = col0 + bj * 128 + n * 16;
                        f32x4 hv = *(const f32x4*)(src + c);
                        if (MODE == 0) { if (!have) hv = (f32x4){0.f, 0.f, 0.f, 0.f}; }
                        else { const f32x4 gv = *(const f32x4*)(g + c), bv = *(const f32x4*)(bta + c); hv = (hv - mean) * rstd * gv + bv; }
                        const f32x4 o = hv * ALPHA + acc[ai][bj][m][n] * scale;
                        *(f32x4*)(zout + (size_t)row * DM + c) = o;
                    }
                asm volatile("" ::: "memory");
            }
    }
};

template <int MODE> struct EpiGate {
    static constexpr bool PERM = true, AFTER_DRAIN = false;
    bf16_t* P; const bf16_t* Q;
    __device__ __forceinline__ void operator()(const f32x4 (&acc)[2][2][4][2], const pg8::Unit& u, int wr, int wc, int fr, int fq) const {
        const int col0 = u.pn * 256 + wc * 32 + 8 * fq;
#pragma unroll
        for (int ai = 0; ai < 2; ++ai)
#pragma unroll
            for (int m = 0; m < 4; ++m) {
                const int row = u.pm * 256 + ai * 128 + wr * 64 + m * 16 + fr;
#pragma unroll
                for (int bj = 0; bj < 2; ++bj) {
                    const size_t off = (size_t)row * DM + col0 + bj * 128;
                    float v[8];
#pragma unroll
                    for (int n = 0; n < 2; ++n)
#pragma unroll
                        for (int i = 0; i < 4; ++i) v[4 * n + i] = acc[ai][bj][m][n][i];
                    if (MODE == 0) {
#pragma unroll
                        for (int i = 0; i < 8; ++i) v[i] = __builtin_amdgcn_rcpf(1.0f + __builtin_amdgcn_exp2f(-v[i] * 1.4426950408889634f));
                    } else {
                        const u32x4 pw = *(const u32x4*)(P + off);
                        float p[8] = {bf_lo(pw.x), bf_hi(pw.x), bf_lo(pw.y), bf_hi(pw.y), bf_lo(pw.z), bf_hi(pw.z), bf_lo(pw.w), bf_hi(pw.w)};
                        if (MODE == 1) {
#pragma unroll
                            for (int i = 0; i < 8; ++i) v[i] = p[i] * v[i];
                        } else {
                            const u32x4 qw = *(const u32x4*)(Q + off);
                            float q[8] = {bf_lo(qw.x), bf_hi(qw.x), bf_lo(qw.y), bf_hi(qw.y), bf_lo(qw.z), bf_hi(qw.z), bf_lo(qw.w), bf_hi(qw.w)};
#pragma unroll
                            for (int i = 0; i < 8; ++i) v[i] = p[i] + q[i] * v[i];
                        }
                    }
                    u32x4 w; w.x = pk2(v[0], v[1]); w.y = pk2(v[2], v[3]); w.z = pk2(v[4], v[5]); w.w = pk2(v[6], v[7]);
                    *(u32x4*)(P + off) = w;
                }
                asm volatile("" ::: "memory");
            }
    }
};

struct EpiY {
    static constexpr bool PERM = true, AFTER_DRAIN = false;
    bf16_t* Y; float scale;
    __device__ __forceinline__ void operator()(const f32x4 (&acc)[2][2][4][2], const pg8::Unit& u, int wr, int wc, int fr, int fq) const {
        const int col0 = u.pn * 256 + wc * 32 + 8 * fq;
#pragma unroll
        for (int ai = 0; ai < 2; ++ai)
#pragma unroll
            for (int m = 0; m < 4; ++m) {
                const int row = u.pm * 256 + ai * 128 + wr * 64 + m * 16 + fr;
#pragma unroll
                for (int bj = 0; bj < 2; ++bj) {
                    const f32x4 a0 = acc[ai][bj][m][0] * scale, a1 = acc[ai][bj][m][1] * scale;
                    u32x4 w; w.x = pk2(a0[0], a0[1]); w.y = pk2(a0[2], a0[3]); w.z = pk2(a1[0], a1[1]); w.w = pk2(a1[2], a1[3]);
                    *(u32x4*)(Y + (size_t)row * DM + col0 + bj * 128) = w;
                }
            }
    }
};

struct EpiProj {
    static constexpr bool PERM = true, AFTER_DRAIN = false;
    bf16_t *QS, *QI, *KV, *KI, *CU, *GB; float* WI; const float* cosT; const float* sinT; unsigned char* K8; unsigned char* QI8; unsigned char* KI8; unsigned char* V8;
    __device__ __forceinline__ void rope_store_k8(const f32x4 (&acc)[2][2][4][2], int ai, int m, int pos, int fq, unsigned char* dst) const {
        const f32x4 c0 = *(const f32x4*)(cosT + pos * 32 + 8 * fq), c1 = *(const f32x4*)(cosT + pos * 32 + 8 * fq + 4);
        const f32x4 s0 = *(const f32x4*)(sinT + pos * 32 + 8 * fq), s1 = *(const f32x4*)(sinT + pos * 32 + 8 * fq + 4);
        const f32x4 a0 = acc[ai][0][m][0], a1 = acc[ai][0][m][1], b0 = acc[ai][1][m][0], b1 = acc[ai][1][m][1];
        const f32x4 lo0 = a0 * c0 - b0 * s0, lo1 = a1 * c1 - b1 * s1, hi0 = b0 * c0 + a0 * s0, hi1 = b1 * c1 + a1 * s1;
        u32x2 w; w.x = pk4_fp8(lo0[0], lo0[1], lo0[2], lo0[3]); w.y = pk4_fp8(lo1[0], lo1[1], lo1[2], lo1[3]); *(u32x2*)dst = w;
        w.x = pk4_fp8(hi0[0], hi0[1], hi0[2], hi0[3]); w.y = pk4_fp8(hi1[0], hi1[1], hi1[2], hi1[3]); *(u32x2*)(dst + 32) = w;
    }
    __device__ __forceinline__ void rope_store(const f32x4 (&acc)[2][2][4][2], int ai, int m, int pos, int fq, bf16_t* dst, float sc) const {
        const f32x4 c0 = *(const f32x4*)(cosT + pos * 32 + 8 * fq), c1 = *(const f32x4*)(cosT + pos * 32 + 8 * fq + 4);
        const f32x4 s0 = *(const f32x4*)(sinT + pos * 32 + 8 * fq), s1 = *(const f32x4*)(sinT + pos * 32 + 8 * fq + 4);
        const f32x4 a0 = acc[ai][0][m][0] * sc, a1 = acc[ai][0][m][1] * sc, b0 = acc[ai][1][m][0] * sc, b1 = acc[ai][1][m][1] * sc;
        const f32x4 lo0 = a0 * c0 - b0 * s0, lo1 = a1 * c1 - b1 * s1, hi0 = b0 * c0 + a0 * s0, hi1 = b1 * c1 + a1 * s1;
        u32x4 w; w.x = pk2(lo0[0], lo0[1]); w.y = pk2(lo0[2], lo0[3]); w.z = pk2(lo1[0], lo1[1]); w.w = pk2(lo1[2], lo1[3]);
        *(u32x4*)dst = w;
        w.x = pk2(hi0[0], hi0[1]); w.y = pk2(hi0[2], hi0[3]); w.z = pk2(hi1[0], hi1[1]); w.w = pk2(hi1[2], hi1[3]);
        *(u32x4*)(dst + 32) = w;
    }
    __device__ __forceinline__ void operator()(const f32x4 (&acc)[2][2][4][2], const pg8::Unit& u, int wr, int wc, int fr, int fq) const {
        const int pn = u.pn;
#pragma unroll
        for (int ai = 0; ai < 2; ++ai)
#pragma unroll
            for (int m = 0; m < 4; ++m) {
                const int row = u.pm * 256 + ai * 128 + wr * 64 + m * 16 + fr;
                const int pos = row < NREAL ? NMETA + (row & (SEQ - 1)) : (row - NREAL);
                if (pn < 2) {
                    rope_store(acc, ai, m, pos, fq, QS + (size_t)row * 512 + (4 * pn + wc) * 64 + 8 * fq, 0.125f);
                } else if (pn == 2) {
                    if (wc < 2) rope_store_k8(acc, ai, m, pos, fq, K8 + (size_t)row * 128 + wc * 64 + 8 * fq);
                    else {
#pragma unroll
                        for (int bj = 0; bj < 2; ++bj) {
                            const f32x4 a0 = acc[ai][bj][m][0], a1 = acc[ai][bj][m][1];
                            u32x2 w; w.x = pk4_fp8(a0[0], a0[1], a0[2], a0[3]); w.y = pk4_fp8(a1[0], a1[1], a1[2], a1[3]);
                            *(u32x2*)(V8 + (size_t)row * 128 + bj * 64 + (wc - 2) * 32 + 8 * fq) = w;
                        }
                    }
                } else if (pn < 5) {
                    rope_store_k8(acc, ai, m, pos, fq, QI8 + (size_t)row * 512 + (4 * (pn - 3) + wc) * 64 + 8 * fq);
                } else if (pn == 5) {
                    if (wc == 0) rope_store_k8(acc, ai, m, pos, fq, KI8 + (size_t)row * 64 + 8 * fq);
                    else if (wc == 1 && fq == 0) {
                        const float sc = 0.04419417382415922f;
                        *(f32x4*)(WI + (size_t)row * 8) = acc[ai][0][m][0] * sc;
                        *(f32x4*)(WI + (size_t)row * 8 + 4) = acc[ai][0][m][1] * sc;
                    }
                } else if (pn < 10) {
                    const f32x4 a0 = acc[ai][0][m][0] * acc[ai][1][m][0], a1 = acc[ai][0][m][1] * acc[ai][1][m][1];
                    u32x4 w; w.x = pk2(a0[0], a0[1]); w.y = pk2(a0[2], a0[3]); w.z = pk2(a1[0], a1[1]); w.w = pk2(a1[2], a1[3]);
                    *(u32x4*)(CU + (size_t)row * 512 + (pn - 6) * 128 + wc * 32 + 8 * fq) = w;
                } else {
#pragma unroll
                    for (int bj = 0; bj < 2; ++bj) {
                        const f32x4 a0 = acc[ai][bj][m][0], a1 = acc[ai][bj][m][1];
                        u32x4 w; w.x = pk2(a0[0], a0[1]); w.y = pk2(a0[2], a0[3]); w.z = pk2(a1[0], a1[1]); w.w = pk2(a1[2], a1[3]);
                        *(u32x4*)(GB + (size_t)row * 512 + (pn - 10) * 256 + bj * 128 + wc * 32 + 8 * fq) = w;
                    }
                }
                if (m & 1) asm volatile("" ::: "memory");
            }
    }
};

__device__ __forceinline__ void tr_item(const float* W, int N, int n0, int nvalid, int k0, bf16_t* WT, int K, int drow0, LAS float* scr, int lane) {
    const int nn4 = (lane & 7) * 4;
    f32x4 tv[8];
#pragma unroll
    for (int i = 0; i < 8; ++i) { const int kk = 8 * i + (lane >> 3); tv[i] = (f32x4){0.f, 0.f, 0.f, 0.f}; if (nn4 < nvalid) tv[i] = *(const f32x4*)(W + (size_t)(k0 + kk) * N + n0 + nn4); }
#pragma unroll
    for (int i = 0; i < 8; ++i) { const int kk = 8 * i + (lane >> 3);
#pragma unroll
        for (int j = 0; j < 4; ++j) scr[kk * 33 + nn4 + j] = tv[i][j]; }
    LDS_WAIT();
    const int c = lane & 7;
#pragma unroll
    for (int j = 0; j < 4; ++j) { const int n = (lane >> 3) + 8 * j; const LAS float* s = scr + (8 * c) * 33 + n;
        u32x4 o; o.x = pk2(s[0 * 33], s[1 * 33]); o.y = pk2(s[2 * 33], s[3 * 33]); o.z = pk2(s[4 * 33], s[5 * 33]); o.w = pk2(s[6 * 33], s[7 * 33]);
        *(u32x4*)(WT + (size_t)(drow0 + n) * K + k0 + 8 * c) = o; }
    LDS_WAIT();
}
__device__ __forceinline__ void win_group(int G, int& n0, int& nvalid) {
    const int pn = G >> 3, bj = (G >> 2) & 1, xg = G & 3; nvalid = 32;
    if (pn < 2) n0 = (pn * 4 + xg) * 64 + bj * 32;
    else if (pn == 2) { if (xg < 2) n0 = 512 + xg * 64 + bj * 32; else n0 = 640 + bj * 64 + (xg - 2) * 32; }
    else if (pn < 5) n0 = 768 + ((pn - 3) * 4 + xg) * 64 + bj * 32;
    else if (pn == 5) { if (xg == 0) n0 = 1280 + bj * 32; else if (xg == 1 && bj == 0) { n0 = 1344; nvalid = 8; } else { n0 = 0; nvalid = 0; } }
    else if (pn < 10) n0 = (bj ? 2376 : 1352) + (pn - 6) * 128 + 32 * xg;
    else n0 = 1864 + (pn - 10) * 256 + bj * 128 + 32 * xg;
}
__device__ __forceinline__ void p0_prologue(const Args& a, LAS unsigned char* lds, int gw, int NGW, int wave, int lane, int parts) {
    unsigned char* ws = a.ws;
    LAS float* scr = (LAS float*)(lds + wave * 16384);
    constexpr int I_GU = 176 * 16, I_D = 32 * 44, I_IN = 96 * 16, I_1K = 32 * 16, I_512 = 32 * 8;
    constexpr int NITEMS = 2 * I_GU + 2 * I_D + I_IN + 3 * I_1K + 2 * I_512;
    if (parts & 1)
    for (int it = gw; it < NITEMS; it += NGW) {
        int r = it;
        if (r < 2 * I_GU) { const int which = r / I_GU; r -= which * I_GU; const int kb = r / 176, G = r % 176, pn = G >> 3, bj = (G >> 2) & 1, xg = G & 3;
            const float* W = which ? (bj ? a.f2u : a.f2g) : (bj ? a.f1u : a.f1g);
            tr_item(W, FF, 128 * pn + 32 * xg, 32, 64 * kb, (bf16_t*)(ws + (which ? OFF_WGU2 : OFF_WGU1)), 1024, 32 * G, scr, lane); continue; }
        r -= 2 * I_GU;
        if (r < 2 * I_D) { const int which = r / I_D; r -= which * I_D; const int kb = r / 32, G = r % 32;
            tr_item(which ? a.f2d : a.f1d, 1024, 32 * G, 32, 64 * kb, (bf16_t*)(ws + (which ? OFF_WD2 : OFF_WD1)), FF, 32 * G, scr, lane); continue; }
        r -= 2 * I_D;
        if (r < I_IN) { const int kb = r / 96, G = r % 96; int n0, nv; win_group(G, n0, nv);
            tr_item(a.win, 4936, n0, nv, 64 * kb, (bf16_t*)(ws + OFF_WIN), 1024, 32 * G, scr, lane); continue; }
        r -= I_IN;
        if (r < I_1K) { const int kb = r / 32, G = r % 32; tr_item(a.win, 4936, 2888 + 32 * G, 32, 64 * kb, (bf16_t*)(ws + OFF_WGA), 1024, 32 * G, scr, lane); continue; }
        r -= I_1K;
        if (r < I_1K) { const int kb = r / 32, G = r % 32; tr_item(a.win, 4936, 3912 + 32 * G, 32, 64 * kb, (bf16_t*)(ws + OFF_WGC), 1024, 32 * G, scr, lane); continue; }
        r -= I_1K;
        if (r < I_1K) { const int kb = r / 32, G = r % 32; tr_item(a.wo, 1024, 32 * G, 32, 64 * kb, (bf16_t*)(ws + OFF_WO), 1024, 32 * G, scr, lane); continue; }
        r -= I_1K;
        if (r < I_512) { const int kb = r / 32, G = r % 32; tr_item(a.wao, 1024, 32 * G, 32, 64 * kb, (bf16_t*)(ws + OFF_WAO), 512, 32 * G, scr, lane); continue; }
        r -= I_512;
        { const int kb = r / 32, G = r % 32; tr_item(a.wco, 1024, 32 * G, 32, 64 * kb, (bf16_t*)(ws + OFF_WCO), 512, 32 * G, scr, lane); }
    }
    bf16_t* AB = (bf16_t*)(ws + OFF_AB);
    if (parts & 2)
    for (int row0 = gw; row0 < MROWS; row0 += 4 * NGW) {
        f32x4 hv[4][4];
#pragma unroll
        for (int r = 0; r < 4; ++r) { const int row = row0 + r * NGW;
            if (row < MROWS) { const float* src = row < NREAL ? a.x + (size_t)row * DM : a.meta + (size_t)((row - NREAL) & 15) * DM;
#pragma unroll
                for (int j = 0; j < 4; ++j) hv[r][j] = *(const f32x4*)(src + 256 * j + 4 * lane); } }
#pragma unroll
        for (int r = 0; r < 4; ++r) { const int row = row0 + r * NGW;
            if (row < MROWS) { const bool have = row < NREAL + NMETA;
#pragma unroll
                for (int j = 0; j < 4; ++j) { f32x4 v = hv[r][j]; if (!have) v = (f32x4){0.f, 0.f, 0.f, 0.f};
                    u32x2 w; w.x = pk2(v[0], v[1]); w.y = pk2(v[2], v[3]);
                    *(u32x2*)(AB + (size_t)row * DM + 256 * j + 4 * lane) = w; } } }
    }
    float* cosT = (float*)(ws + OFF_COS); float* sinT = (float*)(ws + OFF_SIN);
    if (parts & 4)
    for (int idx = gw * 64 + lane; idx < 8208 * 32; idx += NGW * 64) {
        const int pos = idx >> 5, f = idx & 31;
        double fr = 1.0; for (int i = 0; i < f; ++i) fr *= 0.7498942093324559;
        const float inv = (float)fr;
        const float angf = (float)pos * inv;
        const double ang = (double)angf;
        const double k = __builtin_rint(ang * 0.6366197723675814);
        double rr = __builtin_fma(-k, 1.5707963267948966, ang); rr = __builtin_fma(-k, 6.123233995736766e-17, rr);
        const double r2 = rr * rr;
        double sp = -1.0 / 6227020800.0; sp = sp * r2 + 1.0 / 39916800.0; sp = sp * r2 - 1.0 / 362880.0; sp = sp * r2 + 1.0 / 5040.0; sp = sp * r2 - 1.0 / 120.0; sp = sp * r2 + 1.0 / 6.0;
        const double sn = rr - rr * r2 * sp;
        double cp = 1.0 / 87178291200.0; cp = cp * r2 - 1.0 / 479001600.0; cp = cp * r2 + 1.0 / 3628800.0; cp = cp * r2 - 1.0 / 40320.0; cp = cp * r2 + 1.0 / 720.0; cp = cp * r2 - 1.0 / 24.0; cp = cp * r2 + 0.5;
        const double cs = 1.0 - r2 * cp;
        const int q = ((int)k) & 3;
        const double sv = (q == 0) ? sn : (q == 1) ? cs : (q == 2) ? -sn : -cs;
        const double cv = (q == 0) ? cs : (q == 1) ? -sn : (q == 2) ? -cs : sn;
        cosT[idx] = (float)cv; sinT[idx] = (float)sv;
    }
}

template <int MODE> __device__ __forceinline__ void skinny_meta(const bf16_t* A, int lda, const bf16_t* Bt, int K, int ntask, int gw, int NGW, int lane,
                                                                bf16_t* HFF, float* Z, const float* meta, bf16_t* KV, bf16_t* KI, bf16_t* CU, const float* cosT, const float* sinT) {
    const int fr = lane & 15, fq = lane >> 4;
    for (int task = gw; task < ntask; task += NGW) {
        int pn, x0;
        if (MODE == 0) { pn = task >> 3; x0 = (task & 7) * 16; }
        else if (MODE == 1) { pn = 0; x0 = task * 16; }
        else { if (task < 8) { pn = 2; x0 = task * 16; } else if (task < 10) { pn = 5; x0 = (task - 8) * 16; } else { pn = 6 + ((task - 10) >> 3); x0 = ((task - 10) & 7) * 16; } }
        const int r0 = (MODE == 1) ? x0 + fr : 256 * pn + x0 + fr;
        const bf16_t* ap = A + (size_t)fr * lda + 8 * fq;
        const bf16_t* b0 = Bt + (size_t)r0 * K + 8 * fq;
        const bf16_t* b1 = b0 + (size_t)128 * K;
        f32x4 acc0 = {0.f, 0.f, 0.f, 0.f}, acc1 = {0.f, 0.f, 0.f, 0.f};
#pragma unroll 8
        for (int k = 0; k < K; k += 32) {
            const bf16x8 a = *(const bf16x8*)(ap + k), x = *(const bf16x8*)(b0 + k);
            acc0 = __builtin_amdgcn_mfma_f32_16x16x32_bf16(a, x, acc0, 0, 0, 0);
            if (MODE != 1) { const bf16x8 y = *(const bf16x8*)(b1 + k); acc1 = __builtin_amdgcn_mfma_f32_16x16x32_bf16(a, y, acc1, 0, 0, 0); }
        }
#pragma unroll
        for (int i = 0; i < 4; ++i) {
            const int m = 4 * fq + i; const size_t row = (size_t)(NREAL + m); const int x = x0 + fr;
            const float a0 = acc0[i], a1 = acc1[i];
            if (MODE == 0) {
                const float e = __builtin_amdgcn_exp2f(-a0 * 1.4426950408889634f);
                HFF[row * FF + 128 * pn + x] = (bf16_t)f2bf(a0 * __builtin_amdgcn_rcpf(1.0f + e) * a1);
            } else if (MODE == 1) {
                HFF[row * DM + x] = (bf16_t)f2bf(0.5f * a0);
            } else {
                if (pn == 2) {
                    if (x < 64) { const int d = x & 31; const float c = cosT[m * 32 + d], s = sinT[m * 32 + d]; unsigned char* K8m = (unsigned char*)HFF;
                        const float lo = a0 * c - a1 * s, hi = a1 * c + a0 * s;
                        K8m[row * 128 + (x >> 5) * 64 + d] = (unsigned char)(pk4_fp8(lo, lo, lo, lo) & 0xffu); K8m[row * 128 + (x >> 5) * 64 + 32 + d] = (unsigned char)(pk4_fp8(hi, hi, hi, hi) & 0xffu); }
                    else { unsigned char* V8m = (unsigned char*)KV;
                        V8m[row * 128 + (x - 64)] = (unsigned char)(pk4_fp8(a0, a0, a0, a0) & 0xffu); V8m[row * 128 + 64 + (x - 64)] = (unsigned char)(pk4_fp8(a1, a1, a1, a1) & 0xffu); }
                } else if (pn == 5) {
                    const float c = cosT[m * 32 + x], s = sinT[m * 32 + x]; unsigned char* KI8m = (unsigned char*)KI;
                    const float lo = a0 * c - a1 * s, hi = a1 * c + a0 * s;
                    KI8m[row * 64 + x] = (unsigned char)(pk4_fp8(lo, lo, lo, lo) & 0xffu); KI8m[row * 64 + 32 + x] = (unsigned char)(pk4_fp8(hi, hi, hi, hi) & 0xffu);
                } else {
                    CU[row * 512 + (pn - 6) * 128 + x] = (bf16_t)f2bf(a0 * a1);
                }
            }
        }
    }
}

template <bool FINAL> __device__ __forceinline__ void ln_phase(const float* z, const float* g, const float* bta, bf16_t* hb, float* stats, float* outf, int nrows, int gw, int NGW, int lane) {
    f32x4 gv[4], bv[4];
#pragma unroll
    for (int j = 0; j < 4; ++j) { gv[j] = *(const f32x4*)(g + 256 * j + 4 * lane); bv[j] = *(const f32x4*)(bta + 256 * j + 4 * lane); }
    f32x4 v[4], nv[4];
    if (gw < nrows) {
#pragma unroll
        for (int j = 0; j < 4; ++j) v[j] = *(const f32x4*)(z + (size_t)gw * DM + 256 * j + 4 * lane);
    }
    for (int row = gw; row < nrows; row += NGW) {
        float s = 0.f;
#pragma unroll
        for (int j = 0; j < 4; ++j) s += (v[j][0] + v[j][1]) + (v[j][2] + v[j][3]);
        const int nrow = row + NGW;
        if (nrow < nrows) {
#pragma unroll
            for (int j = 0; j < 4; ++j) nv[j] = *(const f32x4*)(z + (size_t)nrow * DM + 256 * j + 4 * lane);
        }
        const float mean = wave_sum(s) * (1.f / DM); float s2 = 0.f;
#pragma unroll
        for (int j = 0; j < 4; ++j) { v[j] = v[j] - mean; s2 += (v[j][0] * v[j][0] + v[j][1] * v[j][1]) + (v[j][2] * v[j][2] + v[j][3] * v[j][3]); }
        const float rstd = 1.f / sqrtf(wave_sum(s2) * (1.f / DM) + LN_EPS);
#pragma unroll
        for (int j = 0; j < 4; ++j) {
            const f32x4 y = v[j] * rstd * gv[j] + bv[j];
            if (FINAL) *(f32x4*)(outf + (size_t)row * DM + 256 * j + 4 * lane) = y;
            else { u32x2 w; w.x = pk2(y[0], y[1]); w.y = pk2(y[2], y[3]); *(u32x2*)(hb + (size_t)row * DM + 256 * j + 4 * lane) = w; }
        }
#pragma unroll
        for (int j = 0; j < 4; ++j) v[j] = nv[j];
        if (!FINAL && lane == 0) { stats[2 * row] = mean; stats[2 * row + 1] = rstd; }
    }
}

template <int MODE> __device__ __forceinline__ void lnres_phase(const float* x, const float* meta, const bf16_t* Y, const float* g, const float* bta, bf16_t* hb, float* outf, int nrows, int gw, int NGW, int lane) {
    f32x4 gv[4], bv[4];
#pragma unroll
    for (int j = 0; j < 4; ++j) { gv[j] = *(const f32x4*)(g + 256 * j + 4 * lane); bv[j] = *(const f32x4*)(bta + 256 * j + 4 * lane); }
    f32x4 v[4], nv[4]; u32x2 yv[4], nyv[4];
#define LNR_LOAD(dv, dy, row) do { \
        if (MODE == 0) { const float* src_ = (row) < NREAL ? x + (size_t)(row) * DM : meta + (size_t)(((row) - NREAL) & 15) * DM; \
            _Pragma("unroll") for (int j = 0; j < 4; ++j) dv[j] = *(const f32x4*)(src_ + 256 * j + 4 * lane); } \
        else { _Pragma("unroll") for (int j = 0; j < 4; ++j) { const u32x2 p_ = *(const u32x2*)(hb + (size_t)(row) * DM + 256 * j + 4 * lane); dv[j] = (f32x4){bf_lo(p_.x), bf_hi(p_.x), bf_lo(p_.y), bf_hi(p_.y)}; } } \
        _Pragma("unroll") for (int j = 0; j < 4; ++j) dy[j] = *(const u32x2*)(Y + (size_t)(row) * DM + 256 * j + 4 * lane); } while (0)
    if (gw < nrows) LNR_LOAD(v, yv, gw);
    for (int row = gw; row < nrows; row += NGW) {
        float s = 0.f;
#pragma unroll
        for (int j = 0; j < 4; ++j) { const f32x4 yy = {bf_lo(yv[j].x), bf_hi(yv[j].x), bf_lo(yv[j].y), bf_hi(yv[j].y)}; v[j] = v[j] * ALPHA + yy; s += (v[j][0] + v[j][1]) + (v[j][2] + v[j][3]); }
        const int nrow = row + NGW;
        if (nrow < nrows) LNR_LOAD(nv, nyv, nrow);
        const float mean = wave_sum(s) * (1.f / DM); float s2 = 0.f;
#pragma unroll
        for (int j = 0; j < 4; ++j) { v[j] = v[j] - mean; s2 += (v[j][0] * v[j][0] + v[j][1] * v[j][1]) + (v[j][2] * v[j][2] + v[j][3] * v[j][3]); }
        const float rstd = 1.f / sqrtf(wave_sum(s2) * (1.f / DM) + LN_EPS);
#pragma unroll
        for (int j = 0; j < 4; ++j) {
            const f32x4 y = v[j] * rstd * gv[j] + bv[j];
            if (MODE == 2) *(f32x4*)(outf + (size_t)row * DM + 256 * j + 4 * lane) = y;
            else { u32x2 w; w.x = pk2(y[0], y[1]); w.y = pk2(y[2], y[3]); *(u32x2*)(hb + (size_t)row * DM + 256 * j + 4 * lane) = w; }
        }
#pragma unroll
        for (int j = 0; j < 4; ++j) { v[j] = nv[j]; yv[j] = nyv[j]; }
    }
#undef LNR_LOAD
}

__device__ __forceinline__ void conv_phase(const bf16_t* CU, const bf16_t* GB, const float* cw, bf16_t* YCV, int gtid, int NT) {
    for (int it = gtid; it < NREAL * 64; it += NT) {
        const int row = it >> 6, c8 = (it & 63) * 8, s = row & (SEQ - 1);
        const size_t r0 = (size_t)row, r1 = s >= 1 ? (size_t)(row - 1) : (size_t)(NREAL + 15), r2 = s >= 2 ? (size_t)(row - 2) : (size_t)(NREAL + 14 + s);
        const u32x4 x0 = *(const u32x4*)(CU + r0 * 512 + c8), x1 = *(const u32x4*)(CU + r1 * 512 + c8), x2 = *(const u32x4*)(CU + r2 * 512 + c8), gb = *(const u32x4*)(GB + r0 * 512 + c8);
        float o[8];
#pragma unroll
        for (int h = 0; h < 4; ++h) {
            const unsigned a0 = h == 0 ? x0.x : h == 1 ? x0.y : h == 2 ? x0.z : x0.w, a1 = h == 0 ? x1.x : h == 1 ? x1.y : h == 2 ? x1.z : x1.w, a2 = h == 0 ? x2.x : h == 1 ? x2.y : h == 2 ? x2.z : x2.w, gg = h == 0 ? gb.x : h == 1 ? gb.y : h == 2 ? gb.z : gb.w;
            const int c = c8 + 2 * h;
            o[2 * h] = bf_lo(gg) * (cw[c] * bf_lo(a2) + cw[512 + c] * bf_lo(a1) + cw[1024 + c] * bf_lo(a0));
            o[2 * h + 1] = bf_hi(gg) * (cw[c + 1] * bf_hi(a2) + cw[512 + c + 1] * bf_hi(a1) + cw[1024 + c + 1] * bf_hi(a0));
        }
        u32x4 w; w.x = pk2(o[0], o[1]); w.y = pk2(o[2], o[3]); w.z = pk2(o[4], o[5]); w.w = pk2(o[6], o[7]);
        *(u32x4*)(YCV + r0 * 512 + c8) = w;
    }
}

__device__ __forceinline__ float relu_i(float x) { const int i = __builtin_bit_cast(int, x); return __builtin_bit_cast(float, i > 0 ? i : 0); }
__device__ __forceinline__ size_t seqrow(int b, int idx) { return idx < NMETA ? (size_t)(NREAL + idx) : (size_t)(b * SEQ + idx - NMETA); }

__device__ __forceinline__ void find_bin(LAS unsigned* hist, unsigned need, int lane, unsigned& bin, unsigned& above) {
    const u32x4 h = *(const LAS u32x4*)(hist + 252 - 4 * lane);
    const unsigned tot = h.x + h.y + h.z + h.w;
    unsigned incl = tot;
#pragma unroll
    for (int o = 1; o < 64; o <<= 1) { const unsigned t = __shfl_up(incl, o); if (lane >= o) incl += t; }
    const unsigned excl = incl - tot;
    const bool found = excl < need && need <= incl;
    unsigned a = excl, bsel = 0, asel = 0;
    if (a + h.w >= need) { bsel = 255 - 4 * lane; asel = a; }
    else { a += h.w; if (a + h.z >= need) { bsel = 254 - 4 * lane; asel = a; } else { a += h.z; if (a + h.y >= need) { bsel = 253 - 4 * lane; asel = a; } else { a += h.y; bsel = 252 - 4 * lane; asel = a; } } }
    const unsigned long long bal = __ballot(found);
    const int src = bal ? (int)__builtin_ctzll(bal) : 0;
    bin = (unsigned)__shfl((int)bsel, src); above = (unsigned)__shfl((int)asel, src);
}

__device__ __forceinline__ void attn_phase(const bf16_t* QS, const bf16_t* QI, const bf16_t* KV, const bf16_t* KI, const float* WI, bf16_t* ATT, const unsigned char* K8,
                                           LAS unsigned char* lds, int wave, int lane) {
    const int c32 = lane & 31, hi = lane >> 5, fr = lane & 15, fq = lane >> 4;
    LAS unsigned char* myreg = lds + wave * WREG;
    LAS unsigned short* myrow = (LAS unsigned short*)myreg;
    LAS unsigned* hist = (LAS unsigned*)(myreg + 16640);
    LAS unsigned short* list = (LAS unsigned short*)(myreg + 16640 + 1024);
    LAS unsigned char* vimg = myreg;
    LAS bf16_t* obuf = (LAS bf16_t*)(myreg);
    const int G = gridDim.x, cb = blockIdx.x;
    *(LAS u32x4*)(hist + 4 * lane) = (u32x4){0u, 0u, 0u, 0u};
    LDS_WAIT();
    __syncthreads();
    for (int p = cb; p < 4096; p += G) {
        const int b = p >> 9, pidx = p & 511;
#pragma unroll 1
        for (int half = 0; half < 2; ++half) {
            const int sblk = half ? 1023 - pidx : pidx, s0 = sblk * 8;
            const int rq0 = b * SEQ + s0;
            {
                const unsigned char* QI8 = (const unsigned char*)QI; const unsigned char* KI8 = (const unsigned char*)KI;
                u32x4 qa[4];
#pragma unroll
                for (int mt = 0; mt < 4; ++mt) qa[mt] = *(const u32x4*)(QI8 + (size_t)(rq0 + 2 * mt + (fr >> 3)) * 512 + (fr & 7) * 64 + 16 * fq);
                f32x4 wv[4];
#pragma unroll
                for (int mt = 0; mt < 4; ++mt) wv[mt] = *(const f32x4*)(WI + (size_t)(rq0 + 2 * mt + (fq >> 1)) * 8 + 4 * (fq & 1));
                const int nmax = NMETA + s0 + 8, ntile = (nmax + 15) >> 4;
                const int qa_ = 2 * (fq & 1) + (fq >> 1);
                asm volatile("" : "+v"(qa[0]), "+v"(qa[1]), "+v"(qa[2]), "+v"(qa[3]), "+v"(wv[0]), "+v"(wv[1]), "+v"(wv[2]), "+v"(wv[3]) :: "memory");
#define S1_LOAD(dst, tt) do { const int kk_ = 16 * (tt) + fr, kld_ = kk_ < nmax ? kk_ : nmax - 1; const unsigned char* kp_ = KI8 + seqrow(b, kld_) * 64 + 16 * fq; \
        asm volatile("global_load_dwordx4 %0, %1, off" : "=&v"(dst) : "v"(kp_) : "memory"); } while (0)
#define S1_WAIT(nn, dst) asm volatile("s_waitcnt vmcnt(" #nn ")" : "+v"(dst) :: "memory")
#define S1_TILE(kbv, tt) do { const int kk = 16 * (tt) + fr; float part_[4]; \
        const long kb0_ = (long)(((unsigned long long)kbv.y << 32) | kbv.x), kb1_ = (long)(((unsigned long long)kbv.w << 32) | kbv.z); \
        _Pragma("unroll") for (int mt = 0; mt < 4; ++mt) { f32x4 acc_ = {0.f, 0.f, 0.f, 0.f}; \
            acc_ = __builtin_amdgcn_mfma_f32_16x16x32_fp8_fp8((long)(((unsigned long long)qa[mt].y << 32) | qa[mt].x), kb0_, acc_, 0, 0, 0); \
            acc_ = __builtin_amdgcn_mfma_f32_16x16x32_fp8_fp8((long)(((unsigned long long)qa[mt].w << 32) | qa[mt].z), kb1_, acc_, 0, 0, 0); \
            const f32x4 w_ = wv[mt]; float p_ = 0.f; \
            _Pragma("unroll") for (int i = 0; i < 4; ++i) p_ = __builtin_fmaf(w_[i], relu_i(acc_[i]), p_); \
            part_[mt] = p_; } \
        _Pragma("unroll") for (int pr = 0; pr < 2; ++pr) { \
            auto rr_ = __builtin_amdgcn_permlane16_swap(__builtin_bit_cast(unsigned, part_[2 * pr]), __builtin_bit_cast(unsigned, part_[2 * pr + 1]), false, false); \
            const float tot_ = __builtin_bit_cast(float, (unsigned)rr_[0]) + __builtin_bit_cast(float, (unsigned)rr_[1]); \
            const int q = 4 * pr + qa_; const _Float16 hh = (_Float16)tot_; const unsigned hb = (unsigned)__builtin_bit_cast(unsigned short, hh); \
            unsigned key = (hb & 0x8000u) ? (~hb & 0xffffu) : (hb | 0x8000u); \
            const bool valid = kk <= NMETA + s0 + q; if (!valid) key = 0u; \
            *(LAS unsigned short*)(lds + q * WREG + kk * 2) = (unsigned short)key; \
            __hip_atomic_fetch_add((LAS unsigned*)(lds + q * WREG + 16640) + (key >> 8), valid ? 1u : 0u, __ATOMIC_RELAXED, __HIP_MEMORY_SCOPE_WORKGROUP); } } while (0)
                u32x4 kr0, kr1, kr2, kr3, kr4, kr5, kr6, kr7;
                S1_LOAD(kr0, wave); S1_LOAD(kr1, wave + NWAVES); S1_LOAD(kr2, wave + 2 * NWAVES); S1_LOAD(kr3, wave + 3 * NWAVES);
                S1_LOAD(kr4, wave + 4 * NWAVES); S1_LOAD(kr5, wave + 5 * NWAVES); S1_LOAD(kr6, wave + 6 * NWAVES); S1_LOAD(kr7, wave + 7 * NWAVES);
#define S1_STEP(kr, off) do { S1_WAIT(7, kr); if (t + (off) * NWAVES < ntile) { S1_TILE(kr, t + (off) * NWAVES); } S1_LOAD(kr, t + ((off) + 8) * NWAVES); } while (0)
                for (int t = wave; t < ntile; t += 8 * NWAVES) {
                    S1_STEP(kr0, 0); S1_STEP(kr1, 1); S1_STEP(kr2, 2); S1_STEP(kr3, 3); S1_STEP(kr4, 4); S1_STEP(kr5, 5); S1_STEP(kr6, 6); S1_STEP(kr7, 7);
                }
                S1_WAIT(0, kr0); S1_WAIT(0, kr1); S1_WAIT(0, kr2); S1_WAIT(0, kr3); S1_WAIT(0, kr4); S1_WAIT(0, kr5); S1_WAIT(0, kr6); S1_WAIT(0, kr7);
#undef S1_STEP
#undef S1_LOAD
#undef S1_WAIT
#undef S1_TILE
            }
            LDS_WAIT();
            __syncthreads();
            const int n = NMETA + s0 + wave + 1;
            const int cnt = n < 256 ? n : 256;
            if (n <= 256) {
#pragma unroll
                for (int i = 0; i < 4; ++i) { const int s = i * 64 + lane; list[s] = (unsigned short)(s < n ? s : 0); }
                LDS_WAIT();
                *(LAS u32x4*)(hist + 4 * lane) = (u32x4){0u, 0u, 0u, 0u};
            } else {
                unsigned b1, ab1; find_bin(hist, 256u, lane, b1, ab1);
                const unsigned c1 = hist[b1];
                if (c1 <= (unsigned)CAND_CAP) {
                    LAS unsigned short* cand = (LAS unsigned short*)(lds + 147456 + wave * 2048);
                    const unsigned need2 = 256u - ab1;
                    LDS_WAIT();
                    *(LAS u32x4*)(hist + 4 * lane) = (u32x4){0u, 0u, 0u, 0u};
                    const int nit8 = (n + 511) >> 9;
                    unsigned sel_cnt = 0, cand_cnt = 0;
                    u32x4 kwm = *(const LAS u32x4*)(myrow + 8 * lane);
                    for (int it = 0; it < nit8; ++it) {
                        const int i0 = 8 * (64 * it + lane);
                        const u32x4 kw = kwm;
                        kwm = *(const LAS u32x4*)(myrow + i0 + 512);
                        const unsigned k[8] = {kw.x & 0xffffu, kw.x >> 16, kw.y & 0xffffu, kw.y >> 16, kw.z & 0xffffu, kw.z >> 16, kw.w & 0xffffu, kw.w >> 16};
                        bool gt[8], cd[8]; unsigned cg = 0, cc = 0;
#pragma unroll
                        for (int j = 0; j < 8; ++j) { const bool in = i0 + j < n; const unsigned hj = k[j] >> 8; gt[j] = in && hj > b1; cd[j] = in && hj == b1; cg += gt[j] ? 1u : 0u; cc += cd[j] ? 1u : 0u; }
                        const unsigned v = cg | (cc << 16);
                        unsigned incl = v;
                        incl += (unsigned)__builtin_amdgcn_update_dpp(0, (int)incl, 0x111, 0xf, 0xf, false);
                        incl += (unsigned)__builtin_amdgcn_update_dpp(0, (int)incl, 0x112, 0xf, 0xf, false);
                        incl += (unsigned)__builtin_amdgcn_update_dpp(0, (int)incl, 0x114, 0xf, 0xf, false);
                        incl += (unsigned)__builtin_amdgcn_update_dpp(0, (int)incl, 0x118, 0xf, 0xf, false);
                        incl += (unsigned)__builtin_amdgcn_update_dpp(0, (int)incl, 0x142, 0xa, 0xf, false);
                        incl += (unsigned)__builtin_amdgcn_update_dpp(0, (int)incl, 0x143, 0xc, 0xf, false);
                        const unsigned excl = incl - v, tot = (unsigned)__builtin_amdgcn_readlane((int)incl, 63);
                        unsigned ps = sel_cnt + (excl & 0xffffu), pc = cand_cnt + (excl >> 16);
                        if (v != 0u) {
#pragma unroll
                            for (int j = 0; j < 8; ++j) {
                                if (gt[j] && ps < 256u) list[ps] = (unsigned short)(i0 + j);
                                if (cd[j] && pc < (unsigned)CAND_CAP) cand[pc] = (unsigned short)(i0 + j);
                                ps += gt[j] ? 1u : 0u; pc += cd[j] ? 1u : 0u;
                            }
                        }
                        sel_cnt += tot & 0xffffu; cand_cnt += tot >> 16;
                    }
                    LDS_WAIT();
                    for (unsigned i = lane; i < c1; i += 64) { const unsigned key = myrow[cand[i]]; __hip_atomic_fetch_add(hist + (key & 255u), 1u, __ATOMIC_RELAXED, __HIP_MEMORY_SCOPE_WORKGROUP); }
                    LDS_WAIT();
                    unsigned b2, ab2; find_bin(hist, need2, lane, b2, ab2);
                    const unsigned need_eq = need2 - ab2;
                    LDS_WAIT();
                    *(LAS u32x4*)(hist + 4 * lane) = (u32x4){0u, 0u, 0u, 0u};
                    unsigned out_cnt = ab1, eq_cnt = 0;
                    for (unsigned base = 0; base < c1; base += 64) {
                        const unsigned i = base + lane; const bool in = i < c1;
                        const unsigned idx = in ? (unsigned)cand[i] : 0u;
                        const unsigned lo = (unsigned)myrow[idx] & 255u;
                        const bool g2 = in && lo > b2, e2 = in && lo == b2;
                        const unsigned long long eqb = __ballot(e2);
                        const unsigned eq_rank = eq_cnt + __builtin_amdgcn_mbcnt_hi((unsigned)(eqb >> 32), __builtin_amdgcn_mbcnt_lo((unsigned)eqb, 0u));
                        const bool sel = g2 || (e2 && eq_rank < need_eq);
                        const unsigned long long sb = __ballot(sel);
                        const unsigned pos = out_cnt + __builtin_amdgcn_mbcnt_hi((unsigned)(sb >> 32), __builtin_amdgcn_mbcnt_lo((unsigned)sb, 0u));
                        if (sel && pos < 256u) list[pos] = (unsigned short)idx;
                        out_cnt += (unsigned)__popcll(sb); eq_cnt += (unsigned)__popcll(eqb);
                    }
                } else {
                const unsigned need2 = 256u - ab1;
                LDS_WAIT();
                *(LAS u32x4*)(hist + 4 * lane) = (u32x4){0u, 0u, 0u, 0u};
                LDS_WAIT();
                const int nit = (n + 255) >> 8;
                u32x2 kwn = *(const LAS u32x2*)(myrow + 4 * lane);
                for (int it = 0; it < nit; ++it) {
                    const int i0 = 4 * (64 * it + lane);
                    const u32x2 kw = kwn;
                    kwn = *(const LAS u32x2*)(myrow + i0 + 256);
                    const unsigned k0 = kw.x & 0xffffu, k1 = kw.x >> 16, k2 = kw.y & 0xffffu, k3 = kw.y >> 16;
                    if (i0 + 0 < n && (k0 >> 8) == b1) __hip_atomic_fetch_add(hist + (k0 & 255u), 1u, __ATOMIC_RELAXED, __HIP_MEMORY_SCOPE_WORKGROUP);
                    if (i0 + 1 < n && (k1 >> 8) == b1) __hip_atomic_fetch_add(hist + (k1 & 255u), 1u, __ATOMIC_RELAXED, __HIP_MEMORY_SCOPE_WORKGROUP);
                    if (i0 + 2 < n && (k2 >> 8) == b1) __hip_atomic_fetch_add(hist + (k2 & 255u), 1u, __ATOMIC_RELAXED, __HIP_MEMORY_SCOPE_WORKGROUP);
                    if (i0 + 3 < n && (k3 >> 8) == b1) __hip_atomic_fetch_add(hist + (k3 & 255u), 1u, __ATOMIC_RELAXED, __HIP_MEMORY_SCOPE_WORKGROUP);
                }
                LDS_WAIT();
                unsigned b2, ab2; find_bin(hist, need2, lane, b2, ab2);
                const unsigned T = (b1 << 8) | b2, need_eq = need2 - ab2;
                LDS_WAIT();
                *(LAS u32x4*)(hist + 4 * lane) = (u32x4){0u, 0u, 0u, 0u};
                unsigned sel_cnt = 0, eq_cnt = 0;
                u32x2 kwm = *(const LAS u32x2*)(myrow + 4 * lane);
                for (int it = 0; it < nit; ++it) {
                    const int i0 = 4 * (64 * it + lane);
                    const u32x2 kw = kwm;
                    kwm = *(const LAS u32x2*)(myrow + i0 + 256);
                    unsigned k[4] = {kw.x & 0xffffu, kw.x >> 16, kw.y & 0xffffu, kw.y >> 16};
                    unsigned cg = 0, ce = 0;
#pragma unroll
                    for (int j = 0; j < 4; ++j) { if (i0 + j >= n) k[j] = 0u; cg += (k[j] > T) ? 1u : 0u; ce += (k[j] == T) ? 1u : 0u; }
                    const unsigned v = cg | (ce << 16);
                    unsigned incl = v;
                    incl += (unsigned)__builtin_amdgcn_update_dpp(0, (int)incl, 0x111, 0xf, 0xf, false);
                    incl += (unsigned)__builtin_amdgcn_update_dpp(0, (int)incl, 0x112, 0xf, 0xf, false);
                    incl += (unsigned)__builtin_amdgcn_update_dpp(0, (int)incl, 0x114, 0xf, 0xf, false);
                    incl += (unsigned)__builtin_amdgcn_update_dpp(0, (int)incl, 0x118, 0xf, 0xf, false);
                    incl += (unsigned)__builtin_amdgcn_update_dpp(0, (int)incl, 0x142, 0xa, 0xf, false);
                    incl += (unsigned)__builtin_amdgcn_update_dpp(0, (int)incl, 0x143, 0xc, 0xf, false);
                    const unsigned excl = incl - v, tot = (unsigned)__builtin_amdgcn_readlane((int)incl, 63);
                    const unsigned pg = excl & 0xffffu, pe = excl >> 16;
                    const unsigned base_eq = eq_cnt < need_eq ? eq_cnt : need_eq;
                    unsigned r_eq = eq_cnt + pe;
                    unsigned pos = sel_cnt + pg + ((r_eq < need_eq ? r_eq : need_eq) - base_eq);
#pragma unroll
                    for (int j = 0; j < 4; ++j) {
                        const bool gt = k[j] > T, eq = k[j] == T;
                        const bool take = gt || (eq && r_eq < need_eq);
                        if (take && pos < 256u) list[pos] = (unsigned short)(i0 + j);
                        pos += take ? 1u : 0u; r_eq += eq ? 1u : 0u;
                    }
                    const unsigned tg = tot & 0xffffu, te = tot >> 16;
                    const unsigned e1 = eq_cnt + te;
                    sel_cnt += tg + ((e1 < need_eq ? e1 : need_eq) - base_eq); eq_cnt = e1;
                }
                            }
            }
            LDS_WAIT();
#ifdef PROBE_S3X2
            for (int rep3 = 0; rep3 < 2; ++rep3)
#endif
            {
                const int rq = rq0 + wave;
                long qb[4];
                {
                    const bool qv = fr < 8 && (fr >> 2) == (fq >> 1);
                    const bf16_t* qp = QS + (size_t)rq * 512 + (qv ? fr : 0) * 64 + ((32 * fq) & 63);
#pragma unroll
                    for (int s = 0; s < 4; ++s) {
                        const u32x4 w = *(const u32x4*)(qp + 8 * s);
                        const unsigned lo = pk4_fp8(bf_lo(w.x) * 8.f, bf_hi(w.x) * 8.f, bf_lo(w.y) * 8.f, bf_hi(w.y) * 8.f), hi = pk4_fp8(bf_lo(w.z) * 8.f, bf_hi(w.z) * 8.f, bf_lo(w.w) * 8.f, bf_hi(w.w) * 8.f);
                        qb[s] = qv ? (long)(((unsigned long long)hi << 32) | lo) : 0l;
                    }
                }
                const int vR = lane >> 4, vpc = lane & 15;
#define V_DMA(kk) do { _Pragma("unroll") for (int it = 0; it < 4; ++it) { const int rho_ = 8 * it + (lane >> 3), j_ = rho_ & 7, f_ = rho_ >> 3; \
        const int kidx_ = list[32 * (kk) + (j_ < 4 ? 4 * f_ + j_ : 12 + 4 * f_ + j_)]; \
        const unsigned char* gp_ = V8 + seqrow(b, kidx_) * 128 + 16 * ((lane & 7) ^ ((rho_ >> 1) & 7)); \
        __builtin_amdgcn_global_load_lds((const unsigned*)gp_, (LAS unsigned*)(vimg + ((kk) & 3) * 4096 + it * 1024), 16, 0, 0); } } while (0)
#define K_LOAD(dst, t) do { const int kidx_ = list[(t) * 16 + fr]; const unsigned char* kp_ = K8 + seqrow(b, kidx_) * 128 + 32 * fq; \
        dst[0] = *(const u32x4*)kp_; dst[1] = *(const u32x4*)(kp_ + 16); } while (0)
                const unsigned char* V8 = (const unsigned char*)KV;
                V_DMA(0); V_DMA(1); V_DMA(2); V_DMA(3);
                u32x4 ka[8][2];
#pragma unroll
                for (int t = 0; t < 8; ++t) K_LOAD(ka[t], t);
                f32x4 sc[16];
#pragma unroll
                for (int t = 0; t < 16; ++t) {
                    f32x4 acc = {0.f, 0.f, 0.f, 0.f};
#pragma unroll
                    for (int s = 0; s < 4; ++s) { const u32x4 kw_ = ka[t & 7][s >> 1]; const unsigned l_ = (s & 1) ? kw_.z : kw_.x, h_ = (s & 1) ? kw_.w : kw_.y;
                        acc = __builtin_amdgcn_mfma_f32_16x16x32_fp8_fp8((long)(((unsigned long long)h_ << 32) | l_), qb[s], acc, 0, 0, 0); }
                    sc[t] = acc * 0.125f;
                    if (t + 8 < 16) K_LOAD(ka[t & 7], t + 8);
                    __builtin_amdgcn_sched_barrier(0);
                }
#undef K_LOAD
                float mx = -INFINITY;
#pragma unroll
                for (int t = 0; t < 16; ++t)
#pragma unroll
                    for (int i = 0; i < 4; ++i) { if (16 * t + 4 * fq + i >= cnt) sc[t][i] = -INFINITY; mx = fmaxf(mx, sc[t][i]); }
                mx = fmaxf(mx, __shfl_xor(mx, 16)); mx = fmaxf(mx, __shfl_xor(mx, 32));
                float l = 0.f;
#pragma unroll
                for (int t = 0; t < 16; ++t)
#pragma unroll
                    for (int i = 0; i < 4; ++i) { const float e = __builtin_amdgcn_exp2f((sc[t][i] - mx) * 1.4426950408889634f); sc[t][i] = e; l += e; }
                l += __shfl_xor(l, 16); l += __shfl_xor(l, 32);
                long pa[8];
#pragma unroll
                for (int kk = 0; kk < 8; ++kk) { const unsigned lo_ = pk4_fp8(sc[2 * kk][0], sc[2 * kk][1], sc[2 * kk][2], sc[2 * kk][3]), hi_ = pk4_fp8(sc[2 * kk + 1][0], sc[2 * kk + 1][1], sc[2 * kk + 1][2], sc[2 * kk + 1][3]); pa[kk] = (long)(((unsigned long long)hi_ << 32) | lo_); }
                f32x4 o[8];
#pragma unroll
                for (int nt = 0; nt < 8; ++nt) o[nt] = (f32x4){0.f, 0.f, 0.f, 0.f};
                const int vrow = 8 * fq + ((lane & 15) >> 1), vswz = (vrow >> 1) & 7;
                const LAS unsigned char* vb = vimg + vrow * 128 + 8 * (lane & 1);
                typedef int v2i32_t __attribute__((ext_vector_type(2)));
#define PV_STEP(kk) do { \
        if ((kk) <= 4) asm volatile("s_waitcnt vmcnt(12)" ::: "memory"); else if ((kk) == 5) asm volatile("s_waitcnt vmcnt(8)" ::: "memory"); else if ((kk) == 6) asm volatile("s_waitcnt vmcnt(4)" ::: "memory"); else asm volatile("s_waitcnt vmcnt(0)" ::: "memory"); \
        _Pragma("unroll") for (int nt = 0; nt < 8; ++nt) { \
            const v2i32_t vv_ = __builtin_amdgcn_ds_read_tr8_b64_v2i32((LAS v2i32_t*)(vb + ((kk) & 3) * 4096 + ((nt ^ vswz) << 4))); \
            o[nt] = __builtin_amdgcn_mfma_f32_16x16x32_fp8_fp8(pa[kk], (long)(((unsigned long long)(unsigned)vv_[1] << 32) | (unsigned)vv_[0]), o[nt], 0, 0, 0); } \
        LDS_WAIT(); \
        if ((kk) + 4 < 8) V_DMA((kk) + 4); __builtin_amdgcn_sched_barrier(0); } while (0)
                PV_STEP(0); PV_STEP(1); PV_STEP(2); PV_STEP(3); PV_STEP(4); PV_STEP(5); PV_STEP(6); PV_STEP(7);
#undef PV_STEP
#undef V_DMA
                LDS_WAIT();
                float linv[4];
#pragma unroll
                for (int i = 0; i < 4; ++i) linv[i] = 1.0f / __shfl(l, (4 * fq + i) & 7);
#pragma unroll
                for (int nt = 0; nt < 8; ++nt) {
                    if (fq == (nt >> 2)) {
#pragma unroll
                        for (int i = 0; i < 4; ++i) obuf[(4 * fq + i) * 64 + (nt & 3) * 16 + fr] = (bf16_t)f2bf(o[nt][i] * linv[i]);
                    }
                }
                LDS_WAIT();
                const u32x4 ov = *(const LAS u32x4*)((LAS unsigned char*)obuf + lane * 16);
                *(u32x4*)(ATT + (size_t)rq * 512 + lane * 8) = ov;
            }
            LDS_WAIT();
            __syncthreads();
        }
    }
}


#define XB_TMO      128
#define XB_XCNT(j)  (256  + 64 * (j))
#define XB_XSUB(j)  (1280 + 64 * (j))
#define XB_XGEN(j)  (2304 + 64 * (j))
#define XB_TOP      3328
#define XB_TOPGEN   3392
#define XCD_BAR_WORDS 3456
#define XB_SPIN_CAP (1u << 18)

__device__ __forceinline__ unsigned xb_ld(unsigned* p)              { return __hip_atomic_load(p, __ATOMIC_RELAXED, __HIP_MEMORY_SCOPE_AGENT); }
__device__ __forceinline__ unsigned xb_add(unsigned* p, unsigned v) { return __hip_atomic_fetch_add(p, v, __ATOMIC_RELAXED, __HIP_MEMORY_SCOPE_AGENT); }
__device__ __forceinline__ unsigned xb_xcc_id() { return (unsigned)__builtin_amdgcn_s_getreg((3 << 11) | 20) & 0xFu; }
#define XB_SPIN(cond, bar) do { unsigned _sp = 0; while (cond) { __builtin_amdgcn_s_sleep(1); \
    if ((++_sp & 255u) == 0u) { if (xb_ld(&(bar)[XB_TMO])) break; if (_sp > XB_SPIN_CAP) { atomicAdd(&(bar)[XB_TMO], 1u); break; } } } } while (0)

struct XcdBarrier {
    unsigned* bar; unsigned x;
    volatile LAS unsigned* st;
};

__device__ __forceinline__ XcdBarrier xcd_barrier_post(unsigned* bar, volatile LAS unsigned* st) {
    XcdBarrier b; b.bar = bar; b.x = xb_xcc_id(); b.st = st;
    if (threadIdx.x == 0) (void)xb_add(&bar[XB_XCNT(b.x)], 1u);
    return b;
}
__device__ __forceinline__ void xcd_barrier_complete(unsigned* bar, unsigned x, unsigned& nloc, unsigned& nx) {
    const unsigned G = gridDim.x * gridDim.y * gridDim.z;
    unsigned sum, cnt, mine, sp = 0u;
    for (;;) {
        sum = 0u; cnt = 0u; mine = 0u;
#pragma unroll
        for (unsigned j = 0; j < 16; ++j) { const unsigned c = xb_ld(&bar[XB_XCNT(j)]); sum += c; cnt += (c > 0u) ? 1u : 0u; mine = (j == x) ? c : mine; }
        if (sum == G) break;
        __builtin_amdgcn_s_sleep(1);
        if ((++sp & 255u) == 0u) { if (xb_ld(&bar[XB_TMO])) break; if (sp > XB_SPIN_CAP) { atomicAdd(&bar[XB_TMO], 1u); break; } }
    }
    nloc = mine > 0u ? mine : 1u; nx = cnt > 0u ? cnt : 1u;
}

__device__ __forceinline__ void xcd_barrier(const XcdBarrier& b) {
    asm volatile("s_waitcnt vmcnt(0)" ::: "memory");
    __syncthreads();
    if (threadIdx.x == 0) {
        unsigned* bar = b.bar;
        __builtin_amdgcn_s_waitcnt(0);
        unsigned nloc = b.st[0], nx = b.st[1];
        if (nloc == 0u) { xcd_barrier_complete(bar, b.x, nloc, nx); b.st[0] = nloc; b.st[1] = nx; }
        const unsigned old = xb_add(&bar[XB_XSUB(b.x)], 1u);
        const unsigned gen = old / nloc;
        if (old + 1u == (gen + 1u) * nloc) {
            __builtin_amdgcn_fence(__ATOMIC_RELEASE, "agent");
            asm volatile("s_waitcnt vmcnt(0)" ::: "memory");
            const unsigned og = xb_add(&bar[XB_TOP], 1u);
            const unsigned tg = og / nx;
            if (og + 1u == (tg + 1u) * nx) xb_add(&bar[XB_TOPGEN], 1u);
            else XB_SPIN(xb_ld(&bar[XB_TOPGEN]) == tg, bar);
            __builtin_amdgcn_fence(__ATOMIC_ACQUIRE, "agent");
            xb_add(&bar[XB_XGEN(b.x)], 1u);
            asm volatile("s_waitcnt vmcnt(0)" ::: "memory");
        } else {
            XB_SPIN(xb_ld(&bar[XB_XGEN(b.x)]) == gen, bar);
            __builtin_amdgcn_fence(__ATOMIC_ACQUIRE, "agent");
            asm volatile("s_waitcnt vmcnt(0)" ::: "memory");
        }
    }
    __syncthreads();
}

__global__ void __launch_bounds__(NWAVES * 64, 2) mk_fwd(Args a) {
    extern __shared__ __attribute__((aligned(16))) unsigned char lds_raw[];
    LAS unsigned char* lds = (LAS unsigned char*)lds_raw;
    const int tid = threadIdx.x, lane = tid & 63, wave = __builtin_amdgcn_readfirstlane(tid >> 6);
    const int G = gridDim.x, gw = blockIdx.x * NWAVES + wave, NGW = G * NWAVES;
    unsigned char* ws = a.ws;
    bf16_t* AB = (bf16_t*)(ws + OFF_AB); float* Z = (float*)(ws + OFF_Z); bf16_t* HFF = (bf16_t*)(ws + OFF_BIG);
    float* ST1 = (float*)(ws + OFF_ST1); float* ST2 = (float*)(ws + OFF_ST2);
    const int lo = a.ph_lo, hi = a.ph_hi;
    volatile LAS unsigned* bst = (volatile LAS unsigned*)(lds + LDS_BST);
    if (tid < 2) bst[tid] = 0u;
    __syncthreads();
    XcdBarrier gbar = xcd_barrier_post((unsigned*)(ws + OFF_CTL), bst);
#define IN(k) (lo <= (k) && (k) < hi)
#define SEAM(k) do { if (IN(k) && IN((k) + 1)) { if ((k) == 0) cooperative_groups::this_grid().sync(); else xcd_barrier(gbar); } } while (0)

    if (IN(0)) { p0_prologue(a, lds, gw, NGW, wave, lane, 7);
#ifdef PROBE_P0_PARTS
        p0_prologue(a, lds, gw, NGW, wave, lane, PROBE_P0_PARTS);
#endif
 }
    SEAM(0);
#ifdef PROBE_SYNC10
    for (int r_ = 0; r_ < 10; ++r_) cooperative_groups::this_grid().sync();
#endif
    if (IN(1)) { pg8::Gemm g{AB, (const bf16_t*)(ws + OFF_WGU1), NREAL, 5632, 1024}; pg8::StaticOrder S; S.init(NREAL, 5632, G, (int)blockIdx.x);
        EpiSwiglu E{HFF}; pg8::gemm_phase<EpiSwiglu, pg8::StaticOrder, true, true>(lds, g, S, E);
        skinny_meta<0>(AB + (size_t)NREAL * DM, DM, (const bf16_t*)(ws + OFF_WGU1), 1024, 22 * 8, gw, NGW, lane, HFF, nullptr, nullptr, nullptr, nullptr, nullptr, nullptr, nullptr); }
    SEAM(1);
    bf16_t* Y12 = (bf16_t*)a.out;
    bf16_t* Y3 = (bf16_t*)(ws + OFF_ATT);
    if (IN(2)) { pg8::Gemm g{HFF, (const bf16_t*)(ws + OFF_WD1), NREAL, 1024, FF}; pg8::StaticOrder S; S.init(NREAL, 1024, G, (int)blockIdx.x);
        EpiY E{Y12, 0.5f}; pg8::gemm_phase<EpiY, pg8::StaticOrder, true, true>(lds, g, S, E);
        skinny_meta<1>(HFF + (size_t)NREAL * FF, FF, (const bf16_t*)(ws + OFF_WD1), FF, 64, gw, NGW, lane, Y12, nullptr, nullptr, nullptr, nullptr, nullptr, nullptr, nullptr); }
    SEAM(2);
    if (IN(3)) { lnres_phase<0>(a.x, a.meta, Y12, a.ln1g, a.ln1b, AB, nullptr, NREAL + NMETA, gw, NGW, lane); }
    SEAM(3);
    if (IN(4)) { pg8::Gemm g{AB, (const bf16_t*)(ws + OFF_WIN), NREAL, 3072, 1024}; pg8::StaticOrder S; S.init(NREAL, 3072, G, (int)blockIdx.x);
        skinny_meta<2>(AB + (size_t)NREAL * DM, DM, (const bf16_t*)(ws + OFF_WIN), 1024, 42, gw, NGW, lane, (bf16_t*)(ws + OFF_K8), nullptr, nullptr, (bf16_t*)(ws + OFF_V8), (bf16_t*)(ws + OFF_KI8), (bf16_t*)(ws + OFF_CU), (const float*)(ws + OFF_COS), (const float*)(ws + OFF_SIN));
        EpiProj E{(bf16_t*)(ws + OFF_QS), (bf16_t*)(ws + OFF_QI), (bf16_t*)(ws + OFF_KV), (bf16_t*)(ws + OFF_KI), (bf16_t*)(ws + OFF_CU), (bf16_t*)(ws + OFF_GB), (float*)(ws + OFF_WI), (const float*)(ws + OFF_COS), (const float*)(ws + OFF_SIN), (unsigned char*)(ws + OFF_K8), (unsigned char*)(ws + OFF_QI8), (unsigned char*)(ws + OFF_KI8), (unsigned char*)(ws + OFF_V8)};
        pg8::gemm_phase<EpiProj, pg8::StaticOrder, true, true>(lds, g, S, E); }
    SEAM(4);
    if (IN(5)) {
        conv_phase((const bf16_t*)(ws + OFF_CU), (const bf16_t*)(ws + OFF_GB), a.convw, (bf16_t*)(ws + OFF_YCV), blockIdx.x * 512 + tid, G * 512);
#ifdef DBG_SKIP_ATTN
        for (int it = blockIdx.x * 512 + tid; it < NREAL * 64; it += G * 512) *(u32x4*)((bf16_t*)(ws + OFF_ATT) + (size_t)it * 8) = (u32x4){0u, 0u, 0u, 0u};
#else
        attn_phase((const bf16_t*)(ws + OFF_QS), (const bf16_t*)(ws + OFF_QI8), (const bf16_t*)(ws + OFF_V8), (const bf16_t*)(ws + OFF_KI8), (const float*)(ws + OFF_WI), (bf16_t*)(ws + OFF_ATT), (const unsigned char*)(ws + OFF_K8), lds, wave, lane);
#ifdef PROBE_ATTN2
        attn_phase((const bf16_t*)(ws + OFF_QS), (const bf16_t*)(ws + OFF_QI8), (const bf16_t*)(ws + OFF_V8), (const bf16_t*)(ws + OFF_KI8), (const float*)(ws + OFF_WI), (bf16_t*)(ws + OFF_ATT), (const unsigned char*)(ws + OFF_K8), lds, wave, lane);
#endif
#endif
    }
    SEAM(5);
    if (IN(6)) {
        bf16_t* S1 = (bf16_t*)(ws + OFF_S1); bf16_t* S2 = (bf16_t*)(ws + OFF_S2);
#ifdef DBG_E1_M
        pg8::StaticOrder S; S.init(DBG_E1_M, 1024, G, (int)blockIdx.x);
        { pg8::Gemm g{AB, (const bf16_t*)(ws + OFF_WGA), DBG_E1_M, 1024, 1024};
#else
        pg8::StaticOrder S; S.init(NREAL, 1024, G, (int)blockIdx.x);
        { pg8::Gemm g{AB, (const bf16_t*)(ws + OFF_WGA), NREAL, 1024, 1024};
#endif
 EpiGate<0> E{S1, nullptr}; pg8::gemm_phase<EpiGate<0>, pg8::StaticOrder, true, true>(lds, g, S, E); }
#ifndef DBG_NO_E3
        { pg8::Gemm g{AB, (const bf16_t*)(ws + OFF_WGC), NREAL, 1024, 1024}; EpiGate<0> E{S2, nullptr}; pg8::gemm_phase<EpiGate<0>, pg8::StaticOrder, true, true>(lds, g, S, E); }
#endif
    }
    if (IN(6)) {
        bf16_t* S1 = (bf16_t*)(ws + OFF_S1);
        pg8::StaticOrder S; S.init(NREAL, 1024, G, (int)blockIdx.x);
        pg8::Gemm g{(const bf16_t*)(ws + OFF_ATT), (const bf16_t*)(ws + OFF_WAO), NREAL, 1024, 512}; EpiGate<1> E{S1, nullptr}; pg8::gemm_phase<EpiGate<1>, pg8::StaticOrder, true, true>(lds, g, S, E);
    }
    if (IN(6)) {
        bf16_t* S1 = (bf16_t*)(ws + OFF_S1); bf16_t* S2 = (bf16_t*)(ws + OFF_S2);
        pg8::StaticOrder S; S.init(NREAL, 1024, G, (int)blockIdx.x);
        pg8::Gemm g{(const bf16_t*)(ws + OFF_YCV), (const bf16_t*)(ws + OFF_WCO), NREAL, 1024, 512}; EpiGate<2> E{S1, S2}; pg8::gemm_phase<EpiGate<2>, pg8::StaticOrder, true, true>(lds, g, S, E);
    }
    SEAM(8);
    if (IN(9)) { pg8::Gemm g{(const bf16_t*)(ws + OFF_S1), (const bf16_t*)(ws + OFF_WO), NREAL, 1024, 1024}; pg8::StaticOrder S; S.init(NREAL, 1024, G, (int)blockIdx.x);
        EpiY E{Y12, 1.0f}; pg8::gemm_phase<EpiY, pg8::StaticOrder, true, true>(lds, g, S, E); }
    SEAM(9);
    if (IN(10)) { lnres_phase<1>(nullptr, nullptr, Y12, a.ln2g, a.ln2b, AB, nullptr, NREAL, gw, NGW, lane); }
    SEAM(10);
    if (IN(11)) { pg8::Gemm g{AB, (const bf16_t*)(ws + OFF_WGU2), NREAL, 5632, 1024}; pg8::StaticOrder S; S.init(NREAL, 5632, G, (int)blockIdx.x);
        EpiSwiglu E{HFF}; pg8::gemm_phase<EpiSwiglu, pg8::StaticOrder, true, true>(lds, g, S, E); }
    SEAM(11);
    if (IN(12)) { pg8::Gemm g{HFF, (const bf16_t*)(ws + OFF_WD2), NREAL, 1024, FF}; pg8::StaticOrder S; S.init(NREAL, 1024, G, (int)blockIdx.x);
        EpiY E{Y3, 0.5f}; pg8::gemm_phase<EpiY, pg8::StaticOrder, true, true>(lds, g, S, E); }
    SEAM(12);
    if (IN(13)) { lnres_phase<2>(nullptr, nullptr, Y3, a.ln3g, a.ln3b, AB, a.out, NREAL, gw, NGW, lane); }
#ifdef DBG_STOP
    if (lo == 100) {
        const int gt = blockIdx.x * 512 + tid, NT = G * 512;
        for (int it = gt; it < NREAL * 256; it += NT) {
            const int row = it >> 8, c4 = (it & 255) * 4; f32x4 v;
#ifdef DBG_DUMP_INPUTS
            if (c4 < 512) { const u32x2 w = *(const u32x2*)(AB + (size_t)row * DM + c4); v = (f32x4){bf_lo(w.x), bf_hi(w.x), bf_lo(w.y), bf_hi(w.y)}; }
            else if (row < 2048) { const u32x2 w = *(const u32x2*)((const bf16_t*)(ws + OFF_WGA) + (size_t)row * 512 + (c4 - 512)); v = (f32x4){bf_lo(w.x), bf_hi(w.x), bf_lo(w.y), bf_hi(w.y)}; }
            else v = (f32x4){0.f, 0.f, 0.f, 0.f};
#else
            if (DBG_STOP == 2 || DBG_STOP == 9) v = *(const f32x4*)(Z + (size_t)row * DM + c4);
            else if (DBG_STOP == 3 || DBG_STOP == 10) { const u32x2 w = *(const u32x2*)(AB + (size_t)row * DM + c4); v = (f32x4){bf_lo(w.x), bf_hi(w.x), bf_lo(w.y), bf_hi(w.y)}; }
            else if (DBG_STOP == 1 || DBG_STOP == 11) { const u32x2 w = *(const u32x2*)(HFF + (size_t)row * FF + c4); v = (f32x4){bf_lo(w.x), bf_hi(w.x), bf_lo(w.y), bf_hi(w.y)}; }
            else if (DBG_STOP == 4) { const bf16_t* src = c4 < 512 ? (const bf16_t*)(ws + OFF_QS) + (size_t)row * 512 + c4 : (const bf16_t*)(ws + OFF_CU) + (size_t)row * 512 + (c4 - 512); const u32x2 w = *(const u32x2*)src; v = (f32x4){bf_lo(w.x), bf_hi(w.x), bf_lo(w.y), bf_hi(w.y)}; }
            else if (DBG_STOP == 5) { const bf16_t* src = c4 < 512 ? (const bf16_t*)(ws + OFF_ATT) + (size_t)row * 512 + c4 : (const bf16_t*)(ws + OFF_YCV) + (size_t)row * 512 + (c4 - 512); const u32x2 w = *(const u32x2*)src; v = (f32x4){bf_lo(w.x), bf_hi(w.x), bf_lo(w.y), bf_hi(w.y)}; }
            else { const u32x2 w = *(const u32x2*)((const bf16_t*)(ws + OFF_S1) + (size_t)row * DM + c4); v = (f32x4){bf_lo(w.x), bf_hi(w.x), bf_lo(w.y), bf_hi(w.y)}; }
#endif
            *(f32x4*)(a.out + (size_t)row * DM + c4) = v;
        }
    }
#endif
#undef IN
#undef SEAM
}

extern "C" void kernel_launch(void* const* d_in, const int* in_sizes, int n_in, void* d_out, int out_size, void* d_ws, size_t ws_size, hipStream_t stream) {
    static int grid = 0;
    if (grid == 0) {
        if (n_in != 19 || in_sizes[0] != NREAL * DM || out_size != NREAL * DM || ws_size < WS_END) {
            fprintf(stderr, "kernel_launch: unexpected shapes (n_in %d, in0 %d, out %d, ws %zu, need %zu); nothing launched\n", n_in, n_in > 0 ? in_sizes[0] : -1, out_size, ws_size, (size_t)WS_END);
            grid = -1; return; }
        int dev = 0, cus = 0, per_cu = 0;
        (void)hipGetDevice(&dev); (void)hipDeviceGetAttribute(&cus, hipDeviceAttributeMultiprocessorCount, dev);
        (void)hipFuncSetAttribute((const void*)mk_fwd, hipFuncAttributeMaxDynamicSharedMemorySize, LDS_BYTES);
        (void)hipOccupancyMaxActiveBlocksPerMultiprocessor(&per_cu, (const void*)mk_fwd, NWAVES * 64, LDS_BYTES);
        if (per_cu < 1) { fprintf(stderr, "kernel_launch: occupancy query says %d blocks per CU\n", per_cu); per_cu = 1; }
        (void)hipGetLastError();
        grid = cus;
    }
    if (grid < 0) return;
    Args a{};
    a.x = (const float*)d_in[0]; a.meta = (const float*)d_in[1];
    a.f1g = (const float*)d_in[2]; a.f1u = (const float*)d_in[3]; a.f1d = (const float*)d_in[4]; a.ln1g = (const float*)d_in[5]; a.ln1b = (const float*)d_in[6];
    a.win = (const float*)d_in[7]; a.convw = (const float*)d_in[8]; a.wao = (const float*)d_in[9]; a.wco = (const float*)d_in[10]; a.wo = (const float*)d_in[11];
    a.ln2g = (const float*)d_in[12]; a.ln2b = (const float*)d_in[13]; a.f2g = (const float*)d_in[14]; a.f2u = (const float*)d_in[15]; a.f2d = (const float*)d_in[16];
    a.ln3g = (const float*)d_in[17]; a.ln3b = (const float*)d_in[18];
    a.out = (float*)d_out; a.ws = (unsigned char*)d_ws;
    (void)hipMemsetAsync((char*)d_ws + OFF_CTL, 0, SZ_CTL, stream);
#if ONE_LAUNCH
    a.ph_lo = 0; a.ph_hi = NPH;
    void* kargs[] = {&a};
    hipError_t e = hipLaunchCooperativeKernel((const void*)mk_fwd, dim3(grid), dim3(NWAVES * 64), kargs, LDS_BYTES, stream);
    if (e != hipSuccess) fprintf(stderr, "cooperative launch failed: %s (grid %d)\n", hipGetErrorString(e), grid);
#else
#ifdef DBG_STOP
    for (int ph = 0; ph <= DBG_STOP; ++ph) {
        a.ph_lo = ph; a.ph_hi = ph + 1;
        hipLaunchKernelGGL(mk_fwd, dim3(grid), dim3(NWAVES * 64), LDS_BYTES, stream, a);
    }
    a.ph_lo = 100; a.ph_hi = 101;
    hipLaunchKernelGGL(mk_fwd, dim3(grid), dim3(NWAVES * 64), LDS_BYTES, stream, a);
#else
    for (int ph = 0; ph < NPH; ++ph) {
        a.ph_lo = ph; a.ph_hi = ph + 1;
        hipLaunchKernelGGL(mk_fwd, dim3(grid), dim3(NWAVES * 64), LDS_BYTES, stream, a);
    }
#endif
#endif
}
```

```cpp
#define ONE_LAUNCH 1
#include <hip/hip_runtime.h>
#include <hip/hip_cooperative_groups.h>
#include <cstdio>
#include <cstdint>
#include <cmath>
namespace pg8 {
#define PG8_LAS __attribute__((address_space(3)))
typedef unsigned short bf16_t;
typedef short bf16x8 __attribute__((ext_vector_type(8)));
typedef float f32x4 __attribute__((ext_vector_type(4)));
typedef unsigned u32x4 __attribute__((ext_vector_type(4)));
constexpr int BM = 256, BK = 64, HALF = 128, HTB = HALF * BK * 2  , STAGE_BYTES = 8 * HTB, NXCD = 8, WGM = 8;

__host__ __device__ __forceinline__ int lds_byte(int r, int c) { const int st = (r >> 4) * 2 + (c >> 5), rr = r & 15, cc = c & 31, ob = rr * 64 + cc * 2; return st * 1024 + (ob ^ (((ob >> 9) & 1) << 5)); }
__host__ __device__ __forceinline__ void stage_rc(int b, int& R, int& C) { const int st = b / 1024, sb = b % 1024, swz = sb ^ (((sb >> 9) & 1) << 5); R = (st >> 1) * 16 + swz / 64; C = (st & 1) * 32 + (swz % 64) / 2; }
__host__ __device__ __forceinline__ int perm32(int rho) { const int n = rho >> 4, i = rho & 15; return 8 * (i >> 2) + 4 * n + (i & 3); }

struct Unit { int pm, pn; };
struct Gemm { const bf16_t* A; const bf16_t* Bt; int M, N, K; };

struct StaticOrder {
    int nM, nN, nwg, G, c;
    __host__ __device__ void init(int M, int N, int G_, int c_) { nM = M / BM; nN = N / BM; nwg = nM * nN; G = G_; c = c_; }
    __host__ __device__ bool next(int i, Unit& u) const {
        const long L = (long)i * G + c; if (L >= nwg) return false;
        int wgid = (int)L; { const int q = nwg / NXCD, r = nwg % NXCD, xcd = wgid % NXCD, off = wgid / NXCD; wgid = (xcd < r ? xcd * (q + 1) : r * (q + 1) + (xcd - r) * q) + off; }
        const int nig = WGM * nN, gid = wgid / nig, fm = gid * WGM, gsz = (nM - fm) < WGM ? (nM - fm) : WGM;
        u.pm = fm + ((wgid % nig) % gsz); u.pn = (wgid % nig) / gsz; return true;
    }
    __device__ __forceinline__ void a_ready(const Unit&) const {}
    __device__ __forceinline__ void done(const Unit&) const {}
};

__device__ __forceinline__ unsigned cvt_pk_bf16(float lo, float hi) { unsigned r; asm volatile("v_cvt_pk_bf16_f32 %0, %1, %2" : "=v"(r) : "v"(lo), "v"(hi)); return r; }
template <class Epi, class Sched, bool ALIGN_EPI = false, bool SP2 = false>
__device__ __forceinline__ void gemm_phase(PG8_LAS unsigned char* lds, const Gemm g, const Sched& S, const Epi& E) {
    const int tid = threadIdx.x, wid = __builtin_amdgcn_readfirstlane(tid >> 6), lane = tid & 63, wr = wid >> 2, wc = wid & 3, fr = lane & 15, fq = lane >> 4;
    const int K = g.K, nt = K / BK;
    unsigned voffA[2], voffB[2];
#pragma unroll
    for (int i = 0; i < 2; ++i) { int R, C; stage_rc(tid * 16 + i * 8192, R, C); const int Rb = Epi::PERM ? ((R & ~31) + perm32(R & 31)) : R;
        voffA[i] = (unsigned)(R * K + C) * 2u; voffB[i] = (unsigned)(Rb * K + C) * 2u; }
    const size_t kstep = (size_t)(BK * 2);
    const size_t hstep = (size_t)HALF * K * 2;
    const size_t tstep = 2 * hstep;
    const unsigned ldsw = (unsigned)wid * 1024u;
    const int aoff = lds_byte(wr * 64 + fr, fq * 8), boff = lds_byte(wc * 32 + fr, fq * 8);
#define PG8_SA(b, h) (((b) * 2 + (h)) * HTB)
#define PG8_SB(b, h) ((4 + (b) * 2 + (h)) * HTB)
#define PG8_STAGE(bufoff, gbase, voff) do { _Pragma("unroll") for (int _i = 0; _i < 2; ++_i) \
        __builtin_amdgcn_global_load_lds((const unsigned*)((const char*)(gbase) + (voff)[_i]), (PG8_LAS unsigned*)(lds + (bufoff) + ldsw + _i * 8192), 16, 0, 0); } while (0)
#define PG8_LDA(dst, b, h) do { _Pragma("unroll") for (int m = 0; m < 4; ++m) _Pragma("unroll") for (int k = 0; k < 2; ++k) dst[m][k] = *(const PG8_LAS bf16x8*)(lds + PG8_SA(b, h) + aoff + m * 2048 + k * 1024); } while (0)
#define PG8_LDB(dst, b, h) do { _Pragma("unroll") for (int n = 0; n < 2; ++n) _Pragma("unroll") for (int k = 0; k < 2; ++k) dst[n][k] = *(const PG8_LAS bf16x8*)(lds + PG8_SB(b, h) + boff + n * 2048 + k * 1024); } while (0)
#define PG8_MMA(ai, bj, At, Bt) do { __builtin_amdgcn_s_setprio(1); _Pragma("unroll") for (int m = 0; m < 4; ++m) _Pragma("unroll") for (int n = 0; n < 2; ++n) _Pragma("unroll") for (int k = 0; k < 2; ++k) \
        acc[ai][bj][m][n] = __builtin_amdgcn_mfma_f32_16x16x32_bf16(Bt[n][k], At[m][k], acc[ai][bj][m][n], 0, 0, 0); __builtin_amdgcn_s_setprio(0); } while (0)
#define PG8_WAIT_V(n) asm volatile("s_waitcnt vmcnt(" #n ")" ::: "memory")
#define PG8_WAIT_L(n) asm volatile("s_waitcnt lgkmcnt(" #n ")" ::: "memory")
#define PG8_BAR __builtin_amdgcn_s_barrier()
#define PG8_SCHED __builtin_amdgcn_sched_barrier(0)
    Unit cur, nxt; int ui = 0;
    if (!S.next(0, cur)) return;
    f32x4 acc[2][2][4][2];
#pragma unroll
    for (int a = 0; a < 2; ++a)
#pragma unroll
        for (int b = 0; b < 2; ++b)
#pragma unroll
            for (int m = 0; m < 4; ++m)
#pragma unroll
                for (int n = 0; n < 2; ++n) acc[a][b][m][n] = (f32x4){0.f, 0.f, 0.f, 0.f};
    bf16x8 At[4][2], B0[2][2], B1[2][2];
    const char* cA = (const char*)g.A + (size_t)cur.pm * tstep; const char* cB = (const char*)g.Bt + (size_t)cur.pn * tstep;
    S.a_ready(cur);
    if constexpr (SP2) {
        PG8_STAGE(PG8_SB(0, 0), cB, voffB); PG8_STAGE(PG8_SB(0, 1), cB + hstep, voffB); PG8_STAGE(PG8_SA(0, 0), cA, voffA); PG8_STAGE(PG8_SA(0, 1), cA + hstep, voffA);
        if (wr == 1) PG8_BAR;
        PG8_WAIT_V(2); PG8_BAR;
        PG8_STAGE(PG8_SB(1, 0), cB + kstep, voffB); PG8_STAGE(PG8_SA(1, 0), cA + kstep, voffA); PG8_STAGE(PG8_SB(1, 1), cB + hstep + kstep, voffB);
        PG8_WAIT_V(6); PG8_BAR;
    } else {
        PG8_STAGE(PG8_SB(0, 0), cB, voffB); PG8_STAGE(PG8_SA(0, 0), cA, voffA); PG8_STAGE(PG8_SB(0, 1), cB + hstep, voffB); PG8_STAGE(PG8_SA(0, 1), cA + hstep, voffA);
        if (wr == 1) PG8_BAR;
        PG8_WAIT_V(4); PG8_BAR;
        PG8_STAGE(PG8_SB(1, 0), cB + kstep, voffB); PG8_STAGE(PG8_SA(1, 0), cA + kstep, voffA); PG8_STAGE(PG8_SB(1, 1), cB + hstep + kstep, voffB);
        PG8_WAIT_V(6); PG8_BAR;
    }
    for (;;) {
        const bool has_next = S.next(ui + 1, nxt);
        const char* nA = has_next ? (const char*)g.A + (size_t)nxt.pm * tstep : cA; const char* nB = has_next ? (const char*)g.Bt + (size_t)nxt.pn * tstep : cB;
        for (int t = 0; t < nt; t += 2) {
            const bool last = (t == nt - 2);
            const char* a1 = cA + (size_t)(t + 1) * kstep;
            const char* a2 = last ? nA : cA + (size_t)(t + 2) * kstep; const char* b2 = last ? nB : cB + (size_t)(t + 2) * kstep;
            const char* a3 = a2 + kstep; const char* b3 = b2 + kstep;
            if (last && has_next) S.a_ready(nxt);
            if constexpr (SP2) {
            PG8_LDB(B0, 0, 0); PG8_LDB(B1, 0, 1); PG8_SCHED; PG8_LDA(At, 0, 0); PG8_STAGE(PG8_SA(1, 1), a1 + hstep, voffA);
            PG8_WAIT_V(8); PG8_WAIT_L(0); PG8_BAR; PG8_MMA(0, 0, At, B0); PG8_MMA(0, 1, At, B1); PG8_BAR; PG8_SCHED;
            PG8_LDA(At, 0, 1); PG8_STAGE(PG8_SB(0, 0), b2, voffB); PG8_STAGE(PG8_SB(0, 1), b2 + hstep, voffB); PG8_STAGE(PG8_SA(0, 0), a2, voffA);
            PG8_WAIT_V(8); PG8_WAIT_L(0); PG8_BAR; PG8_MMA(1, 0, At, B0); PG8_MMA(1, 1, At, B1); PG8_BAR; PG8_SCHED;
            PG8_LDB(B0, 1, 0); PG8_LDB(B1, 1, 1); PG8_SCHED; PG8_LDA(At, 1, 0); PG8_STAGE(PG8_SA(0, 1), a2 + hstep, voffA);
            PG8_WAIT_V(8); PG8_WAIT_L(0); PG8_BAR; PG8_MMA(0, 0, At, B0); PG8_MMA(0, 1, At, B1); PG8_BAR; PG8_SCHED;
            PG8_LDA(At, 1, 1); PG8_STAGE(PG8_SB(1, 0), b3, voffB); PG8_STAGE(PG8_SB(1, 1), b3 + hstep, voffB); PG8_STAGE(PG8_SA(1, 0), a3, voffA);
            PG8_WAIT_V(8); PG8_WAIT_L(0); PG8_BAR; PG8_MMA(1, 0, At, B0); PG8_MMA(1, 1, At, B1); PG8_BAR; PG8_SCHED;
            } else {
            PG8_LDB(B0, 0, 0); PG8_SCHED; PG8_LDA(At, 0, 0); PG8_STAGE(PG8_SA(1, 1), a1 + hstep, voffA);
            PG8_WAIT_L(8); PG8_BAR; PG8_WAIT_L(0); PG8_MMA(0, 0, At, B0); PG8_BAR; PG8_SCHED;
            PG8_LDB(B1, 0, 1); PG8_STAGE(PG8_SB(0, 0), b2, voffB);
            PG8_BAR; PG8_WAIT_L(0); PG8_MMA(0, 1, At, B1); PG8_BAR;
            PG8_LDA(At, 0, 1); PG8_STAGE(PG8_SA(0, 0), a2, voffA);
            PG8_BAR; PG8_WAIT_L(0); PG8_MMA(1, 0, At, B0); PG8_BAR; PG8_SCHED;
            PG8_STAGE(PG8_SB(0, 1), b2 + hstep, voffB);
            PG8_WAIT_V(6); PG8_BAR; PG8_MMA(1, 1, At, B1); PG8_BAR;
            PG8_LDB(B0, 1, 0); PG8_SCHED; PG8_LDA(At, 1, 0); PG8_STAGE(PG8_SA(0, 1), a2 + hstep, voffA);
            PG8_WAIT_L(8); PG8_BAR; PG8_WAIT_L(0); PG8_MMA(0, 0, At, B0); PG8_BAR; PG8_SCHED;
            PG8_LDB(B1, 1, 1); PG8_STAGE(PG8_SB(1, 0), b3, voffB);
            PG8_BAR; PG8_WAIT_L(0); PG8_MMA(0, 1, At, B1); PG8_BAR;
            PG8_LDA(At, 1, 1); PG8_STAGE(PG8_SA(1, 0), a3, voffA);
            PG8_BAR; PG8_WAIT_L(0); PG8_MMA(1, 0, At, B0); PG8_BAR; PG8_SCHED;
            PG8_STAGE(PG8_SB(1, 1), b3 + hstep, voffB);
            PG8_WAIT_V(6); PG8_BAR; PG8_MMA(1, 1, At, B1); PG8_BAR;
            }
        }
        if constexpr (ALIGN_EPI) { if (wr == 0) PG8_BAR; }
        if constexpr (!Epi::AFTER_DRAIN) { E(acc, cur, wr, wc, fr, fq); S.done(cur); }
        if (!has_next) break;
#pragma unroll
        for (int a = 0; a < 2; ++a)
#pragma unroll
            for (int b = 0; b < 2; ++b)
#pragma unroll
                for (int m = 0; m < 4; ++m)
#pragma unroll
                    for (int n = 0; n < 2; ++n) acc[a][b][m][n] = (f32x4){0.f, 0.f, 0.f, 0.f};
        cur = nxt; cA = nA; cB = nB; ++ui;
        if constexpr (ALIGN_EPI) { if (wr == 1) PG8_BAR; }
    }
    PG8_WAIT_V(0);
    if constexpr (!ALIGN_EPI) { if (wr == 0) PG8_BAR; }
    PG8_BAR;
    if constexpr (Epi::AFTER_DRAIN) { E.fused(acc, cur, wr, wc, fr, fq, lds, wid, lane); S.done(cur); }
#undef PG8_SA
#undef PG8_SB
#undef PG8_STAGE
#undef PG8_LDA
#undef PG8_LDB
#undef PG8_MMA
#undef PG8_WAIT_V
#undef PG8_WAIT_L
#undef PG8_BAR
#undef PG8_SCHED
}
}

#define LAS __attribute__((address_space(3)))
typedef unsigned short bf16_t;
typedef short bf16x8 __attribute__((ext_vector_type(8)));
typedef short s16x4 __attribute__((ext_vector_type(4)));
typedef float f32x4 __attribute__((ext_vector_type(4)));
typedef float f32x16 __attribute__((ext_vector_type(16)));
typedef unsigned u32x4 __attribute__((ext_vector_type(4)));
typedef unsigned u32x2 __attribute__((ext_vector_type(2)));

constexpr int NB = 8, SEQ = 8192, NMETA = 16, DM = 1024, FF = 2816;
constexpr int NREAL = NB * SEQ;
constexpr int MROWS = NREAL + 256;
constexpr float ALPHA = 1.189207115002721f;
constexpr float LN_EPS = 1e-5f;
constexpr int NWAVES = 8;
constexpr int LDS_BYTES = 147456 + 16384;
constexpr int LDS_BST = 7 * 18432 + 16512;
constexpr int CAND_CAP = 1024;
constexpr int WREG = 18432;
constexpr int NPH = 14;
#ifndef ONE_LAUNCH
#define ONE_LAUNCH 1
#endif

constexpr size_t SZ_ROPE = (size_t)8208 * 32 * 4;
constexpr size_t OFF_CTL = 0, SZ_CTL = 16384;
constexpr size_t OFF_COS = SZ_CTL, OFF_SIN = OFF_COS + SZ_ROPE;
constexpr size_t OFF_ST1 = OFF_SIN + SZ_ROPE, SZ_ST = (size_t)MROWS * 8;
constexpr size_t OFF_ST2 = OFF_ST1 + SZ_ST;
constexpr size_t OFF_WGU1 = OFF_ST2 + SZ_ST, SZ_WGU = (size_t)5632 * 1024 * 2;
constexpr size_t OFF_WD1 = OFF_WGU1 + SZ_WGU, SZ_WD = (size_t)1024 * 2816 * 2;
constexpr size_t OFF_WGU2 = OFF_WD1 + SZ_WD;
constexpr size_t OFF_WD2 = OFF_WGU2 + SZ_WGU;
constexpr size_t OFF_WIN = OFF_WD2 + SZ_WD, SZ_WIN = (size_t)3072 * 1024 * 2;
constexpr size_t OFF_WGA = OFF_WIN + SZ_WIN, SZ_W1K = (size_t)1024 * 1024 * 2;
constexpr size_t OFF_WGC = OFF_WGA + SZ_W1K;
constexpr size_t OFF_WO = OFF_WGC + SZ_W1K;
constexpr size_t OFF_WAO = OFF_WO + SZ_W1K, SZ_W512 = (size_t)1024 * 512 * 2;
constexpr size_t OFF_WCO = OFF_WAO + SZ_W512;
constexpr size_t OFF_AB = OFF_WCO + SZ_W512, SZ_AB = (size_t)MROWS * 1024 * 2;
constexpr size_t OFF_Z = OFF_AB + SZ_AB, SZ_Z = (size_t)MROWS * 1024 * 4;
constexpr size_t OFF_BIG = OFF_Z + SZ_Z, SZ_BIG = (size_t)MROWS * 2816 * 2;
constexpr size_t OFF_QS = OFF_BIG, SZ_R512 = (size_t)MROWS * 512 * 2;
constexpr size_t OFF_QI = OFF_QS + SZ_R512;
constexpr size_t OFF_KV = OFF_QI + SZ_R512;
constexpr size_t OFF_KI = OFF_KV + (size_t)MROWS * 256 * 2;
constexpr size_t OFF_WI = OFF_KI + (size_t)MROWS * 64 * 2;
constexpr size_t OFF_CU = OFF_WI + (size_t)MROWS * 8 * 4;
constexpr size_t OFF_GB = OFF_CU + SZ_R512;
constexpr size_t OFF_K8 = OFF_GB + SZ_R512;
constexpr size_t OFF_QI8 = OFF_K8 + (size_t)MROWS * 128;
constexpr size_t OFF_KI8 = OFF_QI8 + (size_t)MROWS * 512;
constexpr size_t OFF_V8 = OFF_KI8 + (size_t)MROWS * 64;
static_assert(OFF_V8 + (size_t)MROWS * 128 <= OFF_BIG + SZ_BIG, "mixer tensors overlay the FFN hidden buffer");
constexpr size_t OFF_S1 = OFF_BIG, OFF_S2 = OFF_BIG + (size_t)NREAL * 1024 * 2;
static_assert(OFF_S2 + (size_t)NREAL * 1024 * 2 <= OFF_BIG + SZ_BIG, "gate buffers overlay");
constexpr size_t OFF_ATT = OFF_BIG + SZ_BIG, SZ_ATT = (size_t)NREAL * 512 * 2;
constexpr size_t OFF_YCV = OFF_ATT + SZ_ATT;
constexpr size_t WS_END = OFF_YCV + SZ_ATT;

struct Args {
    const float* x; const float* meta;
    const float* f1g; const float* f1u; const float* f1d; const float* ln1g; const float* ln1b;
    const float* win; const float* convw; const float* wao; const float* wco; const float* wo;
    const float* ln2g; const float* ln2b; const float* f2g; const float* f2u; const float* f2d; const float* ln3g; const float* ln3b;
    float* out; unsigned char* ws; int ph_lo, ph_hi;
};

__device__ __forceinline__ unsigned f2bf(float f) { unsigned u = __builtin_bit_cast(unsigned, f); return (u + 0x7fffu + ((u >> 16) & 1u)) >> 16; }
typedef float f32x2_t __attribute__((ext_vector_type(2))); typedef __bf16 bf16x2_t __attribute__((ext_vector_type(2)));
__device__ __forceinline__ unsigned pk2(float lo, float hi) { f32x2_t v = {lo, hi}; bf16x2_t b = __builtin_convertvector(v, bf16x2_t); return __builtin_bit_cast(unsigned, b); }
__device__ __forceinline__ float bf_lo(unsigned w) { return __builtin_bit_cast(float, w << 16); }
__device__ __forceinline__ float bf_hi(unsigned w) { return __builtin_bit_cast(float, w & 0xffff0000u); }
__device__ __forceinline__ unsigned pk4_fp8(float a, float b_, float c, float d) { int w = __builtin_amdgcn_cvt_pk_fp8_f32(a, b_, 0, false); w = __builtin_amdgcn_cvt_pk_fp8_f32(c, d, w, true); return (unsigned)w; }
#define LDS_WAIT() asm volatile("s_waitcnt lgkmcnt(0)" ::: "memory")
__device__ __forceinline__ float wave_sum(float v) {
#pragma unroll
    for (int o = 1; o < 64; o <<= 1) v += __shfl_xor(v, o);
    return v;
}

struct EpiSwiglu {
    static constexpr bool PERM = true, AFTER_DRAIN = false;
    bf16_t* H;
    __device__ __forceinline__ void operator()(const f32x4 (&acc)[2][2][4][2], const pg8::Unit& u, int wr, int wc, int fr, int fq) const {
        const int row0 = u.pm * 256 + wr * 64 + fr, col0 = u.pn * 128 + wc * 32 + 8 * fq;
#pragma unroll
        for (int ai = 0; ai < 2; ++ai)
#pragma unroll
            for (int m = 0; m < 4; ++m) {
                bf16_t* rowp = H + (size_t)(row0 + ai * 128 + m * 16) * FF + col0;
                float h[8];
#pragma unroll
                for (int n = 0; n < 2; ++n)
#pragma unroll
                    for (int i = 0; i < 4; ++i) {
                        const float g = acc[ai][0][m][n][i], up = acc[ai][1][m][n][i];
                        const float e = __builtin_amdgcn_exp2f(-g * 1.4426950408889634f);
                        h[4 * n + i] = g * __builtin_amdgcn_rcpf(1.0f + e) * up;
                    }
                u32x4 w; w.x = pk2(h[0], h[1]); w.y = pk2(h[2], h[3]); w.z = pk2(h[4], h[5]); w.w = pk2(h[6], h[7]);
                *(u32x4*)rowp = w;
            }
    }
};

template <int MODE> struct EpiResid {
    static constexpr bool PERM = false, AFTER_DRAIN = false;
    const float* x; const float* meta; const float* zin; const float* stats; const float* g; const float* bta; float* zout; float scale;
    __device__ __forceinline__ void operator()(const f32x4 (&acc)[2][2][4][2], const pg8::Unit& u, int wr, int wc, int fr, int fq) const {
        const int col0 = u.pn * 256 + wc * 32 + 4 * fq;
#pragma unroll
        for (int ai = 0; ai < 2; ++ai)
#pragma unroll
            for (int m = 0; m < 4; ++m) {
                const int row = u.pm * 256 + ai * 128 + wr * 64 + m * 16 + fr;
                const float* src; float mean = 0.f, rstd = 1.f; bool have = true;
                if (MODE == 0) { src = row < NREAL ? x + (size_t)row * DM : meta + (size_t)((row - NREAL) & 15) * DM; have = row < NREAL + NMETA; }
                else { src = zin + (size_t)row * DM; mean = stats[2 * row]; rstd = stats[2 * row + 1]; }
#pragma unroll
                for (int bj = 0; bj < 2; ++bj)
#pragma unroll
                    for (int n = 0; n < 2; ++n) {
                        const int c = col0 + bj * 128 + n * 16;
                        f32x4 hv = *(const f32x4*)(src + c);
                        if (MODE == 0) { if (!have) hv = (f32x4){0.f, 0.f, 0.f, 0.f}; }
                        else { const f32x4 gv = *(const f32x4*)(g + c), bv = *(const f32x4*)(bta + c); hv = (hv - mean) * rstd * gv + bv; }
                        const f32x4 o = hv * ALPHA + acc[ai][bj][m][n] * scale;
                        *(f32x4*)(zout + (size_t)row * DM + c) = o;
                    }
                asm volatile("" ::: "memory");
            }
    }
};

template <int MODE> struct EpiGate {
    static constexpr bool PERM = true, AFTER_DRAIN = false;
    bf16_t* P; const bf16_t* Q;
    __device__ __forceinline__ void operator()(const f32x4 (&acc)[2][2][4][2], const pg8::Unit& u, int wr, int wc, int fr, int fq) const {
        const int col0 = u.pn * 256 + wc * 32 + 8 * fq;
#pragma unroll
        for (int ai = 0; ai < 2; ++ai)
#pragma unroll
            for (int m = 0; m < 4; ++m) {
                const int row = u.pm * 256 + ai * 128 + wr * 64 + m * 16 + fr;
#pragma unroll
                for (int bj = 0; bj < 2; ++bj) {
                    const size_t off = (size_t)row * DM + col0 + bj * 128;
                    float v[8];
#pragma unroll
                    for (int n = 0; n < 2; ++n)
#pragma unroll
                        for (int i = 0; i < 4; ++i) v[4 * n + i] = acc[ai][bj][m][n][i];
                    if (MODE == 0) {
#pragma unroll
                        for (int i = 0; i < 8; ++i) v[i] = __builtin_amdgcn_rcpf(1.0f + __builtin_amdgcn_exp2f(-v[i] * 1.4426950408889634f));
                    } else {
                        const u32x4 pw = *(const u32x4*)(P + off);
                        float p[8] = {bf_lo(pw.x), bf_hi(pw.x), bf_lo(pw.y), bf_hi(pw.y), bf_lo(pw.z), bf_hi(pw.z), bf_lo(pw.w), bf_hi(pw.w)};
                        if (MODE == 1) {
#pragma unroll
                            for (int i = 0; i < 8; ++i) v[i] = p[i] * v[i];
                        } else {
                            const u32x4 qw = *(const u32x4*)(Q + off);
                            float q[8] = {bf_lo(qw.x), bf_hi(qw.x), bf_lo(qw.y), bf_hi(qw.y), bf_lo(qw.z), bf_hi(qw.z), bf_lo(qw.w), bf_hi(qw.w)};
#pragma unroll
                            for (int i = 0; i < 8; ++i) v[i] = p[i] + q[i] * v[i];
                        }
                    }
                    u32x4 w; w.x = pk2(v[0], v[1]); w.y = pk2(v[2], v[3]); w.z = pk2(v[4], v[5]); w.w = pk2(v[6], v[7]);
                    *(u32x4*)(P + off) = w;
                }
                asm volatile("" ::: "memory");
            }
    }
};

struct EpiY {
    static constexpr bool PERM = true, AFTER_DRAIN = false;
    bf16_t* Y; float scale;
    __device__ __forceinline__ void operator()(const f32x4 (&acc)[2][2][4][2], const pg8::Unit& u, int wr, int wc, int fr, int fq) const {
        const int col0 = u.pn * 256 + wc * 32 + 8 * fq;
#pragma unroll
        for (int ai = 0; ai < 2; ++ai)
#pragma unroll
            for (int m = 0; m < 4; ++m) {
                const int row = u.pm * 256 + ai * 128 + wr * 64 + m * 16 + fr;
#pragma unroll
                for (int bj = 0; bj < 2; ++bj) {
                    const f32x4 a0 = acc[ai][bj][m][0] * scale, a1 = acc[ai][bj][m][1] * scale;
                    u32x4 w; w.x = pk2(a0[0], a0[1]); w.y = pk2(a0[2], a0[3]); w.z = pk2(a1[0], a1[1]); w.w = pk2(a1[2], a1[3]);
                    *(u32x4*)(Y + (size_t)row * DM + col0 + bj * 128) = w;
                }
            }
    }
};

struct EpiProj {
    static constexpr bool PERM = true, AFTER_DRAIN = false;
    bf16_t *QS, *QI, *KV, *KI, *CU, *GB; float* WI; const float* cosT; const float* sinT; unsigned char* K8; unsigned char* QI8; unsigned char* KI8; unsigned char* V8;
    __device__ __forceinline__ void rope_store_k8(const f32x4 (&acc)[2][2][4][2], int ai, int m, int pos, int fq, unsigned char* dst) const {
        const f32x4 c0 = *(const f32x4*)(cosT + pos * 32 + 8 * fq), c1 = *(const f32x4*)(cosT + pos * 32 + 8 * fq + 4);
        const f32x4 s0 = *(const f32x4*)(sinT + pos * 32 + 8 * fq), s1 = *(const f32x4*)(sinT + pos * 32 + 8 * fq + 4);
        const f32x4 a0 = acc[ai][0][m][0], a1 = acc[ai][0][m][1], b0 = acc[ai][1][m][0], b1 = acc[ai][1][m][1];
        const f32x4 lo0 = a0 * c0 - b0 * s0, lo1 = a1 * c1 - b1 * s1, hi0 = b0 * c0 + a0 * s0, hi1 = b1 * c1 + a1 * s1;
        u32x2 w; w.x = pk4_fp8(lo0[0], lo0[1], lo0[2], lo0[3]); w.y = pk4_fp8(lo1[0], lo1[1], lo1[2], lo1[3]); *(u32x2*)dst = w;
        w.x = pk4_fp8(hi0[0], hi0[1], hi0[2], hi0[3]); w.y = pk4_fp8(hi1[0], hi1[1], hi1[2], hi1[3]); *(u32x2*)(dst + 32) = w;
    }
    __device__ __forceinline__ void rope_store(const f32x4 (&acc)[2][2][4][2], int ai, int m, int pos, int fq, bf16_t* dst, float sc) const {
        const f32x4 c0 = *(const f32x4*)(cosT + pos * 32 + 8 * fq), c1 = *(const f32x4*)(cosT + pos * 32 + 8 * fq + 4);
        const f32x4 s0 = *(const f32x4*)(sinT + pos * 32 + 8 * fq), s1 = *(const f32x4*)(sinT + pos * 32 + 8 * fq + 4);
        const f32x4 a0 = acc[ai][0][m][0] * sc, a1 = acc[ai][0][m][1] * sc, b0 = acc[ai][1][m][0] * sc, b1 = acc[ai][1][m][1] * sc;
        const f32x4 lo0 = a0 * c0 - b0 * s0, lo1 = a1 * c1 - b1 * s1, hi0 = b0 * c0 + a0 * s0, hi1 = b1 * c1 + a1 * s1;
        u32x4 w; w.x = pk2(lo0[0], lo0[1]); w.y = pk2(lo0[2], lo0[3]); w.z = pk2(lo1[0], lo1[1]); w.w = pk2(lo1[2], lo1[3]);
        *(u32x4*)dst = w;
        w.x = pk2(hi0[0], hi0[1]); w.y = pk2(hi0[2], hi0[3]); w.z = pk2(hi1[0], hi1[1]); w.w = pk2(hi1[2], hi1[3]);
        *(u32x4*)(dst + 32) = w;
    }
    __device__ __forceinline__ void operator()(const f32x4 (&acc)[2][2][4][2], const pg8::Unit& u, int wr, int wc, int fr, int fq) const {
        const int pn = u.pn;
#pragma unroll
        for (int ai = 0; ai < 2; ++ai)
#pragma unroll
            for (int m = 0; m < 4; ++m) {
                const int row = u.pm * 256 + ai * 128 + wr * 64 + m * 16 + fr;
                const int pos = row < NREAL ? NMETA + (row & (SEQ - 1)) : (row - NREAL);
                if (pn < 2) {
                    rope_store(acc, ai, m, pos, fq, QS + (size_t)row * 512 + (4 * pn + wc) * 64 + 8 * fq, 0.125f);
                } else if (pn == 2) {
                    if (wc < 2) rope_store_k8(acc, ai, m, pos, fq, K8 + (size_t)row * 128 + wc * 64 + 8 * fq);
                    else {
#pragma unroll
                        for (int bj = 0; bj < 2; ++bj) {
                            const f32x4 a0 = acc[ai][bj][m][0], a1 = acc[ai][bj][m][1];
                            u32x2 w; w.x = pk4_fp8(a0[0], a0[1], a0[2], a0[3]); w.y = pk4_fp8(a1[0], a1[1], a1[2], a1[3]);
                            *(u32x2*)(V8 + (size_t)row * 128 + bj * 64 + (wc - 2) * 32 + 8 * fq) = w;
                        }
                    }
                } else if (pn < 5) {
                    rope_store_k8(acc, ai, m, pos, fq, QI8 + (size_t)row * 512 + (4 * (pn - 3) + wc) * 64 + 8 * fq);
                } else if (pn == 5) {
                    if (wc == 0) rope_store_k8(acc, ai, m, pos, fq, KI8 + (size_t)row * 64 + 8 * fq);
                    else if (wc == 1 && fq == 0) {
                        const float sc = 0.04419417382415922f;
                        *(f32x4*)(WI + (size_t)row * 8) = acc[ai][0][m][0] * sc;
                        *(f32x4*)(WI + (size_t)row * 8 + 4) = acc[ai][0][m][1] * sc;
                    }
                } else if (pn < 10) {
                    const f32x4 a0 = acc[ai][0][m][0] * acc[ai][1][m][0], a1 = acc[ai][0][m][1] * acc[ai][1][m][1];
                    u32x4 w; w.x = pk2(a0[0], a0[1]); w.y = pk2(a0[2], a0[3]); w.z = pk2(a1[0], a1[1]); w.w = pk2(a1[2], a1[3]);
                    *(u32x4*)(CU + (size_t)row * 512 + (pn - 6) * 128 + wc * 32 + 8 * fq) = w;
                } else {
#pragma unroll
                    for (int bj = 0; bj < 2; ++bj) {
                        const f32x4 a0 = acc[ai][bj][m][0], a1 = acc[ai][bj][m][1];
                        u32x4 w; w.x = pk2(a0[0], a0[1]); w.y = pk2(a0[2], a0[3]); w.z = pk2(a1[0], a1[1]); w.w = pk2(a1[2], a1[3]);
                        *(u32x4*)(GB + (size_t)row * 512 + (pn - 10) * 256 + bj * 128 + wc * 32 + 8 * fq) = w;
                    }
                }
                if (m & 1) asm volatile("" ::: "memory");
            }
    }
};

__device__ __forceinline__ void tr_item(const float* W, int N, int n0, int nvalid, int k0, bf16_t* WT, int K, int drow0, LAS float* scr, int lane) {
    const int nn4 = (lane & 7) * 4;
    f32x4 tv[8];
#pragma unroll
    for (int i = 0; i < 8; ++i) { const int kk = 8 * i + (lane >> 3); tv[i] = (f32x4){0.f, 0.f, 0.f, 0.f}; if (nn4 < nvalid) tv[i] = *(const f32x4*)(W + (size_t)(k0 + kk) * N + n0 + nn4); }
#pragma unroll
    for (int i = 0; i < 8; ++i) { const int kk = 8 * i + (lane >> 3);
#pragma unroll
        for (int j = 0; j < 4; ++j) scr[kk * 33 + nn4 + j] = tv[i][j]; }
    LDS_WAIT();
    const int c = lane & 7;
#pragma unroll
    for (int j = 0; j < 4; ++j) { const int n = (lane >> 3) + 8 * j; const LAS float* s = scr + (8 * c) * 33 + n;
        u32x4 o; o.x = pk2(s[0 * 33], s[1 * 33]); o.y = pk2(s[2 * 33], s[3 * 33]); o.z = pk2(s[4 * 33], s[5 * 33]); o.w = pk2(s[6 * 33], s[7 * 33]);
        *(u32x4*)(WT + (size_t)(drow0 + n) * K + k0 + 8 * c) = o; }
    LDS_WAIT();
}
__device__ __forceinline__ void win_group(int G, int& n0, int& nvalid) {
    const int pn = G >> 3, bj = (G >> 2) & 1, xg = G & 3; nvalid = 32;
    if (pn < 2) n0 = (pn * 4 + xg) * 64 + bj * 32;
    else if (pn == 2) { if (xg < 2) n0 = 512 + xg * 64 + bj * 32; else n0 = 640 + bj * 64 + (xg - 2) * 32; }
    else if (pn < 5) n0 = 768 + ((pn - 3) * 4 + xg) * 64 + bj * 32;
    else if (pn == 5) { if (xg == 0) n0 = 1280 + bj * 32; else if (xg == 1 && bj == 0) { n0 = 1344; nvalid = 8; } else { n0 = 0; nvalid = 0; } }
    else if (pn < 10) n0 = (bj ? 2376 : 1352) + (pn - 6) * 128 + 32 * xg;
    else n0 = 1864 + (pn - 10) * 256 + bj * 128 + 32 * xg;
}
__device__ __forceinline__ void p0_prologue(const Args& a, LAS unsigned char* lds, int gw, int NGW, int wave, int lane, int parts) {
    unsigned char* ws = a.ws;
    LAS float* scr = (LAS float*)(lds + wave * 16384);
    constexpr int I_GU = 176 * 16, I_D = 32 * 44, I_IN = 96 * 16, I_1K = 32 * 16, I_512 = 32 * 8;
    constexpr int NITEMS = 2 * I_GU + 2 * I_D + I_IN + 3 * I_1K + 2 * I_512;
    if (parts & 1)
    for (int it = gw; it < NITEMS; it += NGW) {
        int r = it;
        if (r < 2 * I_GU) { const int which = r / I_GU; r -= which * I_GU; const int kb = r / 176, G = r % 176, pn = G >> 3, bj = (G >> 2) & 1, xg = G & 3;
            const float* W = which ? (bj ? a.f2u : a.f2g) : (bj ? a.f1u : a.f1g);
            tr_item(W, FF, 128 * pn + 32 * xg, 32, 64 * kb, (bf16_t*)(ws + (which ? OFF_WGU2 : OFF_WGU1)), 1024, 32 * G, scr, lane); continue; }
        r -= 2 * I_GU;
        if (r < 2 * I_D) { const int which = r / I_D; r -= which * I_D; const int kb = r / 32, G = r % 32;
            tr_item(which ? a.f2d : a.f1d, 1024, 32 * G, 32, 64 * kb, (bf16_t*)(ws + (which ? OFF_WD2 : OFF_WD1)), FF, 32 * G, scr, lane); continue; }
        r -= 2 * I_D;
        if (r < I_IN) { const int kb = r / 96, G = r % 96; int n0, nv; win_group(G, n0, nv);
            tr_item(a.win, 4936, n0, nv, 64 * kb, (bf16_t*)(ws + OFF_WIN), 1024, 32 * G, scr, lane); continue; }
        r -= I_IN;
        if (r < I_1K) { const int kb = r / 32, G = r % 32; tr_item(a.win, 4936, 2888 + 32 * G, 32, 64 * kb, (bf16_t*)(ws + OFF_WGA), 1024, 32 * G, scr, lane); continue; }
        r -= I_1K;
        if (r < I_1K) { const int kb = r / 32, G = r % 32; tr_item(a.win, 4936, 3912 + 32 * G, 32, 64 * kb, (bf16_t*)(ws + OFF_WGC), 1024, 32 * G, scr, lane); continue; }
        r -= I_1K;
        if (r < I_1K) { const int kb = r / 32, G = r % 32; tr_item(a.wo, 1024, 32 * G, 32, 64 * kb, (bf16_t*)(ws + OFF_WO), 1024, 32 * G, scr, lane); continue; }
        r -= I_1K;
        if (r < I_512) { const int kb = r / 32, G = r % 32; tr_item(a.wao, 1024, 32 * G, 32, 64 * kb, (bf16_t*)(ws + OFF_WAO), 512, 32 * G, scr, lane); continue; }
        r -= I_512;
        { const int kb = r / 32, G = r % 32; tr_item(a.wco, 1024, 32 * G, 32, 64 * kb, (bf16_t*)(ws + OFF_WCO), 512, 32 * G, scr, lane); }
    }
    bf16_t* AB = (bf16_t*)(ws + OFF_AB);
    if (parts & 2)
    for (int row0 = gw; row0 < MROWS; row0 += 4 * NGW) {
        f32x4 hv[4][4];
#pragma unroll
        for (int r = 0; r < 4; ++r) { const int row = row0 + r * NGW;
            if (row < MROWS) { const float* src = row < NREAL ? a.x + (size_t)row * DM : a.meta + (size_t)((row - NREAL) & 15) * DM;
#pragma unroll
                for (int j = 0; j < 4; ++j) hv[r][j] = *(const f32x4*)(src + 256 * j + 4 * lane); } }
#pragma unroll
        for (int r = 0; r < 4; ++r) { const int row = row0 + r * NGW;
            if (row < MROWS) { const bool have = row < NREAL + NMETA;
#pragma unroll
                for (int j = 0; j < 4; ++j) { f32x4 v = hv[r][j]; if (!have) v = (f32x4){0.f, 0.f, 0.f, 0.f};
                    u32x2 w; w.x = pk2(v[0], v[1]); w.y = pk2(v[2], v[3]);
                    *(u32x2*)(AB + (size_t)row * DM + 256 * j + 4 * lane) = w; } } }
    }
    float* cosT = (float*)(ws + OFF_COS); float* sinT = (float*)(ws + OFF_SIN);
    if (parts & 4)
    for (int idx = gw * 64 + lane; idx < 8208 * 32; idx += NGW * 64) {
        const int pos = idx >> 5, f = idx & 31;
        double fr = 1.0; for (int i = 0; i < f; ++i) fr *= 0.7498942093324559;
        const float inv = (float)fr;
        const float angf = (float)pos * inv;
        const double ang = (double)angf;
        const double k = __builtin_rint(ang * 0.6366197723675814);
        double rr = __builtin_fma(-k, 1.5707963267948966, ang); rr = __builtin_fma(-k, 6.123233995736766e-17, rr);
        const double r2 = rr * rr;
        double sp = -1.0 / 6227020800.0; sp = sp * r2 + 1.0 / 39916800.0; sp = sp * r2 - 1.0 / 362880.0; sp = sp * r2 + 1.0 / 5040.0; sp = sp * r2 - 1.0 / 120.0; sp = sp * r2 + 1.0 / 6.0;
        const double sn = rr - rr * r2 * sp;
        double cp = 1.0 / 87178291200.0; cp = cp * r2 - 1.0 / 479001600.0; cp = cp * r2 + 1.0 / 3628800.0; cp = cp * r2 - 1.0 / 40320.0; cp = cp * r2 + 1.0 / 720.0; cp = cp * r2 - 1.0 / 24.0; cp = cp * r2 + 0.5;
        const double cs = 1.0 - r2 * cp;
        const int q = ((int)k) & 3;
        const double sv = (q == 0) ? sn : (q == 1) ? cs : (q == 2) ? -sn : -cs;
        const double cv = (q == 0) ? cs : (q == 1) ? -sn : (q == 2) ? -cs : sn;
        cosT[idx] = (float)cv; sinT[idx] = (float)sv;
    }
}

template <int MODE> __device__ __forceinline__ void skinny_meta(const bf16_t* A, int lda, const bf16_t* Bt, int K, int ntask, int gw, int NGW, int lane,
                                                                bf16_t* HFF, float* Z, const float* meta, bf16_t* KV, bf16_t* KI, bf16_t* CU, const float* cosT, const float* sinT) {
    const int fr = lane & 15, fq = lane >> 4;
    for (int task = gw; task < ntask; task += NGW) {
        int pn, x0;
        if (MODE == 0) { pn = task >> 3; x0 = (task & 7) * 16; }
        else if (MODE == 1) { pn = 0; x0 = task * 16; }
        else { if (task < 8) { pn = 2; x0 = task * 16; } else if (task < 10) { pn = 5; x0 = (task - 8) * 16; } else { pn = 6 + ((task - 10) >> 3); x0 = ((task - 10) & 7) * 16; } }
        const int r0 = (MODE == 1) ? x0 + fr : 256 * pn + x0 + fr;
        const bf16_t* ap = A + (size_t)fr * lda + 8 * fq;
        const bf16_t* b0 = Bt + (size_t)r0 * K + 8 * fq;
        const bf16_t* b1 = b0 + (size_t)128 * K;
        f32x4 acc0 = {0.f, 0.f, 0.f, 0.f}, acc1 = {0.f, 0.f, 0.f, 0.f};
#pragma unroll 8
        for (int k = 0; k < K; k += 32) {
            const bf16x8 a = *(const bf16x8*)(ap + k), x = *(const bf16x8*)(b0 + k);
            acc0 = __builtin_amdgcn_mfma_f32_16x16x32_bf16(a, x, acc0, 0, 0, 0);
            if (MODE != 1) { const bf16x8 y = *(const bf16x8*)(b1 + k); acc1 = __builtin_amdgcn_mfma_f32_16x16x32_bf16(a, y, acc1, 0, 0, 0); }
        }
#pragma unroll
        for (int i = 0; i < 4; ++i) {
            const int m = 4 * fq + i; const size_t row = (size_t)(NREAL + m); const int x = x0 + fr;
            const float a0 = acc0[i], a1 = acc1[i];
            if (MODE == 0) {
                const float e = __builtin_amdgcn_exp2f(-a0 * 1.4426950408889634f);
                HFF[row * FF + 128 * pn + x] = (bf16_t)f2bf(a0 * __builtin_amdgcn_rcpf(1.0f + e) * a1);
            } else if (MODE == 1) {
                HFF[row * DM + x] = (bf16_t)f2bf(0.5f * a0);
            } else {
                if (pn == 2) {
                    if (x < 64) { const int d = x & 31; const float c = cosT[m * 32 + d], s = sinT[m * 32 + d]; unsigned char* K8m = (unsigned char*)HFF;
                        const float lo = a0 * c - a1 * s, hi = a1 * c + a0 * s;
                        K8m[row * 128 + (x >> 5) * 64 + d] = (unsigned char)(pk4_fp8(lo, lo, lo, lo) & 0xffu); K8m[row * 128 + (x >> 5) * 64 + 32 + d] = (unsigned char)(pk4_fp8(hi, hi, hi, hi) & 0xffu); }
                    else { unsigned char* V8m = (unsigned char*)KV;
                        V8m[row * 128 + (x - 64)] = (unsigned char)(pk4_fp8(a0, a0, a0, a0) & 0xffu); V8m[row * 128 + 64 + (x - 64)] = (unsigned char)(pk4_fp8(a1, a1, a1, a1) & 0xffu); }
                } else if (pn == 5) {
                    const float c = cosT[m * 32 + x], s = sinT[m * 32 + x]; unsigned char* KI8m = (unsigned char*)KI;
                    const float lo = a0 * c - a1 * s, hi = a1 * c + a0 * s;
                    KI8m[row * 64 + x] = (unsigned char)(pk4_fp8(lo, lo, lo, lo) & 0xffu); KI8m[row * 64 + 32 + x] = (unsigned char)(pk4_fp8(hi, hi, hi, hi) & 0xffu);
                } else {
                    CU[row * 512 + (pn - 6) * 128 + x] = (bf16_t)f2bf(a0 * a1);
                }
            }
        }
    }
}

template <bool FINAL> __device__ __forceinline__ void ln_phase(const float* z, const float* g, const float* bta, bf16_t* hb, float* stats, float* outf, int nrows, int gw, int NGW, int lane) {
    f32x4 gv[4], bv[4];
#pragma unroll
    for (int j = 0; j < 4; ++j) { gv[j] = *(const f32x4*)(g + 256 * j + 4 * lane); bv[j] = *(const f32x4*)(bta + 256 * j + 4 * lane); }
    f32x4 v[4], nv[4];
    if (gw < nrows) {
#pragma unroll
        for (int j = 0; j < 4; ++j) v[j] = *(const f32x4*)(z + (size_t)gw * DM + 256 * j + 4 * lane);
    }
    for (int row = gw; row < nrows; row += NGW) {
        float s = 0.f;
#pragma unroll
        for (int j = 0; j < 4; ++j) s += (v[j][0] + v[j][1]) + (v[j][2] + v[j][3]);
        const int nrow = row + NGW;
        if (nrow < nrows) {
#pragma unroll
            for (int j = 0; j < 4; ++j) nv[j] = *(const f32x4*)(z + (size_t)nrow * DM + 256 * j + 4 * lane);
        }
        const float mean = wave_sum(s) * (1.f / DM); float s2 = 0.f;
#pragma unroll
        for (int j = 0; j < 4; ++j) { v[j] = v[j] - mean; s2 += (v[j][0] * v[j][0] + v[j][1] * v[j][1]) + (v[j][2] * v[j][2] + v[j][3] * v[j][3]); }
        const float rstd = 1.f / sqrtf(wave_sum(s2) * (1.f / DM) + LN_EPS);
#pragma unroll
        for (int j = 0; j < 4; ++j) {
            const f32x4 y = v[j] * rstd * gv[j] + bv[j];
            if (FINAL) *(f32x4*)(outf + (size_t)row * DM + 256 * j + 4 * lane) = y;
            else { u32x2 w; w.x = pk2(y[0], y[1]); w.y = pk2(y[2], y[3]); *(u32x2*)(hb + (size_t)row * DM + 256 * j + 4 * lane) = w; }
        }
#pragma unroll
        for (int j = 0; j < 4; ++j) v[j] = nv[j];
        if (!FINAL && lane == 0) { stats[2 * row] = mean; stats[2 * row + 1] = rstd; }
    }
}

template <int MODE> __device__ __forceinline__ void lnres_phase(const float* x, const float* meta, const bf16_t* Y, const float* g, const float* bta, bf16_t* hb, float* outf, int nrows, int gw, int NGW, int lane) {
    f32x4 gv[4], bv[4];
#pragma unroll
    for (int j = 0; j < 4; ++j) { gv[j] = *(const f32x4*)(g + 256 * j + 4 * lane); bv[j] = *(const f32x4*)(bta + 256 * j + 4 * lane); }
    f32x4 v[4], nv[4]; u32x2 yv[4], nyv[4];
#define LNR_LOAD(dv, dy, row) do { \
        if (MODE == 0) { const float* src_ = (row) < NREAL ? x + (size_t)(row) * DM : meta + (size_t)(((row) - NREAL) & 15) * DM; \
            _Pragma("unroll") for (int j = 0; j < 4; ++j) dv[j] = *(const f32x4*)(src_ + 256 * j + 4 * lane); } \
        else { _Pragma("unroll") for (int j = 0; j < 4; ++j) { const u32x2 p_ = *(const u32x2*)(hb + (size_t)(row) * DM + 256 * j + 4 * lane); dv[j] = (f32x4){bf_lo(p_.x), bf_hi(p_.x), bf_lo(p_.y), bf_hi(p_.y)}; } } \
        _Pragma("unroll") for (int j = 0; j < 4; ++j) dy[j] = *(const u32x2*)(Y + (size_t)(row) * DM + 256 * j + 4 * lane); } while (0)
    if (gw < nrows) LNR_LOAD(v, yv, gw);
    for (int row = gw; row < nrows; row += NGW) {
        float s = 0.f;
#pragma unroll
        for (int j = 0; j < 4; ++j) { const f32x4 yy = {bf_lo(yv[j].x), bf_hi(yv[j].x), bf_lo(yv[j].y), bf_hi(yv[j].y)}; v[j] = v[j] * ALPHA + yy; s += (v[j][0] + v[j][1]) + (v[j][2] + v[j][3]); }
        const int nrow = row + NGW;
        if (nrow < nrows) LNR_LOAD(nv, nyv, nrow);
        const float mean = wave_sum(s) * (1.f / DM); float s2 = 0.f;
#pragma unroll
        for (int j = 0; j < 4; ++j) { v[j] = v[j] - mean; s2 += (v[j][0] * v[j][0] + v[j][1] * v[j][1]) + (v[j][2] * v[j][2] + v[j][3] * v[j][3]); }
        const float rstd = 1.f / sqrtf(wave_sum(s2) * (1.f / DM) + LN_EPS);
#pragma unroll
        for (int j = 0; j < 4; ++j) {
            const f32x4 y = v[j] * rstd * gv[j] + bv[j];
            if (MODE == 2) *(f32x4*)(outf + (size_t)row * DM + 256 * j + 4 * lane) = y;
            else { u32x2 w; w.x = pk2(y[0], y[1]); w.y = pk2(y[2], y[3]); *(u32x2*)(hb + (size_t)row * DM + 256 * j + 4 * lane) = w; }
        }
#pragma unroll
        for (int j = 0; j < 4; ++j) { v[j] = nv[j]; yv[j] = nyv[j]; }
    }
#undef LNR_LOAD
}

__device__ __forceinline__ void conv_phase(const bf16_t* CU, const bf16_t* GB, const float* cw, bf16_t* YCV, int gtid, int NT) {
    for (int it = gtid; it < NREAL * 64; it += NT) {
        const int row = it >> 6, c8 = (it & 63) * 8, s = row & (SEQ - 1);
        const size_t r0 = (size_t)row, r1 = s >= 1 ? (size_t)(row - 1) : (size_t)(NREAL + 15), r2 = s >= 2 ? (size_t)(row - 2) : (size_t)(NREAL + 14 + s);
        const u32x4 x0 = *(const u32x4*)(CU + r0 * 512 + c8), x1 = *(const u32x4*)(CU + r1 * 512 + c8), x2 = *(const u32x4*)(CU + r2 * 512 + c8), gb = *(const u32x4*)(GB + r0 * 512 + c8);
        float o[8];
#pragma unroll
        for (int h = 0; h < 4; ++h) {
            const unsigned a0 = h == 0 ? x0.x : h == 1 ? x0.y : h == 2 ? x0.z : x0.w, a1 = h == 0 ? x1.x : h == 1 ? x1.y : h == 2 ? x1.z : x1.w, a2 = h == 0 ? x2.x : h == 1 ? x2.y : h == 2 ? x2.z : x2.w, gg = h == 0 ? gb.x : h == 1 ? gb.y : h == 2 ? gb.z : gb.w;
            const int c = c8 + 2 * h;
            o[2 * h] = bf_lo(gg) * (cw[c] * bf_lo(a2) + cw[512 + c] * bf_lo(a1) + cw[1024 + c] * bf_lo(a0));
            o[2 * h + 1] = bf_hi(gg) * (cw[c + 1] * bf_hi(a2) + cw[512 + c + 1] * bf_hi(a1) + cw[1024 + c + 1] * bf_hi(a0));
        }
        u32x4 w; w.x = pk2(o[0], o[1]); w.y = pk2(o[2], o[3]); w.z = pk2(o[4], o[5]); w.w = pk2(o[6], o[7]);
        *(u32x4*)(YCV + r0 * 512 + c8) = w;
    }
}

__device__ __forceinline__ float relu_i(float x) { const int i = __builtin_bit_cast(int, x); return __builtin_bit_cast(float, i > 0 ? i : 0); }
__device__ __forceinline__ size_t seqrow(int b, int idx) { return idx < NMETA ? (size_t)(NREAL + idx) : (size_t)(b * SEQ + idx - NMETA); }

__device__ __forceinline__ void find_bin(LAS unsigned* hist, unsigned need, int lane, unsigned& bin, unsigned& above) {
    const u32x4 h = *(const LAS u32x4*)(hist + 252 - 4 * lane);
    const unsigned tot = h.x + h.y + h.z + h.w;
    unsigned incl = tot;
    incl += (unsigned)__builtin_amdgcn_update_dpp(0, (int)incl, 0x111, 0xf, 0xf, false);
    incl += (unsigned)__builtin_amdgcn_update_dpp(0, (int)incl, 0x112, 0xf, 0xf, false);
    incl += (unsigned)__builtin_amdgcn_update_dpp(0, (int)incl, 0x114, 0xf, 0xf, false);
    incl += (unsigned)__builtin_amdgcn_update_dpp(0, (int)incl, 0x118, 0xf, 0xf, false);
    incl += (unsigned)__builtin_amdgcn_update_dpp(0, (int)incl, 0x142, 0xa, 0xf, false);
    incl += (unsigned)__builtin_amdgcn_update_dpp(0, (int)incl, 0x143, 0xc, 0xf, false);
    const unsigned excl = incl - tot;
    const bool found = excl < need && need <= incl;
    unsigned a = excl, bsel = 0, asel = 0;
    if (a + h.w >= need) { bsel = 255 - 4 * lane; asel = a; }
    else { a += h.w; if (a + h.z >= need) { bsel = 254 - 4 * lane; asel = a; } else { a += h.z; if (a + h.y >= need) { bsel = 253 - 4 * lane; asel = a; } else { a += h.y; bsel = 252 - 4 * lane; asel = a; } } }
    const unsigned long long bal = __ballot(found);
    const int src = bal ? (int)__builtin_ctzll(bal) : 0;
    bin = (unsigned)__builtin_amdgcn_readlane((int)bsel, src); above = (unsigned)__builtin_amdgcn_readlane((int)asel, src);
}

__device__ __forceinline__ void attn_phase(const bf16_t* QS, const bf16_t* QI, const bf16_t* KV, const bf16_t* KI, const float* WI, bf16_t* ATT, const unsigned char* K8,
                                           LAS unsigned char* lds, int wave, int lane) {
    const int c32 = lane & 31, hi = lane >> 5, fr = lane & 15, fq = lane >> 4;
    LAS unsigned char* myreg = lds + wave * WREG;
    LAS unsigned short* myrow = (LAS unsigned short*)myreg;
    LAS unsigned* hist = (LAS unsigned*)(myreg + 16640);
    LAS unsigned short* list = (LAS unsigned short*)(myreg + 16640 + 1024);
    LAS unsigned char* vimg = myreg;
    LAS bf16_t* obuf = (LAS bf16_t*)(myreg);
    const int G = gridDim.x, cb = blockIdx.x;
    *(LAS u32x4*)(hist + 4 * lane) = (u32x4){0u, 0u, 0u, 0u};
    LDS_WAIT();
    __syncthreads();
    for (int p = cb; p < 4096; p += G) {
        const int b = p >> 9, pidx = p & 511;
#pragma unroll 1
        for (int half = 0; half < 2; ++half) {
            const int sblk = half ? 1023 - pidx : pidx, s0 = sblk * 8;
            const int rq0 = b * SEQ + s0;
            {
                const unsigned char* QI8 = (const unsigned char*)QI; const unsigned char* KI8 = (const unsigned char*)KI;
                u32x4 qa[4];
#pragma unroll
                for (int mt = 0; mt < 4; ++mt) qa[mt] = *(const u32x4*)(QI8 + (size_t)(rq0 + 2 * mt + (fr >> 3)) * 512 + (fr & 7) * 64 + 16 * fq);
                f32x4 wv[4];
#pragma unroll
                for (int mt = 0; mt < 4; ++mt) wv[mt] = *(const f32x4*)(WI + (size_t)(rq0 + 2 * mt + (fq >> 1)) * 8 + 4 * (fq & 1));
                const int nmax = NMETA + s0 + 8, ntile = (nmax + 15) >> 4;
                const int qa_ = 2 * (fq & 1) + (fq >> 1);
                asm volatile("" : "+v"(qa[0]), "+v"(qa[1]), "+v"(qa[2]), "+v"(qa[3]), "+v"(wv[0]), "+v"(wv[1]), "+v"(wv[2]), "+v"(wv[3]) :: "memory");
#define S1_LOAD(dst, tt) do { const int kk_ = 16 * (tt) + fr, kld_ = kk_ < nmax ? kk_ : nmax - 1; const unsigned char* kp_ = KI8 + seqrow(b, kld_) * 64 + 16 * fq; \
        asm volatile("global_load_dwordx4 %0, %1, off" : "=&v"(dst) : "v"(kp_) : "memory"); } while (0)
#define S1_WAIT(nn, dst) asm volatile("s_waitcnt vmcnt(" #nn ")" : "+v"(dst) :: "memory")
#define S1_TILE(kbv, tt) do { const int kk = 16 * (tt) + fr; float part_[4]; \
        const long kb0_ = (long)(((unsigned long long)kbv.y << 32) | kbv.x), kb1_ = (long)(((unsigned long long)kbv.w << 32) | kbv.z); \
        _Pragma("unroll") for (int mt = 0; mt < 4; ++mt) { f32x4 acc_ = {0.f, 0.f, 0.f, 0.f}; \
            acc_ = __builtin_amdgcn_mfma_f32_16x16x32_fp8_fp8((long)(((unsigned long long)qa[mt].y << 32) | qa[mt].x), kb0_, acc_, 0, 0, 0); \
            acc_ = __builtin_amdgcn_mfma_f32_16x16x32_fp8_fp8((long)(((unsigned long long)qa[mt].w << 32) | qa[mt].z), kb1_, acc_, 0, 0, 0); \
            const f32x4 w_ = wv[mt]; float p_ = 0.f; \
            _Pragma("unroll") for (int i = 0; i < 4; ++i) p_ = __builtin_fmaf(w_[i], relu_i(acc_[i]), p_); \
            part_[mt] = p_; } \
        _Pragma("unroll") for (int pr = 0; pr < 2; ++pr) { \
            auto rr_ = __builtin_amdgcn_permlane16_swap(__builtin_bit_cast(unsigned, part_[2 * pr]), __builtin_bit_cast(unsigned, part_[2 * pr + 1]), false, false); \
            const float tot_ = __builtin_bit_cast(float, (unsigned)rr_[0]) + __builtin_bit_cast(float, (unsigned)rr_[1]); \
            const int q = 4 * pr + qa_; const _Float16 hh = (_Float16)tot_; const unsigned hb = (unsigned)__builtin_bit_cast(unsigned short, hh); \
            unsigned key = (hb & 0x8000u) ? (~hb & 0xffffu) : (hb | 0x8000u); \
            const bool valid = kk <= NMETA + s0 + q; if (!valid) key = 0u; \
            *(LAS unsigned short*)(lds + q * WREG + kk * 2) = (unsigned short)key; \
            __hip_atomic_fetch_add((LAS unsigned*)(lds + q * WREG + 16640) + (key >> 8), valid ? 1u : 0u, __ATOMIC_RELAXED, __HIP_MEMORY_SCOPE_WORKGROUP); } } while (0)
                u32x4 kr0, kr1, kr2, kr3, kr4, kr5, kr6, kr7;
                S1_LOAD(kr0, wave); S1_LOAD(kr1, wave + NWAVES); S1_LOAD(kr2, wave + 2 * NWAVES); S1_LOAD(kr3, wave + 3 * NWAVES);
                S1_LOAD(kr4, wave + 4 * NWAVES); S1_LOAD(kr5, wave + 5 * NWAVES); S1_LOAD(kr6, wave + 6 * NWAVES); S1_LOAD(kr7, wave + 7 * NWAVES);
#define S1_STEP(kr, off) do { S1_WAIT(7, kr); if (t + (off) * NWAVES < ntile) { S1_TILE(kr, t + (off) * NWAVES); } S1_LOAD(kr, t + ((off) + 8) * NWAVES); } while (0)
                for (int t = wave; t < ntile; t += 8 * NWAVES) {
                    S1_STEP(kr0, 0); S1_STEP(kr1, 1); S1_STEP(kr2, 2); S1_STEP(kr3, 3); S1_STEP(kr4, 4); S1_STEP(kr5, 5); S1_STEP(kr6, 6); S1_STEP(kr7, 7);
                }
                S1_WAIT(0, kr0); S1_WAIT(0, kr1); S1_WAIT(0, kr2); S1_WAIT(0, kr3); S1_WAIT(0, kr4); S1_WAIT(0, kr5); S1_WAIT(0, kr6); S1_WAIT(0, kr7);
#undef S1_STEP
#undef S1_LOAD
#undef S1_WAIT
#undef S1_TILE
            }
            LDS_WAIT();
            __syncthreads();
            const int n = NMETA + s0 + wave + 1;
            const int cnt = n < 256 ? n : 256;
            if (n <= 256) {
#pragma unroll
                for (int i = 0; i < 4; ++i) { const int s = i * 64 + lane; list[s] = (unsigned short)(s < n ? s : 0); }
                LDS_WAIT();
                *(LAS u32x4*)(hist + 4 * lane) = (u32x4){0u, 0u, 0u, 0u};
            } else {
                unsigned b1, ab1; find_bin(hist, 256u, lane, b1, ab1);
                const unsigned c1 = hist[b1];
                if (c1 <= (unsigned)CAND_CAP) {
                    LAS unsigned short* cand = (LAS unsigned short*)(lds + 147456 + wave * 2048);
                    const unsigned need2 = 256u - ab1;
                    LDS_WAIT();
                    *(LAS u32x4*)(hist + 4 * lane) = (u32x4){0u, 0u, 0u, 0u};
                    const int nit8 = (n + 511) >> 9;
                    unsigned sel_cnt = 0, cand_cnt = 0;
                    u32x4 kwm = *(const LAS u32x4*)(myrow + 8 * lane);
                    for (int it = 0; it < nit8; ++it) {
                        const int i0 = 8 * (64 * it + lane);
                        const u32x4 kw = kwm;
                        kwm = *(const LAS u32x4*)(myrow + i0 + 512);
                        const unsigned k[8] = {kw.x & 0xffffu, kw.x >> 16, kw.y & 0xffffu, kw.y >> 16, kw.z & 0xffffu, kw.z >> 16, kw.w & 0xffffu, kw.w >> 16};
                        bool gt[8], cd[8]; unsigned cg = 0, cc = 0;
#pragma unroll
                        for (int j = 0; j < 8; ++j) { const bool in = i0 + j < n; const unsigned hj = k[j] >> 8; gt[j] = in && hj > b1; cd[j] = in && hj == b1; cg += gt[j] ? 1u : 0u; cc += cd[j] ? 1u : 0u; }
                        const unsigned v = cg | (cc << 16);
                        unsigned incl = v;
                        incl += (unsigned)__builtin_amdgcn_update_dpp(0, (int)incl, 0x111, 0xf, 0xf, false);
                        incl += (unsigned)__builtin_amdgcn_update_dpp(0, (int)incl, 0x112, 0xf, 0xf, false);
                        incl += (unsigned)__builtin_amdgcn_update_dpp(0, (int)incl, 0x114, 0xf, 0xf, false);
                        incl += (unsigned)__builtin_amdgcn_update_dpp(0, (int)incl, 0x118, 0xf, 0xf, false);
                        incl += (unsigned)__builtin_amdgcn_update_dpp(0, (int)incl, 0x142, 0xa, 0xf, false);
                        incl += (unsigned)__builtin_amdgcn_update_dpp(0, (int)incl, 0x143, 0xc, 0xf, false);
                        const unsigned excl = incl - v, tot = (unsigned)__builtin_amdgcn_readlane((int)incl, 63);
                        unsigned ps = sel_cnt + (excl & 0xffffu), pc = cand_cnt + (excl >> 16);
                        if (v != 0u) {
#pragma unroll
                            for (int j = 0; j < 8; ++j) {
                                if (gt[j] && ps < 256u) list[ps] = (unsigned short)(i0 + j);
                                if (cd[j] && pc < (unsigned)CAND_CAP) cand[pc] = (unsigned short)(i0 + j);
                                ps += gt[j] ? 1u : 0u; pc += cd[j] ? 1u : 0u;
                            }
                        }
                        sel_cnt += tot & 0xffffu; cand_cnt += tot >> 16;
                    }
                    LDS_WAIT();
                    for (unsigned i = lane; i < c1; i += 64) { const unsigned key = myrow[cand[i]]; __hip_atomic_fetch_add(hist + (key & 255u), 1u, __ATOMIC_RELAXED, __HIP_MEMORY_SCOPE_WORKGROUP); }
                    LDS_WAIT();
                    unsigned b2, ab2; find_bin(hist, need2, lane, b2, ab2);
                    const unsigned need_eq = need2 - ab2;
                    LDS_WAIT();
                    *(LAS u32x4*)(hist + 4 * lane) = (u32x4){0u, 0u, 0u, 0u};
                    unsigned out_cnt = ab1, eq_cnt = 0;
                    for (unsigned base = 0; base < c1; base += 64) {
                        const unsigned i = base + lane; const bool in = i < c1;
                        const unsigned idx = in ? (unsigned)cand[i] : 0u;
                        const unsigned lo = (unsigned)myrow[idx] & 255u;
                        const bool g2 = in && lo > b2, e2 = in && lo == b2;
                        const unsigned long long eqb = __ballot(e2);
                        const unsigned eq_rank = eq_cnt + __builtin_amdgcn_mbcnt_hi((unsigned)(eqb >> 32), __builtin_amdgcn_mbcnt_lo((unsigned)eqb, 0u));
                        const bool sel = g2 || (e2 && eq_rank < need_eq);
                        const unsigned long long sb = __ballot(sel);
                        const unsigned pos = out_cnt + __builtin_amdgcn_mbcnt_hi((unsigned)(sb >> 32), __builtin_amdgcn_mbcnt_lo((unsigned)sb, 0u));
                        if (sel && pos < 256u) list[pos] = (unsigned short)idx;
                        out_cnt += (unsigned)__popcll(sb); eq_cnt += (unsigned)__popcll(eqb);
                    }
                } else {
                const unsigned need2 = 256u - ab1;
                LDS_WAIT();
                *(LAS u32x4*)(hist + 4 * lane) = (u32x4){0u, 0u, 0u, 0u};
                LDS_WAIT();
                const int nit = (n + 255) >> 8;
                u32x2 kwn = *(const LAS u32x2*)(myrow + 4 * lane);
                for (int it = 0; it < nit; ++it) {
                    const int i0 = 4 * (64 * it + lane);
                    const u32x2 kw = kwn;
                    kwn = *(const LAS u32x2*)(myrow + i0 + 256);
                    const unsigned k0 = kw.x & 0xffffu, k1 = kw.x >> 16, k2 = kw.y & 0xffffu, k3 = kw.y >> 16;
                    if (i0 + 0 < n && (k0 >> 8) == b1) __hip_atomic_fetch_add(hist + (k0 & 255u), 1u, __ATOMIC_RELAXED, __HIP_MEMORY_SCOPE_WORKGROUP);
                    if (i0 + 1 < n && (k1 >> 8) == b1) __hip_atomic_fetch_add(hist + (k1 & 255u), 1u, __ATOMIC_RELAXED, __HIP_MEMORY_SCOPE_WORKGROUP);
                    if (i0 + 2 < n && (k2 >> 8) == b1) __hip_atomic_fetch_add(hist + (k2 & 255u), 1u, __ATOMIC_RELAXED, __HIP_MEMORY_SCOPE_WORKGROUP);
                    if (i0 + 3 < n && (k3 >> 8) == b1) __hip_atomic_fetch_add(hist + (k3 & 255u), 1u, __ATOMIC_RELAXED, __HIP_MEMORY_SCOPE_WORKGROUP);
                }
                LDS_WAIT();
                unsigned b2, ab2; find_bin(hist, need2, lane, b2, ab2);
                const unsigned T = (b1 << 8) | b2, need_eq = need2 - ab2;
                LDS_WAIT();
                *(LAS u32x4*)(hist + 4 * lane) = (u32x4){0u, 0u, 0u, 0u};
                unsigned sel_cnt = 0, eq_cnt = 0;
                u32x2 kwm = *(const LAS u32x2*)(myrow + 4 * lane);
                for (int it = 0; it < nit; ++it) {
                    const int i0 = 4 * (64 * it + lane);
                    const u32x2 kw = kwm;
                    kwm = *(const LAS u32x2*)(myrow + i0 + 256);
                    unsigned k[4] = {kw.x & 0xffffu, kw.x >> 16, kw.y & 0xffffu, kw.y >> 16};
                    unsigned cg = 0, ce = 0;
#pragma unroll
                    for (int j = 0; j < 4; ++j) { if (i0 + j >= n) k[j] = 0u; cg += (k[j] > T) ? 1u : 0u; ce += (k[j] == T) ? 1u : 0u; }
                    const unsigned v = cg | (ce << 16);
                    unsigned incl = v;
                    incl += (unsigned)__builtin_amdgcn_update_dpp(0, (int)incl, 0x111, 0xf, 0xf, false);
                    incl += (unsigned)__builtin_amdgcn_update_dpp(0, (int)incl, 0x112, 0xf, 0xf, false);
                    incl += (unsigned)__builtin_amdgcn_update_dpp(0, (int)incl, 0x114, 0xf, 0xf, false);
                    incl += (unsigned)__builtin_amdgcn_update_dpp(0, (int)incl, 0x118, 0xf, 0xf, false);
                    incl += (unsigned)__builtin_amdgcn_update_dpp(0, (int)incl, 0x142, 0xa, 0xf, false);
                    incl += (unsigned)__builtin_amdgcn_update_dpp(0, (int)incl, 0x143, 0xc, 0xf, false);
                    const unsigned excl = incl - v, tot = (unsigned)__builtin_amdgcn_readlane((int)incl, 63);
                    const unsigned pg = excl & 0xffffu, pe = excl >> 16;
                    const unsigned base_eq = eq_cnt < need_eq ? eq_cnt : need_eq;
                    unsigned r_eq = eq_cnt + pe;
                    unsigned pos = sel_cnt + pg + ((r_eq < need_eq ? r_eq : need_eq) - base_eq);
#pragma unroll
                    for (int j = 0; j < 4; ++j) {
                        const bool gt = k[j] > T, eq = k[j] == T;
                        const bool take = gt || (eq && r_eq < need_eq);
                        if (take && pos < 256u) list[pos] = (unsigned short)(i0 + j);
                        pos += take ? 1u : 0u; r_eq += eq ? 1u : 0u;
                    }
                    const unsigned tg = tot & 0xffffu, te = tot >> 16;
                    const unsigned e1 = eq_cnt + te;
                    sel_cnt += tg + ((e1 < need_eq ? e1 : need_eq) - base_eq); eq_cnt = e1;
                }
                            }
            }
            LDS_WAIT();
#ifdef PROBE_S3X2
            for (int rep3 = 0; rep3 < 2; ++rep3)
#endif
            {
                const int rq = rq0 + wave;
                long qb[4];
                {
                    const bool qv = fr < 8 && (fr >> 2) == (fq >> 1);
                    const bf16_t* qp = QS + (size_t)rq * 512 + (qv ? fr : 0) * 64 + ((32 * fq) & 63);
#pragma unroll
                    for (int s = 0; s < 4; ++s) {
                        const u32x4 w = *(const u32x4*)(qp + 8 * s);
                        const unsigned lo = pk4_fp8(bf_lo(w.x) * 8.f, bf_hi(w.x) * 8.f, bf_lo(w.y) * 8.f, bf_hi(w.y) * 8.f), hi = pk4_fp8(bf_lo(w.z) * 8.f, bf_hi(w.z) * 8.f, bf_lo(w.w) * 8.f, bf_hi(w.w) * 8.f);
                        qb[s] = qv ? (long)(((unsigned long long)hi << 32) | lo) : 0l;
                    }
                }
                const int vR = lane >> 4, vpc = lane & 15;
#define V_DMA(kk) do { _Pragma("unroll") for (int it = 0; it < 4; ++it) { const int rho_ = 8 * it + (lane >> 3), j_ = rho_ & 7, f_ = rho_ >> 3; \
        const int kidx_ = list[32 * (kk) + (j_ < 4 ? 4 * f_ + j_ : 12 + 4 * f_ + j_)]; \
        const unsigned char* gp_ = V8 + seqrow(b, kidx_) * 128 + 16 * ((lane & 7) ^ ((rho_ >> 1) & 7)); \
        __builtin_amdgcn_global_load_lds((const unsigned*)gp_, (LAS unsigned*)(vimg + ((kk) & 3) * 4096 + it * 1024), 16, 0, 0); } } while (0)
#define K_LOAD(dst, t) do { const int kidx_ = list[(t) * 16 + fr]; const unsigned char* kp_ = K8 + seqrow(b, kidx_) * 128 + 32 * fq; \
        dst[0] = *(const u32x4*)kp_; dst[1] = *(const u32x4*)(kp_ + 16); } while (0)
                const unsigned char* V8 = (const unsigned char*)KV;
                V_DMA(0); V_DMA(1); V_DMA(2); V_DMA(3);
                u32x4 ka[8][2];
#pragma unroll
                for (int t = 0; t < 8; ++t) K_LOAD(ka[t], t);
                f32x4 sc[16];
#pragma unroll
                for (int t = 0; t < 16; ++t) {
                    f32x4 acc = {0.f, 0.f, 0.f, 0.f};
#pragma unroll
                    for (int s = 0; s < 4; ++s) { const u32x4 kw_ = ka[t & 7][s >> 1]; const unsigned l_ = (s & 1) ? kw_.z : kw_.x, h_ = (s & 1) ? kw_.w : kw_.y;
                        acc = __builtin_amdgcn_mfma_f32_16x16x32_fp8_fp8((long)(((unsigned long long)h_ << 32) | l_), qb[s], acc, 0, 0, 0); }
                    sc[t] = acc * 0.125f;
                    if (t + 8 < 16) K_LOAD(ka[t & 7], t + 8);
                    __builtin_amdgcn_sched_barrier(0);
                }
#undef K_LOAD
                float mx = -INFINITY;
#pragma unroll
                for (int t = 0; t < 16; ++t)
#pragma unroll
                    for (int i = 0; i < 4; ++i) { if (16 * t + 4 * fq + i >= cnt) sc[t][i] = -INFINITY; mx = fmaxf(mx, sc[t][i]); }
                { auto r16 = __builtin_amdgcn_permlane16_swap(__builtin_bit_cast(unsigned, mx), __builtin_bit_cast(unsigned, mx), false, false);
                  mx = fmaxf(__builtin_bit_cast(float, (unsigned)r16[0]), __builtin_bit_cast(float, (unsigned)r16[1]));
                  auto r32 = __builtin_amdgcn_permlane32_swap(__builtin_bit_cast(unsigned, mx), __builtin_bit_cast(unsigned, mx), false, false);
                  mx = fmaxf(__builtin_bit_cast(float, (unsigned)r32[0]), __builtin_bit_cast(float, (unsigned)r32[1])); }
                float l = 0.f;
#pragma unroll
                for (int t = 0; t < 16; ++t)
#pragma unroll
                    for (int i = 0; i < 4; ++i) { const float e = __builtin_amdgcn_exp2f((sc[t][i] - mx) * 1.4426950408889634f); sc[t][i] = e; l += e; }
                { auto r16 = __builtin_amdgcn_permlane16_swap(__builtin_bit_cast(unsigned, l), __builtin_bit_cast(unsigned, l), false, false);
                  l = __builtin_bit_cast(float, (unsigned)r16[0]) + __builtin_bit_cast(float, (unsigned)r16[1]);
                  auto r32 = __builtin_amdgcn_permlane32_swap(__builtin_bit_cast(unsigned, l), __builtin_bit_cast(unsigned, l), false, false);
                  l = __builtin_bit_cast(float, (unsigned)r32[0]) + __builtin_bit_cast(float, (unsigned)r32[1]); }
                long pa[8];
#pragma unroll
                for (int kk = 0; kk < 8; ++kk) { const unsigned lo_ = pk4_fp8(sc[2 * kk][0], sc[2 * kk][1], sc[2 * kk][2], sc[2 * kk][3]), hi_ = pk4_fp8(sc[2 * kk + 1][0], sc[2 * kk + 1][1], sc[2 * kk + 1][2], sc[2 * kk + 1][3]); pa[kk] = (long)(((unsigned long long)hi_ << 32) | lo_); }
                f32x4 o[8];
#pragma unroll
                for (int nt = 0; nt < 8; ++nt) o[nt] = (f32x4){0.f, 0.f, 0.f, 0.f};
                const int vrow = 8 * fq + ((lane & 15) >> 1), vswz = (vrow >> 1) & 7;
                const LAS unsigned char* vb = vimg + vrow * 128 + 8 * (lane & 1);
                typedef int v2i32_t __attribute__((ext_vector_type(2)));
#define PV_STEP(kk) do { \
        if ((kk) <= 4) asm volatile("s_waitcnt vmcnt(12)" ::: "memory"); else if ((kk) == 5) asm volatile("s_waitcnt vmcnt(8)" ::: "memory"); else if ((kk) == 6) asm volatile("s_waitcnt vmcnt(4)" ::: "memory"); else asm volatile("s_waitcnt vmcnt(0)" ::: "memory"); \
        _Pragma("unroll") for (int nt = 0; nt < 8; ++nt) { \
            const v2i32_t vv_ = __builtin_amdgcn_ds_read_tr8_b64_v2i32((LAS v2i32_t*)(vb + ((kk) & 3) * 4096 + ((nt ^ vswz) << 4))); \
            o[nt] = __builtin_amdgcn_mfma_f32_16x16x32_fp8_fp8(pa[kk], (long)(((unsigned long long)(unsigned)vv_[1] << 32) | (unsigned)vv_[0]), o[nt], 0, 0, 0); } \
        LDS_WAIT(); \
        if ((kk) + 4 < 8) V_DMA((kk) + 4); __builtin_amdgcn_sched_barrier(0); } while (0)
                PV_STEP(0); PV_STEP(1); PV_STEP(2); PV_STEP(3); PV_STEP(4); PV_STEP(5); PV_STEP(6); PV_STEP(7);
#undef PV_STEP
#undef V_DMA
                LDS_WAIT();
                float linv[4];
#pragma unroll
                for (int i = 0; i < 4; ++i) linv[i] = 1.0f / __shfl(l, (4 * fq + i) & 7);
#pragma unroll
                for (int nt = 0; nt < 8; ++nt) {
                    if (fq == (nt >> 2)) {
#pragma unroll
                        for (int i = 0; i < 4; ++i) obuf[(4 * fq + i) * 64 + (nt & 3) * 16 + fr] = (bf16_t)f2bf(o[nt][i] * linv[i]);
                    }
                }
                LDS_WAIT();
                const u32x4 ov = *(const LAS u32x4*)((LAS unsigned char*)obuf + lane * 16);
                *(u32x4*)(ATT + (size_t)rq * 512 + lane * 8) = ov;
            }
            LDS_WAIT();
            __syncthreads();
        }
    }
}


#define XB_TMO      128
#define XB_XCNT(j)  (256  + 64 * (j))
#define XB_XSUB(j)  (1280 + 64 * (j))
#define XB_XGEN(j)  (2304 + 64 * (j))
#define XB_TOP      3328
#define XB_TOPGEN   3392
#define XCD_BAR_WORDS 3456
#define XB_SPIN_CAP (1u << 18)

__device__ __forceinline__ unsigned xb_ld(unsigned* p)              { return __hip_atomic_load(p, __ATOMIC_RELAXED, __HIP_MEMORY_SCOPE_AGENT); }
__device__ __forceinline__ unsigned xb_add(unsigned* p, unsigned v) { return __hip_atomic_fetch_add(p, v, __ATOMIC_RELAXED, __HIP_MEMORY_SCOPE_AGENT); }
__device__ __forceinline__ unsigned xb_xcc_id() { return (unsigned)__builtin_amdgcn_s_getreg((3 << 11) | 20) & 0xFu; }
#define XB_SPIN(cond, bar) do { unsigned _sp = 0; while (cond) { __builtin_amdgcn_s_sleep(1); \
    if ((++_sp & 255u) == 0u) { if (xb_ld(&(bar)[XB_TMO])) break; if (_sp > XB_SPIN_CAP) { atomicAdd(&(bar)[XB_TMO], 1u); break; } } } } while (0)

struct XcdBarrier {
    unsigned* bar; unsigned x;
    volatile LAS unsigned* st;
};

__device__ __forceinline__ XcdBarrier xcd_barrier_post(unsigned* bar, volatile LAS unsigned* st) {
    XcdBarrier b; b.bar = bar; b.x = xb_xcc_id(); b.st = st;
    if (threadIdx.x == 0) (void)xb_add(&bar[XB_XCNT(b.x)], 1u);
    return b;
}
__device__ __forceinline__ void xcd_barrier_complete(unsigned* bar, unsigned x, unsigned& nloc, unsigned& nx) {
    const unsigned G = gridDim.x * gridDim.y * gridDim.z;
    unsigned sum, cnt, mine, sp = 0u;
    for (;;) {
        sum = 0u; cnt = 0u; mine = 0u;
#pragma unroll
        for (unsigned j = 0; j < 16; ++j) { const unsigned c = xb_ld(&bar[XB_XCNT(j)]); sum += c; cnt += (c > 0u) ? 1u : 0u; mine = (j == x) ? c : mine; }
        if (sum == G) break;
        __builtin_amdgcn_s_sleep(1);
        if ((++sp & 255u) == 0u) { if (xb_ld(&bar[XB_TMO])) break; if (sp > XB_SPIN_CAP) { atomicAdd(&bar[XB_TMO], 1u); break; } }
    }
    nloc = mine > 0u ? mine : 1u; nx = cnt > 0u ? cnt : 1u;
}

__device__ __forceinline__ void xcd_barrier(const XcdBarrier& b) {
    asm volatile("s_waitcnt vmcnt(0)" ::: "memory");
    __syncthreads();
    if (threadIdx.x == 0) {
        unsigned* bar = b.bar;
        __builtin_amdgcn_s_waitcnt(0);
        unsigned nloc = b.st[0], nx = b.st[1];
        if (nloc == 0u) { xcd_barrier_complete(bar, b.x, nloc, nx); b.st[0] = nloc; b.st[1] = nx; }
        const unsigned old = xb_add(&bar[XB_XSUB(b.x)], 1u);
        const unsigned gen = old / nloc;
        if (old + 1u == (gen + 1u) * nloc) {
            __builtin_amdgcn_fence(__ATOMIC_RELEASE, "agent");
            asm volatile("s_waitcnt vmcnt(0)" ::: "memory");
            const unsigned og = xb_add(&bar[XB_TOP], 1u);
            const unsigned tg = og / nx;
            if (og + 1u == (tg + 1u) * nx) xb_add(&bar[XB_TOPGEN], 1u);
            else XB_SPIN(xb_ld(&bar[XB_TOPGEN]) == tg, bar);
            __builtin_amdgcn_fence(__ATOMIC_ACQUIRE, "agent");
            xb_add(&bar[XB_XGEN(b.x)], 1u);
            asm volatile("s_waitcnt vmcnt(0)" ::: "memory");
        } else {
            XB_SPIN(xb_ld(&bar[XB_XGEN(b.x)]) == gen, bar);
            __builtin_amdgcn_fence(__ATOMIC_ACQUIRE, "agent");
            asm volatile("s_waitcnt vmcnt(0)" ::: "memory");
        }
    }
    __syncthreads();
}

__global__ void __launch_bounds__(NWAVES * 64, 2) mk_fwd(Args a) {
    extern __shared__ __attribute__((aligned(16))) unsigned char lds_raw[];
    LAS unsigned char* lds = (LAS unsigned char*)lds_raw;
    const int tid = threadIdx.x, lane = tid & 63, wave = __builtin_amdgcn_readfirstlane(tid >> 6);
    const int G = gridDim.x, gw = blockIdx.x * NWAVES + wave, NGW = G * NWAVES;
    unsigned char* ws = a.ws;
    bf16_t* AB = (bf16_t*)(ws + OFF_AB); float* Z = (float*)(ws + OFF_Z); bf16_t* HFF = (bf16_t*)(ws + OFF_BIG);
    float* ST1 = (float*)(ws + OFF_ST1); float* ST2 = (float*)(ws + OFF_ST2);
    const int lo = a.ph_lo, hi = a.ph_hi;
    volatile LAS unsigned* bst = (volatile LAS unsigned*)(lds + LDS_BST);
    if (tid < 2) bst[tid] = 0u;
    __syncthreads();
    XcdBarrier gbar = xcd_barrier_post((unsigned*)(ws + OFF_CTL), bst);
#define IN(k) (lo <= (k) && (k) < hi)
#define SEAM(k) do { if (IN(k) && IN((k) + 1)) { if ((k) == 0) cooperative_groups::this_grid().sync(); else xcd_barrier(gbar); } } while (0)

    if (IN(0)) { p0_prologue(a, lds, gw, NGW, wave, lane, 7);
#ifdef PROBE_P0_PARTS
        p0_prologue(a, lds, gw, NGW, wave, lane, PROBE_P0_PARTS);
#endif
 }
    SEAM(0);
#ifdef PROBE_SYNC10
    for (int r_ = 0; r_ < 10; ++r_) cooperative_groups::this_grid().sync();
#endif
    if (IN(1)) { pg8::Gemm g{AB, (const bf16_t*)(ws + OFF_WGU1), NREAL, 5632, 1024}; pg8::StaticOrder S; S.init(NREAL, 5632, G, (int)blockIdx.x);
        EpiSwiglu E{HFF}; pg8::gemm_phase<EpiSwiglu, pg8::StaticOrder, true, true>(lds, g, S, E);
        skinny_meta<0>(AB + (size_t)NREAL * DM, DM, (const bf16_t*)(ws + OFF_WGU1), 1024, 22 * 8, gw, NGW, lane, HFF, nullptr, nullptr, nullptr, nullptr, nullptr, nullptr, nullptr); }
    SEAM(1);
    bf16_t* Y12 = (bf16_t*)a.out;
    bf16_t* Y3 = (bf16_t*)(ws + OFF_ATT);
    if (IN(2)) { pg8::Gemm g{HFF, (const bf16_t*)(ws + OFF_WD1), NREAL, 1024, FF}; pg8::StaticOrder S; S.init(NREAL, 1024, G, (int)blockIdx.x);
        EpiY E{Y12, 0.5f}; pg8::gemm_phase<EpiY, pg8::StaticOrder, true, true>(lds, g, S, E);
        skinny_meta<1>(HFF + (size_t)NREAL * FF, FF, (const bf16_t*)(ws + OFF_WD1), FF, 64, gw, NGW, lane, Y12, nullptr, nullptr, nullptr, nullptr, nullptr, nullptr, nullptr); }
    SEAM(2);
    if (IN(3)) { lnres_phase<0>(a.x, a.meta, Y12, a.ln1g, a.ln1b, AB, nullptr, NREAL + NMETA, gw, NGW, lane); }
    SEAM(3);
    if (IN(4)) { pg8::Gemm g{AB, (const bf16_t*)(ws + OFF_WIN), NREAL, 3072, 1024}; pg8::StaticOrder S; S.init(NREAL, 3072, G, (int)blockIdx.x);
        skinny_meta<2>(AB + (size_t)NREAL * DM, DM, (const bf16_t*)(ws + OFF_WIN), 1024, 42, gw, NGW, lane, (bf16_t*)(ws + OFF_K8), nullptr, nullptr, (bf16_t*)(ws + OFF_V8), (bf16_t*)(ws + OFF_KI8), (bf16_t*)(ws + OFF_CU), (const float*)(ws + OFF_COS), (const float*)(ws + OFF_SIN));
        EpiProj E{(bf16_t*)(ws + OFF_QS), (bf16_t*)(ws + OFF_QI), (bf16_t*)(ws + OFF_KV), (bf16_t*)(ws + OFF_KI), (bf16_t*)(ws + OFF_CU), (bf16_t*)(ws + OFF_GB), (float*)(ws + OFF_WI), (const float*)(ws + OFF_COS), (const float*)(ws + OFF_SIN), (unsigned char*)(ws + OFF_K8), (unsigned char*)(ws + OFF_QI8), (unsigned char*)(ws + OFF_KI8), (unsigned char*)(ws + OFF_V8)};
        pg8::gemm_phase<EpiProj, pg8::StaticOrder, true, true>(lds, g, S, E); }
    SEAM(4);
    if (IN(5)) {
        conv_phase((const bf16_t*)(ws + OFF_CU), (const bf16_t*)(ws + OFF_GB), a.convw, (bf16_t*)(ws + OFF_YCV), blockIdx.x * 512 + tid, G * 512);
#ifdef DBG_SKIP_ATTN
        for (int it = blockIdx.x * 512 + tid; it < NREAL * 64; it += G * 512) *(u32x4*)((bf16_t*)(ws + OFF_ATT) + (size_t)it * 8) = (u32x4){0u, 0u, 0u, 0u};
#else
        attn_phase((const bf16_t*)(ws + OFF_QS), (const bf16_t*)(ws + OFF_QI8), (const bf16_t*)(ws + OFF_V8), (const bf16_t*)(ws + OFF_KI8), (const float*)(ws + OFF_WI), (bf16_t*)(ws + OFF_ATT), (const unsigned char*)(ws + OFF_K8), lds, wave, lane);
#ifdef PROBE_ATTN2
        attn_phase((const bf16_t*)(ws + OFF_QS), (const bf16_t*)(ws + OFF_QI8), (const bf16_t*)(ws + OFF_V8), (const bf16_t*)(ws + OFF_KI8), (const float*)(ws + OFF_WI), (bf16_t*)(ws + OFF_ATT), (const unsigned char*)(ws + OFF_K8), lds, wave, lane);
#endif
#endif
    }
    SEAM(5);
    if (IN(6)) {
        bf16_t* S1 = (bf16_t*)(ws + OFF_S1); bf16_t* S2 = (bf16_t*)(ws + OFF_S2);
#ifdef DBG_E1_M
        pg8::StaticOrder S; S.init(DBG_E1_M, 1024, G, (int)blockIdx.x);
        { pg8::Gemm g{AB, (const bf16_t*)(ws + OFF_WGA), DBG_E1_M, 1024, 1024};
#else
        pg8::StaticOrder S; S.init(NREAL, 1024, G, (int)blockIdx.x);
        { pg8::Gemm g{AB, (const bf16_t*)(ws + OFF_WGA), NREAL, 1024, 1024};
#endif
 EpiGate<0> E{S1, nullptr}; pg8::gemm_phase<EpiGate<0>, pg8::StaticOrder, true, true>(lds, g, S, E); }
#ifndef DBG_NO_E3
        { pg8::Gemm g{AB, (const bf16_t*)(ws + OFF_WGC), NREAL, 1024, 1024}; EpiGate<0> E{S2, nullptr}; pg8::gemm_phase<EpiGate<0>, pg8::StaticOrder, true, true>(lds, g, S, E); }
#endif
    }
    if (IN(6)) {
        bf16_t* S1 = (bf16_t*)(ws + OFF_S1);
        pg8::StaticOrder S; S.init(NREAL, 1024, G, (int)blockIdx.x);
        pg8::Gemm g{(const bf16_t*)(ws + OFF_ATT), (const bf16_t*)(ws + OFF_WAO), NREAL, 1024, 512}; EpiGate<1> E{S1, nullptr}; pg8::gemm_phase<EpiGate<1>, pg8::StaticOrder, true, true>(lds, g, S, E);
    }
    if (IN(6)) {
        bf16_t* S1 = (bf16_t*)(ws + OFF_S1); bf16_t* S2 = (bf16_t*)(ws + OFF_S2);
        pg8::StaticOrder S; S.init(NREAL, 1024, G, (int)blockIdx.x);
        pg8::Gemm g{(const bf16_t*)(ws + OFF_YCV), (const bf16_t*)(ws + OFF_WCO), NREAL, 1024, 512}; EpiGate<2> E{S1, S2}; pg8::gemm_phase<EpiGate<2>, pg8::StaticOrder, true, true>(lds, g, S, E);
    }
    SEAM(8);
    if (IN(9)) { pg8::Gemm g{(const bf16_t*)(ws + OFF_S1), (const bf16_t*)(ws + OFF_WO), NREAL, 1024, 1024}; pg8::StaticOrder S; S.init(NREAL, 1024, G, (int)blockIdx.x);
        EpiY E{Y12, 1.0f}; pg8::gemm_phase<EpiY, pg8::StaticOrder, true, true>(lds, g, S, E); }
    SEAM(9);
    if (IN(10)) { lnres_phase<1>(nullptr, nullptr, Y12, a.ln2g, a.ln2b, AB, nullptr, NREAL, gw, NGW, lane); }
    SEAM(10);
    if (IN(11)) { pg8::Gemm g{AB, (const bf16_t*)(ws + OFF_WGU2), NREAL, 5632, 1024}; pg8::StaticOrder S; S.init(NREAL, 5632, G, (int)blockIdx.x);
        EpiSwiglu E{HFF}; pg8::gemm_phase<EpiSwiglu, pg8::StaticOrder, true, true>(lds, g, S, E); }
    SEAM(11);
    if (IN(12)) { pg8::Gemm g{HFF, (const bf16_t*)(ws + OFF_WD2), NREAL, 1024, FF}; pg8::StaticOrder S; S.init(NREAL, 1024, G, (int)blockIdx.x);
        EpiY E{Y3, 0.5f}; pg8::gemm_phase<EpiY, pg8::StaticOrder, true, true>(lds, g, S, E); }
    SEAM(12);
    if (IN(13)) { lnres_phase<2>(nullptr, nullptr, Y3, a.ln3g, a.ln3b, AB, a.out, NREAL, gw, NGW, lane); }
#ifdef DBG_STOP
    if (lo == 100) {
        const int gt = blockIdx.x * 512 + tid, NT = G * 512;
        for (int it = gt; it < NREAL * 256; it += NT) {
            const int row = it >> 8, c4 = (it & 255) * 4; f32x4 v;
#ifdef DBG_DUMP_INPUTS
            if (c4 < 512) { const u32x2 w = *(const u32x2*)(AB + (size_t)row * DM + c4); v = (f32x4){bf_lo(w.x), bf_hi(w.x), bf_lo(w.y), bf_hi(w.y)}; }
            else if (row < 2048) { const u32x2 w = *(const u32x2*)((const bf16_t*)(ws + OFF_WGA) + (size_t)row * 512 + (c4 - 512)); v = (f32x4){bf_lo(w.x), bf_hi(w.x), bf_lo(w.y), bf_hi(w.y)}; }
            else v = (f32x4){0.f, 0.f, 0.f, 0.f};
#else
            if (DBG_STOP == 2 || DBG_STOP == 9) v = *(const f32x4*)(Z + (size_t)row * DM + c4);
            else if (DBG_STOP == 3 || DBG_STOP == 10) { const u32x2 w = *(const u32x2*)(AB + (size_t)row * DM + c4); v = (f32x4){bf_lo(w.x), bf_hi(w.x), bf_lo(w.y), bf_hi(w.y)}; }
            else if (DBG_STOP == 1 || DBG_STOP == 11) { const u32x2 w = *(const u32x2*)(HFF + (size_t)row * FF + c4); v = (f32x4){bf_lo(w.x), bf_hi(w.x), bf_lo(w.y), bf_hi(w.y)}; }
            else if (DBG_STOP == 4) { const bf16_t* src = c4 < 512 ? (const bf16_t*)(ws + OFF_QS) + (size_t)row * 512 + c4 : (const bf16_t*)(ws + OFF_CU) + (size_t)row * 512 + (c4 - 512); const u32x2 w = *(const u32x2*)src; v = (f32x4){bf_lo(w.x), bf_hi(w.x), bf_lo(w.y), bf_hi(w.y)}; }
            else if (DBG_STOP == 5) { const bf16_t* src = c4 < 512 ? (const bf16_t*)(ws + OFF_ATT) + (size_t)row * 512 + c4 : (const bf16_t*)(ws + OFF_YCV) + (size_t)row * 512 + (c4 - 512); const u32x2 w = *(const u32x2*)src; v = (f32x4){bf_lo(w.x), bf_hi(w.x), bf_lo(w.y), bf_hi(w.y)}; }
            else { const u32x2 w = *(const u32x2*)((const bf16_t*)(ws + OFF_S1) + (size_t)row * DM + c4); v = (f32x4){bf_lo(w.x), bf_hi(w.x), bf_lo(w.y), bf_hi(w.y)}; }
#endif
            *(f32x4*)(a.out + (size_t)row * DM + c4) = v;
        }
    }
#endif
#undef IN
#undef SEAM
}

extern "C" void kernel_launch(void* const* d_in, const int* in_sizes, int n_in, void* d_out, int out_size, void* d_ws, size_t ws_size, hipStream_t stream) {
    static int grid = 0;
    if (grid == 0) {
        if (n_in != 19 || in_sizes[0] != NREAL * DM || out_size != NREAL * DM || ws_size < WS_END) {
            fprintf(stderr, "kernel_launch: unexpected shapes (n_in %d, in0 %d, out %d, ws %zu, need %zu); nothing launched\n", n_in, n_in > 0 ? in_sizes[0] : -1, out_size, ws_size, (size_t)WS_END);
            grid = -1; return; }
        int dev = 0, cus = 0, per_cu = 0;
        (void)hipGetDevice(&dev); (void)hipDeviceGetAttribute(&cus, hipDeviceAttributeMultiprocessorCount, dev);
        (void)hipFuncSetAttribute((const void*)mk_fwd, hipFuncAttributeMaxDynamicSharedMemorySize, LDS_BYTES);
        (void)hipOccupancyMaxActiveBlocksPerMultiprocessor(&per_cu, (const void*)mk_fwd, NWAVES * 64, LDS_BYTES);
        if (per_cu < 1) { fprintf(stderr, "kernel_launch: occupancy query says %d blocks per CU\n", per_cu); per_cu = 1; }
        (void)hipGetLastError();
        grid = cus;
    }
    if (grid < 0) return;
    Args a{};
    a.x = (const float*)d_in[0]; a.meta = (const float*)d_in[1];
    a.f1g = (const float*)d_in[2]; a.f1u = (const float*)d_in[3]; a.f1d = (const float*)d_in[4]; a.ln1g = (const float*)d_in[5]; a.ln1b = (const float*)d_in[6];
    a.win = (const float*)d_in[7]; a.convw = (const float*)d_in[8]; a.wao = (const float*)d_in[9]; a.wco = (const float*)d_in[10]; a.wo = (const float*)d_in[11];
    a.ln2g = (const float*)d_in[12]; a.ln2b = (const float*)d_in[13]; a.f2g = (const float*)d_in[14]; a.f2u = (const float*)d_in[15]; a.f2d = (const float*)d_in[16];
    a.ln3g = (const float*)d_in[17]; a.ln3b = (const float*)d_in[18];
    a.out = (float*)d_out; a.ws = (unsigned char*)d_ws;
    (void)hipMemsetAsync((char*)d_ws + OFF_CTL, 0, SZ_CTL, stream);
#if ONE_LAUNCH
    a.ph_lo = 0; a.ph_hi = NPH;
    void* kargs[] = {&a};
    hipError_t e = hipLaunchCooperativeKernel((const void*)mk_fwd, dim3(grid), dim3(NWAVES * 64), kargs, LDS_BYTES, stream);
    if (e != hipSuccess) fprintf(stderr, "cooperative launch failed: %s (grid %d)\n", hipGetErrorString(e), grid);
#else
#ifdef DBG_STOP
    for (int ph = 0; ph <= DBG_STOP; ++ph) {
        a.ph_lo = ph; a.ph_hi = ph + 1;
        hipLaunchKernelGGL(mk_fwd, dim3(grid), dim3(NWAVES * 64), LDS_BYTES, stream, a);
    }
    a.ph_lo = 100; a.ph_hi = 101;
    hipLaunchKernelGGL(mk_fwd, dim3(grid), dim3(NWAVES * 64), LDS_BYTES, stream, a);
#else
    for (int ph = 0; ph < NPH; ++ph) {
        a.ph_lo = ph; a.ph_hi = ph + 1;
        hipLaunchKernelGGL(mk_fwd, dim3(grid), dim3(NWAVES * 64), LDS_BYTES, stream, a);
    }
#endif
#endif
}
```

```cpp
#define ONE_LAUNCH 1
#include <hip/hip_runtime.h>
#include <hip/hip_cooperative_groups.h>
#include <cstdio>
#include <cstdint>
#include <cmath>
namespace pg8 {
#define PG8_LAS __attribute__((address_space(3)))
typedef unsigned short bf16_t;
typedef short bf16x8 __attribute__((ext_vector_type(8)));
typedef float f32x4 __attribute__((ext_vector_type(4)));
typedef unsigned u32x4 __attribute__((ext_vector_type(4)));
constexpr int BM = 256, BK = 64, HALF = 128, HTB = HALF * BK * 2  , STAGE_BYTES = 8 * HTB, NXCD = 8, WGM = 8;

__host__ __device__ __forceinline__ int lds_byte(int r, int c) { const int st = (r >> 4) * 2 + (c >> 5), rr = r & 15, cc = c & 31, ob = rr * 64 + cc * 2; return st * 1024 + (ob ^ (((ob >> 9) & 1) << 5)); }
__host__ __device__ __forceinline__ void stage_rc(int b, int& R, int& C) { const int st = b / 1024, sb = b % 1024, swz = sb ^ (((sb >> 9) & 1) << 5); R = (st >> 1) * 16 + swz / 64; C = (st & 1) * 32 + (swz % 64) / 2; }
__host__ __device__ __forceinline__ int perm32(int rho) { const int n = rho >> 4, i = rho & 15; return 8 * (i >> 2) + 4 * n + (i & 3); }

struct Unit { int pm, pn; };
struct Gemm { const bf16_t* A; const bf16_t* Bt; int M, N, K; };

struct StaticOrder {
    int nM, nN, nwg, G, c;
    __host__ __device__ void init(int M, int N, int G_, int c_) { nM = M / BM; nN = N / BM; nwg = nM * nN; G = G_; c = c_; }
    __host__ __device__ bool next(int i, Unit& u) const {
        const long L = (long)i * G + c; if (L >= nwg) return false;
        int wgid = (int)L; { const int q = nwg / NXCD, r = nwg % NXCD, xcd = wgid % NXCD, off = wgid / NXCD; wgid = (xcd < r ? xcd * (q + 1) : r * (q + 1) + (xcd - r) * q) + off; }
        const int nig = WGM * nN, gid = wgid / nig, fm = gid * WGM, gsz = (nM - fm) < WGM ? (nM - fm) : WGM;
        u.pm = fm + ((wgid % nig) % gsz); u.pn = (wgid % nig) / gsz; return true;
    }
    __device__ __forceinline__ void a_ready(const Unit&) const {}
    __device__ __forceinline__ void done(const Unit&) const {}
};

__device__ __forceinline__ unsigned cvt_pk_bf16(float lo, float hi) { unsigned r; asm volatile("v_cvt_pk_bf16_f32 %0, %1, %2" : "=v"(r) : "v"(lo), "v"(hi)); return r; }
template <class Epi, class Sched, bool ALIGN_EPI = false, bool SP2 = false>
__device__ __forceinline__ void gemm_phase(PG8_LAS unsigned char* lds, const Gemm g, const Sched& S, const Epi& E) {
    const int tid = threadIdx.x, wid = __builtin_amdgcn_readfirstlane(tid >> 6), lane = tid & 63, wr = wid >> 2, wc = wid & 3, fr = lane & 15, fq = lane >> 4;
    const int K = g.K, nt = K / BK;
    unsigned voffA[2], voffB[2];
#pragma unroll
    for (int i = 0; i < 2; ++i) { int R, C; stage_rc(tid * 16 + i * 8192, R, C); const int Rb = Epi::PERM ? ((R & ~31) + perm32(R & 31)) : R;
        voffA[i] = (unsigned)(R * K + C) * 2u; voffB[i] = (unsigned)(Rb * K + C) * 2u; }
    const size_t kstep = (size_t)(BK * 2);
    const size_t hstep = (size_t)HALF * K * 2;
    const size_t tstep = 2 * hstep;
    const unsigned ldsw = (unsigned)wid * 1024u;
    const int aoff = lds_byte(wr * 64 + fr, fq * 8), boff = lds_byte(wc * 32 + fr, fq * 8);
#define PG8_SA(b, h) (((b) * 2 + (h)) * HTB)
#define PG8_SB(b, h) ((4 + (b) * 2 + (h)) * HTB)
#define PG8_STAGE(bufoff, gbase, voff) do { _Pragma("unroll") for (int _i = 0; _i < 2; ++_i) \
        __builtin_amdgcn_global_load_lds((const unsigned*)((const char*)(gbase) + (voff)[_i]), (PG8_LAS unsigned*)(lds + (bufoff) + ldsw + _i * 8192), 16, 0, 0); } while (0)
#define PG8_LDA(dst, b, h) do { _Pragma("unroll") for (int m = 0; m < 4; ++m) _Pragma("unroll") for (int k = 0; k < 2; ++k) dst[m][k] = *(const PG8_LAS bf16x8*)(lds + PG8_SA(b, h) + aoff + m * 2048 + k * 1024); } while (0)
#define PG8_LDB(dst, b, h) do { _Pragma("unroll") for (int n = 0; n < 2; ++n) _Pragma("unroll") for (int k = 0; k < 2; ++k) dst[n][k] = *(const PG8_LAS bf16x8*)(lds + PG8_SB(b, h) + boff + n * 2048 + k * 1024); } while (0)
#define PG8_MMA(ai, bj, At, Bt) do { __builtin_amdgcn_s_setprio(1); _Pragma("unroll") for (int m = 0; m < 4; ++m) _Pragma("unroll") for (int n = 0; n < 2; ++n) _Pragma("unroll") for (int k = 0; k < 2; ++k) \
        acc[ai][bj][m][n] = __builtin_amdgcn_mfma_f32_16x16x32_bf16(Bt[n][k], At[m][k], acc[ai][bj][m][n], 0, 0, 0); __builtin_amdgcn_s_setprio(0); } while (0)
#define PG8_WAIT_V(n) asm volatile("s_waitcnt vmcnt(" #n ")" ::: "memory")
#define PG8_WAIT_L(n) asm volatile("s_waitcnt lgkmcnt(" #n ")" ::: "memory")
#define PG8_BAR __builtin_amdgcn_s_barrier()
#define PG8_SCHED __builtin_amdgcn_sched_barrier(0)
    Unit cur, nxt; int ui = 0;
    if (!S.next(0, cur)) return;
    f32x4 acc[2][2][4][2];
#pragma unroll
    for (int a = 0; a < 2; ++a)
#pragma unroll
        for (int b = 0; b < 2; ++b)
#pragma unroll
            for (int m = 0; m < 4; ++m)
#pragma unroll
                for (int n = 0; n < 2; ++n) acc[a][b][m][n] = (f32x4){0.f, 0.f, 0.f, 0.f};
    bf16x8 At[4][2], B0[2][2], B1[2][2];
    const char* cA = (const char*)g.A + (size_t)cur.pm * tstep; const char* cB = (const char*)g.Bt + (size_t)cur.pn * tstep;
    S.a_ready(cur);
    if constexpr (SP2) {
        PG8_STAGE(PG8_SB(0, 0), cB, voffB); PG8_STAGE(PG8_SB(0, 1), cB + hstep, voffB); PG8_STAGE(PG8_SA(0, 0), cA, voffA); PG8_STAGE(PG8_SA(0, 1), cA + hstep, voffA);
        if (wr == 1) PG8_BAR;
        PG8_WAIT_V(2); PG8_BAR;
        PG8_STAGE(PG8_SB(1, 0), cB + kstep, voffB); PG8_STAGE(PG8_SA(1, 0), cA + kstep, voffA); PG8_STAGE(PG8_SB(1, 1), cB + hstep + kstep, voffB);
        PG8_WAIT_V(6); PG8_BAR;
    } else {
        PG8_STAGE(PG8_SB(0, 0), cB, voffB); PG8_STAGE(PG8_SA(0, 0), cA, voffA); PG8_STAGE(PG8_SB(0, 1), cB + hstep, voffB); PG8_STAGE(PG8_SA(0, 1), cA + hstep, voffA);
        if (wr == 1) PG8_BAR;
        PG8_WAIT_V(4); PG8_BAR;
        PG8_STAGE(PG8_SB(1, 0), cB + kstep, voffB); PG8_STAGE(PG8_SA(1, 0), cA + kstep, voffA); PG8_STAGE(PG8_SB(1, 1), cB + hstep + kstep, voffB);
        PG8_WAIT_V(6); PG8_BAR;
    }
    for (;;) {
        const bool has_next = S.next(ui + 1, nxt);
        const char* nA = has_next ? (const char*)g.A + (size_t)nxt.pm * tstep : cA; const char* nB = has_next ? (const char*)g.Bt + (size_t)nxt.pn * tstep : cB;
        for (int t = 0; t < nt; t += 2) {
            const bool last = (t == nt - 2);
            const char* a1 = cA + (size_t)(t + 1) * kstep;
            const char* a2 = last ? nA : cA + (size_t)(t + 2) * kstep; const char* b2 = last ? nB : cB + (size_t)(t + 2) * kstep;
            const char* a3 = a2 + kstep; const char* b3 = b2 + kstep;
            if (last && has_next) S.a_ready(nxt);
            if constexpr (SP2) {
            PG8_LDB(B0, 0, 0); PG8_LDB(B1, 0, 1); PG8_SCHED; PG8_LDA(At, 0, 0); PG8_STAGE(PG8_SA(1, 1), a1 + hstep, voffA);
            PG8_WAIT_V(8); PG8_WAIT_L(0); PG8_BAR; PG8_MMA(0, 0, At, B0); PG8_MMA(0, 1, At, B1); PG8_BAR; PG8_SCHED;
            PG8_LDA(At, 0, 1); PG8_STAGE(PG8_SB(0, 0), b2, voffB); PG8_STAGE(PG8_SB(0, 1), b2 + hstep, voffB); PG8_STAGE(PG8_SA(0, 0), a2, voffA);
            PG8_WAIT_V(8); PG8_WAIT_L(0); PG8_BAR; PG8_MMA(1, 0, At, B0); PG8_MMA(1, 1, At, B1); PG8_BAR; PG8_SCHED;
            PG8_LDB(B0, 1, 0); PG8_LDB(B1, 1, 1); PG8_SCHED; PG8_LDA(At, 1, 0); PG8_STAGE(PG8_SA(0, 1), a2 + hstep, voffA);
            PG8_WAIT_V(8); PG8_WAIT_L(0); PG8_BAR; PG8_MMA(0, 0, At, B0); PG8_MMA(0, 1, At, B1); PG8_BAR; PG8_SCHED;
            PG8_LDA(At, 1, 1); PG8_STAGE(PG8_SB(1, 0), b3, voffB); PG8_STAGE(PG8_SB(1, 1), b3 + hstep, voffB); PG8_STAGE(PG8_SA(1, 0), a3, voffA);
            PG8_WAIT_V(8); PG8_WAIT_L(0); PG8_BAR; PG8_MMA(1, 0, At, B0); PG8_MMA(1, 1, At, B1); PG8_BAR; PG8_SCHED;
            } else {
            PG8_LDB(B0, 0, 0); PG8_SCHED; PG8_LDA(At, 0, 0); PG8_STAGE(PG8_SA(1, 1), a1 + hstep, voffA);
            PG8_WAIT_L(8); PG8_BAR; PG8_WAIT_L(0); PG8_MMA(0, 0, At, B0); PG8_BAR; PG8_SCHED;
            PG8_LDB(B1, 0, 1); PG8_STAGE(PG8_SB(0, 0), b2, voffB);
            PG8_BAR; PG8_WAIT_L(0); PG8_MMA(0, 1, At, B1); PG8_BAR;
            PG8_LDA(At, 0, 1); PG8_STAGE(PG8_SA(0, 0), a2, voffA);
            PG8_BAR; PG8_WAIT_L(0); PG8_MMA(1, 0, At, B0); PG8_BAR; PG8_SCHED;
            PG8_STAGE(PG8_SB(0, 1), b2 + hstep, voffB);
            PG8_WAIT_V(6); PG8_BAR; PG8_MMA(1, 1, At, B1); PG8_BAR;
            PG8_LDB(B0, 1, 0); PG8_SCHED; PG8_LDA(At, 1, 0); PG8_STAGE(PG8_SA(0, 1), a2 + hstep, voffA);
            PG8_WAIT_L(8); PG8_BAR; PG8_WAIT_L(0); PG8_MMA(0, 0, At, B0); PG8_BAR; PG8_SCHED;
            PG8_LDB(B1, 1, 1); PG8_STAGE(PG8_SB(1, 0), b3, voffB);
            PG8_BAR; PG8_WAIT_L(0); PG8_MMA(0, 1, At, B1); PG8_BAR;
            PG8_LDA(At, 1, 1); PG8_STAGE(PG8_SA(1, 0), a3, voffA);
            PG8_BAR; PG8_WAIT_L(0); PG8_MMA(1, 0, At, B0); PG8_BAR; PG8_SCHED;
            PG8_STAGE(PG8_SB(1, 1), b3 + hstep, voffB);
            PG8_WAIT_V(6); PG8_BAR; PG8_MMA(1, 1, At, B1); PG8_BAR;
            }
        }
        if constexpr (ALIGN_EPI) { if (wr == 0) PG8_BAR; }
        if constexpr (!Epi::AFTER_DRAIN) { E(acc, cur, wr, wc, fr, fq); S.done(cur); }
        if (!has_next) break;
#pragma unroll
        for (int a = 0; a < 2; ++a)
#pragma unroll
            for (int b = 0; b < 2; ++b)
#pragma unroll
                for (int m = 0; m < 4; ++m)
#pragma unroll
                    for (int n = 0; n < 2; ++n) acc[a][b][m][n] = (f32x4){0.f, 0.f, 0.f, 0.f};
        cur = nxt; cA = nA; cB = nB; ++ui;
        if constexpr (ALIGN_EPI) { if (wr == 1) PG8_BAR; }
    }
    PG8_WAIT_V(0);
    if constexpr (!ALIGN_EPI) { if (wr == 0) PG8_BAR; }
    PG8_BAR;
    if constexpr (Epi::AFTER_DRAIN) { E.fused(acc, cur, wr, wc, fr, fq, lds, wid, lane); S.done(cur); }
#undef PG8_SA
#undef PG8_SB
#undef PG8_STAGE
#undef PG8_LDA
#undef PG8_LDB
#undef PG8_MMA
#undef PG8_WAIT_V
#undef PG8_WAIT_L
#undef PG8_BAR
#undef PG8_SCHED
}
}

#define LAS __attribute__((address_space(3)))
typedef unsigned short bf16_t;
typedef short bf16x8 __attribute__((ext_vector_type(8)));
typedef short s16x4 __attribute__((ext_vector_type(4)));
typedef float f32x4 __attribute__((ext_vector_type(4)));
typedef float f32x16 __attribute__((ext_vector_type(16)));
typedef unsigned u32x4 __attribute__((ext_vector_type(4)));
typedef unsigned u32x2 __attribute__((ext_vector_type(2)));

constexpr int NB = 8, SEQ = 8192, NMETA = 16, DM = 1024, FF = 2816;
constexpr int NREAL = NB * SEQ;
constexpr int MROWS = NREAL + 256;
constexpr float ALPHA = 1.189207115002721f;
constexpr float LN_EPS = 1e-5f;
constexpr int NWAVES = 8;
constexpr int LDS_BYTES = 147456 + 16384;
constexpr int LDS_BST = 7 * 18432 + 16512;
constexpr int CAND_CAP = 1024;
constexpr int WREG = 18432;
constexpr int NPH = 14;
#ifndef ONE_LAUNCH
#define ONE_LAUNCH 1
#endif

constexpr size_t SZ_ROPE = (size_t)8208 * 32 * 4;
constexpr size_t OFF_CTL = 0, SZ_CTL = 16384;
constexpr size_t OFF_COS = SZ_CTL, OFF_SIN = OFF_COS + SZ_ROPE;
constexpr size_t OFF_ST1 = OFF_SIN + SZ_ROPE, SZ_ST = (size_t)MROWS * 8;
constexpr size_t OFF_ST2 = OFF_ST1 + SZ_ST;
constexpr size_t OFF_WGU1 = OFF_ST2 + SZ_ST, SZ_WGU = (size_t)5632 * 1024 * 2;
constexpr size_t OFF_WD1 = OFF_WGU1 + SZ_WGU, SZ_WD = (size_t)1024 * 2816 * 2;
constexpr size_t OFF_WGU2 = OFF_WD1 + SZ_WD;
constexpr size_t OFF_WD2 = OFF_WGU2 + SZ_WGU;
constexpr size_t OFF_WIN = OFF_WD2 + SZ_WD, SZ_WIN = (size_t)3072 * 1024 * 2;
constexpr size_t OFF_WGA = OFF_WIN + SZ_WIN, SZ_W1K = (size_t)1024 * 1024 * 2;
constexpr size_t OFF_WGC = OFF_WGA + SZ_W1K;
constexpr size_t OFF_WO = OFF_WGC + SZ_W1K;
constexpr size_t OFF_WAO = OFF_WO + SZ_W1K, SZ_W512 = (size_t)1024 * 512 * 2;
constexpr size_t OFF_WCO = OFF_WAO + SZ_W512;
constexpr size_t OFF_AB = OFF_WCO + SZ_W512, SZ_AB = (size_t)MROWS * 1024 * 2;
constexpr size_t OFF_Z = OFF_AB + SZ_AB, SZ_Z = (size_t)MROWS * 1024 * 4;
constexpr size_t OFF_BIG = OFF_Z + SZ_Z, SZ_BIG = (size_t)MROWS * 2816 * 2;
constexpr size_t OFF_QS = OFF_BIG, SZ_R512 = (size_t)MROWS * 512 * 2;
constexpr size_t OFF_QI = OFF_QS + SZ_R512;
constexpr size_t OFF_KV = OFF_QI + SZ_R512;
constexpr size_t OFF_KI = OFF_KV + (size_t)MROWS * 256 * 2;
constexpr size_t OFF_WI = OFF_KI + (size_t)MROWS * 64 * 2;
constexpr size_t OFF_CU = OFF_WI + (size_t)MROWS * 8 * 4;
constexpr size_t OFF_GB = OFF_CU + SZ_R512;
constexpr size_t OFF_K8 = OFF_GB + SZ_R512;
constexpr size_t OFF_QI8 = OFF_K8 + (size_t)MROWS * 128;
constexpr size_t OFF_KI8 = OFF_QI8 + (size_t)MROWS * 512;
constexpr size_t OFF_V8 = OFF_KI8 + (size_t)MROWS * 64;
static_assert(OFF_V8 + (size_t)MROWS * 128 <= OFF_BIG + SZ_BIG, "mixer tensors overlay the FFN hidden buffer");
constexpr size_t OFF_S1 = OFF_BIG, OFF_S2 = OFF_BIG + (size_t)NREAL * 1024 * 2;
static_assert(OFF_S2 + (size_t)NREAL * 1024 * 2 <= OFF_BIG + SZ_BIG, "gate buffers overlay");
constexpr size_t OFF_ATT = OFF_BIG + SZ_BIG, SZ_ATT = (size_t)NREAL * 512 * 2;
constexpr size_t OFF_YCV = OFF_ATT + SZ_ATT;
constexpr size_t WS_END = OFF_YCV + SZ_ATT;

struct Args {
    const float* x; const float* meta;
    const float* f1g; const float* f1u; const float* f1d; const float* ln1g; const float* ln1b;
    const float* win; const float* convw; const float* wao; const float* wco; const float* wo;
    const float* ln2g; const float* ln2b; const float* f2g; const float* f2u; const float* f2d; const float* ln3g; const float* ln3b;
    float* out; unsigned char* ws; int ph_lo, ph_hi;
};

__device__ __forceinline__ unsigned f2bf(float f) { unsigned u = __builtin_bit_cast(unsigned, f); return (u + 0x7fffu + ((u >> 16) & 1u)) >> 16; }
typedef float f32x2_t __attribute__((ext_vector_type(2))); typedef __bf16 bf16x2_t __attribute__((ext_vector_type(2)));
__device__ __forceinline__ unsigned pk2(float lo, float hi) { f32x2_t v = {lo, hi}; bf16x2_t b = __builtin_convertvector(v, bf16x2_t); return __builtin_bit_cast(unsigned, b); }
__device__ __forceinline__ float bf_lo(unsigned w) { return __builtin_bit_cast(float, w << 16); }
__device__ __forceinline__ float bf_hi(unsigned w) { return __builtin_bit_cast(float, w & 0xffff0000u); }
__device__ __forceinline__ unsigned pk4_fp8(float a, float b_, float c, float d) { int w = __builtin_amdgcn_cvt_pk_fp8_f32(a, b_, 0, false); w = __builtin_amdgcn_cvt_pk_fp8_f32(c, d, w, true); return (unsigned)w; }
#define LDS_WAIT() asm volatile("s_waitcnt lgkmcnt(0)" ::: "memory")
__device__ __forceinline__ float wave_sum(float v) {
#pragma unroll
    for (int o = 1; o < 64; o <<= 1) v += __shfl_xor(v, o);
    return v;
}

struct EpiSwiglu {
    static constexpr bool PERM = true, AFTER_DRAIN = false;
    bf16_t* H;
    __device__ __forceinline__ void operator()(const f32x4 (&acc)[2][2][4][2], const pg8::Unit& u, int wr, int wc, int fr, int fq) const {
        const int row0 = u.pm * 256 + wr * 64 + fr, col0 = u.pn * 128 + wc * 32 + 8 * fq;
#pragma unroll
        for (int ai = 0; ai < 2; ++ai)
#pragma unroll
            for (int m = 0; m < 4; ++m) {
                bf16_t* rowp = H + (size_t)(row0 + ai * 128 + m * 16) * FF + col0;
                float h[8];
#pragma unroll
                for (int n = 0; n < 2; ++n)
#pragma unroll
                    for (int i = 0; i < 4; ++i) {
                        const float g = acc[ai][0][m][n][i], up = acc[ai][1][m][n][i];
                        const float e = __builtin_amdgcn_exp2f(-g * 1.4426950408889634f);
                        h[4 * n + i] = g * __builtin_amdgcn_rcpf(1.0f + e) * up;
                    }
                u32x4 w; w.x = pk2(h[0], h[1]); w.y = pk2(h[2], h[3]); w.z = pk2(h[4], h[5]); w.w = pk2(h[6], h[7]);
                *(u32x4*)rowp = w;
            }
    }
};

template <int MODE> struct EpiResid {
    static constexpr bool PERM = false, AFTER_DRAIN = false;
    const float* x; const float* meta; const float* zin; const float* stats; const float* g; const float* bta; float* zout; float scale;
    __device__ __forceinline__ void operator()(const f32x4 (&acc)[2][2][4][2], const pg8::Unit& u, int wr, int wc, int fr, int fq) const {
        const int col0 = u.pn * 256 + wc * 32 + 4 * fq;
#pragma unroll
        for (int ai = 0; ai < 2; ++ai)
#pragma unroll
            for (int m = 0; m < 4; ++m) {
                const int row = u.pm * 256 + ai * 128 + wr * 64 + m * 16 + fr;
                const float* src; float mean = 0.f, rstd = 1.f; bool have = true;
                if (MODE == 0) { src = row < NREAL ? x + (size_t)row * DM : meta + (size_t)((row - NREAL) & 15) * DM; have = row < NREAL + NMETA; }
                else { src = zin + (size_t)row * DM; mean = stats[2 * row]; rstd = stats[2 * row + 1]; }
#pragma unroll
                for (int bj = 0; bj < 2; ++bj)
#pragma unroll
                    for (int n = 0; n < 2; ++n) {
                        const int c = col0 + bj * 128 + n * 16;
                        f32x4 hv = *(const f32x4*)(src + c);
                        if (MODE == 0) { if (!have) hv = (f32x4){0.f, 0.f, 0.f, 0.f}; }
                        else { const f32x4 gv = *(const f32x4*)(g + c), bv = *(const f32x4*)(bta + c); hv = (hv - mean) * rstd * gv + bv; }
                        const f32x4 o = hv * ALPHA + acc[ai][bj][m][n] * scale;
                        *(f32x4*)(zout + (size_t)row * DM + c) = o;
                    }
                asm volatile("" ::: "memory");
            }
    }
};

template <int MODE> struct EpiGate {
    static constexpr bool PERM = true, AFTER_DRAIN = false;
    bf16_t* P; const bf16_t* Q;
    __device__ __forceinline__ void operator()(const f32x4 (&acc)[2][2][4][2], const pg8::Unit& u, int wr, int wc, int fr, int fq) const {
        const int col0 = u.pn * 256 + wc * 32 + 8 * fq;
#pragma unroll
        for (int ai = 0; ai < 2; ++ai)
#pragma unroll
            for (int m = 0; m < 4; ++m) {
                const int row = u.pm * 256 + ai * 128 + wr * 64 + m * 16 + fr;
#pragma unroll
                for (int bj = 0; bj < 2; ++bj) {
                    const size_t off = (size_t)row * DM + col0 + bj * 128;
                    float v[8];
#pragma unroll
                    for (int n = 0; n < 2; ++n)
#pragma unroll
                        for (int i = 0; i < 4; ++i) v[4 * n + i] = acc[ai][bj][m][n][i];
                    if (MODE == 0) {
#pragma unroll
                        for (int i = 0; i < 8; ++i) v[i] = __builtin_amdgcn_rcpf(1.0f + __builtin_amdgcn_exp2f(-v[i] * 1.4426950408889634f));
                    } else {
                        const u32x4 pw = *(const u32x4*)(P + off);
                        float p[8] = {bf_lo(pw.x), bf_hi(pw.x), bf_lo(pw.y), bf_hi(pw.y), bf_lo(pw.z), bf_hi(pw.z), bf_lo(pw.w), bf_hi(pw.w)};
                        if (MODE == 1) {
#pragma unroll
                            for (int i = 0; i < 8; ++i) v[i] = p[i] * v[i];
                        } else {
                            const u32x4 qw = *(const u32x4*)(Q + off);
                            float q[8] = {bf_lo(qw.x), bf_hi(qw.x), bf_lo(qw.y), bf_hi(qw.y), bf_lo(qw.z), bf_hi(qw.z), bf_lo(qw.w), bf_hi(qw.w)};
#pragma unroll
                            for (int i = 0; i < 8; ++i) v[i] = p[i] + q[i] * v[i];
                        }
                    }
                    u32x4 w; w.x = pk2(v[0], v[1]); w.y = pk2(v[2], v[3]); w.z = pk2(v[4], v[5]); w.w = pk2(v[6], v[7]);
                    *(u32x4*)(P + off) = w;
                }
                asm volatile("" ::: "memory");
            }
    }
};

struct EpiY {
    static constexpr bool PERM = true, AFTER_DRAIN = false;
    bf16_t* Y; float scale;
    __device__ __forceinline__ void operator()(const f32x4 (&acc)[2][2][4][2], const pg8::Unit& u, int wr, int wc, int fr, int fq) const {
        const int col0 = u.pn * 256 + wc * 32 + 8 * fq;
#pragma unroll
        for (int ai = 0; ai < 2; ++ai)
#pragma unroll
            for (int m = 0; m < 4; ++m) {
                const int row = u.pm * 256 + ai * 128 + wr * 64 + m * 16 + fr;
#pragma unroll
                for (int bj = 0; bj < 2; ++bj) {
                    const f32x4 a0 = acc[ai][bj][m][0] * scale, a1 = acc[ai][bj][m][1] * scale;
                    u32x4 w; w.x = pk2(a0[0], a0[1]); w.y = pk2(a0[2], a0[3]); w.z = pk2(a1[0], a1[1]); w.w = pk2(a1[2], a1[3]);
                    *(u32x4*)(Y + (size_t)row * DM + col0 + bj * 128) = w;
                }
            }
    }
};

struct EpiProj {
    static constexpr bool PERM = true, AFTER_DRAIN = false;
    bf16_t *QS, *QI, *KV, *KI, *CU, *GB; float* WI; const float* cosT; const float* sinT; unsigned char* K8; unsigned char* QI8; unsigned char* KI8; unsigned char* V8;
    __device__ __forceinline__ void rope_store_k8(const f32x4 (&acc)[2][2][4][2], int ai, int m, int pos, int fq, unsigned char* dst) const {
        const f32x4 c0 = *(const f32x4*)(cosT + pos * 32 + 8 * fq), c1 = *(const f32x4*)(cosT + pos * 32 + 8 * fq + 4);
        const f32x4 s0 = *(const f32x4*)(sinT + pos * 32 + 8 * fq), s1 = *(const f32x4*)(sinT + pos * 32 + 8 * fq + 4);
        const f32x4 a0 = acc[ai][0][m][0], a1 = acc[ai][0][m][1], b0 = acc[ai][1][m][0], b1 = acc[ai][1][m][1];
        const f32x4 lo0 = a0 * c0 - b0 * s0, lo1 = a1 * c1 - b1 * s1, hi0 = b0 * c0 + a0 * s0, hi1 = b1 * c1 + a1 * s1;
        u32x2 w; w.x = pk4_fp8(lo0[0], lo0[1], lo0[2], lo0[3]); w.y = pk4_fp8(lo1[0], lo1[1], lo1[2], lo1[3]); *(u32x2*)dst = w;
        w.x = pk4_fp8(hi0[0], hi0[1], hi0[2], hi0[3]); w.y = pk4_fp8(hi1[0], hi1[1], hi1[2], hi1[3]); *(u32x2*)(dst + 32) = w;
    }
    __device__ __forceinline__ void rope_store(const f32x4 (&acc)[2][2][4][2], int ai, int m, int pos, int fq, bf16_t* dst, float sc) const {
        const f32x4 c0 = *(const f32x4*)(cosT + pos * 32 + 8 * fq), c1 = *(const f32x4*)(cosT + pos * 32 + 8 * fq + 4);
        const f32x4 s0 = *(const f32x4*)(sinT + pos * 32 + 8 * fq), s1 = *(const f32x4*)(sinT + pos * 32 + 8 * fq + 4);
        const f32x4 a0 = acc[ai][0][m][0] * sc, a1 = acc[ai][0][m][1] * sc, b0 = acc[ai][1][m][0] * sc, b1 = acc[ai][1][m][1] * sc;
        const f32x4 lo0 = a0 * c0 - b0 * s0, lo1 = a1 * c1 - b1 * s1, hi0 = b0 * c0 + a0 * s0, hi1 = b1 * c1 + a1 * s1;
        u32x4 w; w.x = pk2(lo0[0], lo0[1]); w.y = pk2(lo0[2], lo0[3]); w.z = pk2(lo1[0], lo1[1]); w.w = pk2(lo1[2], lo1[3]);
        *(u32x4*)dst = w;
        w.x = pk2(hi0[0], hi0[1]); w.y = pk2(hi0[2], hi0[3]); w.z = pk2(hi1[0], hi1[1]); w.w = pk2(hi1[2], hi1[3]);
        *(u32x4*)(dst + 32) = w;
    }
    __device__ __forceinline__ void operator()(const f32x4 (&acc)[2][2][4][2], const pg8::Unit& u, int wr, int wc, int fr, int fq) const {
        const int pn = u.pn;
#pragma unroll
        for (int ai = 0; ai < 2; ++ai)
#pragma unroll
            for (int m = 0; m < 4; ++m) {
                const int row = u.pm * 256 + ai * 128 + wr * 64 + m * 16 + fr;
                const int pos = row < NREAL ? NMETA + (row & (SEQ - 1)) : (row - NREAL);
                if (pn < 2) {
                    rope_store(acc, ai, m, pos, fq, QS + (size_t)row * 512 + (4 * pn + wc) * 64 + 8 * fq, 0.125f);
                } else if (pn == 2) {
                    if (wc < 2) rope_store_k8(acc, ai, m, pos, fq, K8 + (size_t)row * 128 + wc * 64 + 8 * fq);
                    else {
#pragma unroll
                        for (int bj = 0; bj < 2; ++bj) {
                            const f32x4 a0 = acc[ai][bj][m][0], a1 = acc[ai][bj][m][1];
                            u32x2 w; w.x = pk4_fp8(a0[0], a0[1], a0[2], a0[3]); w.y = pk4_fp8(a1[0], a1[1], a1[2], a1[3]);
                            *(u32x2*)(V8 + (size_t)row * 128 + bj * 64 + (wc - 2) * 32 + 8 * fq) = w;
                        }
                    }
                } else if (pn < 5) {
                    rope_store_k8(acc, ai, m, pos, fq, QI8 + (size_t)row * 512 + (4 * (pn - 3) + wc) * 64 + 8 * fq);
                } else if (pn == 5) {
                    if (wc == 0) rope_store_k8(acc, ai, m, pos, fq, KI8 + (size_t)row * 64 + 8 * fq);
                    else if (wc == 1 && fq == 0) {
                        const float sc = 0.04419417382415922f;
                        *(f32x4*)(WI + (size_t)row * 8) = acc[ai][0][m][0] * sc;
                        *(f32x4*)(WI + (size_t)row * 8 + 4) = acc[ai][0][m][1] * sc;
                    }
                } else if (pn < 10) {
                    const f32x4 a0 = acc[ai][0][m][0] * acc[ai][1][m][0], a1 = acc[ai][0][m][1] * acc[ai][1][m][1];
                    u32x4 w; w.x = pk2(a0[0], a0[1]); w.y = pk2(a0[2], a0[3]); w.z = pk2(a1[0], a1[1]); w.w = pk2(a1[2], a1[3]);
                    *(u32x4*)(CU + (size_t)row * 512 + (pn - 6) * 128 + wc * 32 + 8 * fq) = w;
                } else {
#pragma unroll
                    for (int bj = 0; bj < 2; ++bj) {
                        const f32x4 a0 = acc[ai][bj][m][0], a1 = acc[ai][bj][m][1];
                        u32x4 w; w.x = pk2(a0[0], a0[1]); w.y = pk2(a0[2], a0[3]); w.z = pk2(a1[0], a1[1]); w.w = pk2(a1[2], a1[3]);
                        *(u32x4*)(GB + (size_t)row * 512 + (pn - 10) * 256 + bj * 128 + wc * 32 + 8 * fq) = w;
                    }
                }
                if (m & 1) asm volatile("" ::: "memory");
            }
    }
};

__device__ __forceinline__ void tr_item(const float* W, int N, int n0, int nvalid, int k0, bf16_t* WT, int K, int drow0, LAS float* scr, int lane) {
    const int nn4 = (lane & 7) * 4;
    f32x4 tv[8];
#pragma unroll
    for (int i = 0; i < 8; ++i) { const int kk = 8 * i + (lane >> 3); tv[i] = (f32x4){0.f, 0.f, 0.f, 0.f}; if (nn4 < nvalid) tv[i] = *(const f32x4*)(W + (size_t)(k0 + kk) * N + n0 + nn4); }
#pragma unroll
    for (int i = 0; i < 8; ++i) { const int kk = 8 * i + (lane >> 3);
#pragma unroll
        for (int j = 0; j < 4; ++j) scr[kk * 33 + nn4 + j] = tv[i][j]; }
    LDS_WAIT();
    const int c = lane & 7;
#pragma unroll
    for (int j = 0; j < 4; ++j) { const int n = (lane >> 3) + 8 * j; const LAS float* s = scr + (8 * c) * 33 + n;
        u32x4 o; o.x = pk2(s[0 * 33], s[1 * 33]); o.y = pk2(s[2 * 33], s[3 * 33]); o.z = pk2(s[4 * 33], s[5 * 33]); o.w = pk2(s[6 * 33], s[7 * 33]);
        *(u32x4*)(WT + (size_t)(drow0 + n) * K + k0 + 8 * c) = o; }
    LDS_WAIT();
}
__device__ __forceinline__ void win_group(int G, int& n0, int& nvalid) {
    const int pn = G >> 3, bj = (G >> 2) & 1, xg = G & 3; nvalid = 32;
    if (pn < 2) n0 = (pn * 4 + xg) * 64 + bj * 32;
    else if (pn == 2) { if (xg < 2) n0 = 512 + xg * 64 + bj * 32; else n0 = 640 + bj * 64 + (xg - 2) * 32; }
    else if (pn < 5) n0 = 768 + ((pn - 3) * 4 + xg) * 64 + bj * 32;
    else if (pn == 5) { if (xg == 0) n0 = 1280 + bj * 32; else if (xg == 1 && bj == 0) { n0 = 1344; nvalid = 8; } else { n0 = 0; nvalid = 0; } }
    else if (pn < 10) n0 = (bj ? 2376 : 1352) + (pn - 6) * 128 + 32 * xg;
    else n0 = 1864 + (pn - 10) * 256 + bj * 128 + 32 * xg;
}
__device__ __forceinline__ void p0_prologue(const Args& a, LAS unsigned char* lds, int gw, int NGW, int wave, int lane, int parts) {
    unsigned char* ws = a.ws;
    LAS float* scr = (LAS float*)(lds + wave * 16384);
    constexpr int I_GU = 176 * 16, I_D = 32 * 44, I_IN = 96 * 16, I_1K = 32 * 16, I_512 = 32 * 8;
    constexpr int NITEMS = 2 * I_GU + 2 * I_D + I_IN + 3 * I_1K + 2 * I_512;
    if (parts & 1)
    for (int it = gw; it < NITEMS; it += NGW) {
        int r = it;
        if (r < 2 * I_GU) { const int which = r / I_GU; r -= which * I_GU; const int kb = r / 176, G = r % 176, pn = G >> 3, bj = (G >> 2) & 1, xg = G & 3;
            const float* W = which ? (bj ? a.f2u : a.f2g) : (bj ? a.f1u : a.f1g);
            tr_item(W, FF, 128 * pn + 32 * xg, 32, 64 * kb, (bf16_t*)(ws + (which ? OFF_WGU2 : OFF_WGU1)), 1024, 32 * G, scr, lane); continue; }
        r -= 2 * I_GU;
        if (r < 2 * I_D) { const int which = r / I_D; r -= which * I_D; const int kb = r / 32, G = r % 32;
            tr_item(which ? a.f2d : a.f1d, 1024, 32 * G, 32, 64 * kb, (bf16_t*)(ws + (which ? OFF_WD2 : OFF_WD1)), FF, 32 * G, scr, lane); continue; }
        r -= 2 * I_D;
        if (r < I_IN) { const int kb = r / 96, G = r % 96; int n0, nv; win_group(G, n0, nv);
            tr_item(a.win, 4936, n0, nv, 64 * kb, (bf16_t*)(ws + OFF_WIN), 1024, 32 * G, scr, lane); continue; }
        r -= I_IN;
        if (r < I_1K) { const int kb = r / 32, G = r % 32; tr_item(a.win, 4936, 2888 + 32 * G, 32, 64 * kb, (bf16_t*)(ws + OFF_WGA), 1024, 32 * G, scr, lane); continue; }
        r -= I_1K;
        if (r < I_1K) { const int kb = r / 32, G = r % 32; tr_item(a.win, 4936, 3912 + 32 * G, 32, 64 * kb, (bf16_t*)(ws + OFF_WGC), 1024, 32 * G, scr, lane); continue; }
        r -= I_1K;
        if (r < I_1K) { const int kb = r / 32, G = r % 32; tr_item(a.wo, 1024, 32 * G, 32, 64 * kb, (bf16_t*)(ws + OFF_WO), 1024, 32 * G, scr, lane); continue; }
        r -= I_1K;
        if (r < I_512) { const int kb = r / 32, G = r % 32; tr_item(a.wao, 1024, 32 * G, 32, 64 * kb, (bf16_t*)(ws + OFF_WAO), 512, 32 * G, scr, lane); continue; }
        r -= I_512;
        { const int kb = r / 32, G = r % 32; tr_item(a.wco, 1024, 32 * G, 32, 64 * kb, (bf16_t*)(ws + OFF_WCO), 512, 32 * G, scr, lane); }
    }
    bf16_t* AB = (bf16_t*)(ws + OFF_AB);
    if (parts & 2)
    for (int row0 = gw; row0 < MROWS; row0 += 4 * NGW) {
        f32x4 hv[4][4];
#pragma unroll
        for (int r = 0; r < 4; ++r) { const int row = row0 + r * NGW;
            if (row < MROWS) { const float* src = row < NREAL ? a.x + (size_t)row * DM : a.meta + (size_t)((row - NREAL) & 15) * DM;
#pragma unroll
                for (int j = 0; j < 4; ++j) hv[r][j] = *(const f32x4*)(src + 256 * j + 4 * lane); } }
#pragma unroll
        for (int r = 0; r < 4; ++r) { const int row = row0 + r * NGW;
            if (row < MROWS) { const bool have = row < NREAL + NMETA;
#pragma unroll
                for (int j = 0; j < 4; ++j) { f32x4 v = hv[r][j]; if (!have) v = (f32x4){0.f, 0.f, 0.f, 0.f};
                    u32x2 w; w.x = pk2(v[0], v[1]); w.y = pk2(v[2], v[3]);
                    *(u32x2*)(AB + (size_t)row * DM + 256 * j + 4 * lane) = w; } } }
    }
    float* cosT = (float*)(ws + OFF_COS); float* sinT = (float*)(ws + OFF_SIN);
    if (parts & 4)
    for (int idx = gw * 64 + lane; idx < 8208 * 32; idx += NGW * 64) {
        const int pos = idx >> 5, f = idx & 31;
        double fr = 1.0; for (int i = 0; i < f; ++i) fr *= 0.7498942093324559;
        const float inv = (float)fr;
        const float angf = (float)pos * inv;
        const double ang = (double)angf;
        const double k = __builtin_rint(ang * 0.6366197723675814);
        double rr = __builtin_fma(-k, 1.5707963267948966, ang); rr = __builtin_fma(-k, 6.123233995736766e-17, rr);
        const double r2 = rr * rr;
        double sp = -1.0 / 6227020800.0; sp = sp * r2 + 1.0 / 39916800.0; sp = sp * r2 - 1.0 / 362880.0; sp = sp * r2 + 1.0 / 5040.0; sp = sp * r2 - 1.0 / 120.0; sp = sp * r2 + 1.0 / 6.0;
        const double sn = rr - rr * r2 * sp;
        double cp = 1.0 / 87178291200.0; cp = cp * r2 - 1.0 / 479001600.0; cp = cp * r2 + 1.0 / 3628800.0; cp = cp * r2 - 1.0 / 40320.0; cp = cp * r2 + 1.0 / 720.0; cp = cp * r2 - 1.0 / 24.0; cp = cp * r2 + 0.5;
        const double cs = 1.0 - r2 * cp;
        const int q = ((int)k) & 3;
        const double sv = (q == 0) ? sn : (q == 1) ? cs : (q == 2) ? -sn : -cs;
        const double cv = (q == 0) ? cs : (q == 1) ? -sn : (q == 2) ? -cs : sn;
        cosT[idx] = (float)cv; sinT[idx] = (float)sv;
    }
}

template <int MODE> __device__ __forceinline__ void skinny_meta(const bf16_t* A, int lda, const bf16_t* Bt, int K, int ntask, int gw, int NGW, int lane,
                                                                bf16_t* HFF, float* Z, const float* meta, bf16_t* KV, bf16_t* KI, bf16_t* CU, const float* cosT, const float* sinT) {
    const int fr = lane & 15, fq = lane >> 4;
    for (int task = gw; task < ntask; task += NGW) {
        int pn, x0;
        if (MODE == 0) { pn = task >> 3; x0 = (task & 7) * 16; }
        else if (MODE == 1) { pn = 0; x0 = task * 16; }
        else { if (task < 8) { pn = 2; x0 = task * 16; } else if (task < 10) { pn = 5; x0 = (task - 8) * 16; } else { pn = 6 + ((task - 10) >> 3); x0 = ((task - 10) & 7) * 16; } }
        const int r0 = (MODE == 1) ? x0 + fr : 256 * pn + x0 + fr;
        const bf16_t* ap = A + (size_t)fr * lda + 8 * fq;
        const bf16_t* b0 = Bt + (size_t)r0 * K + 8 * fq;
        const bf16_t* b1 = b0 + (size_t)128 * K;
        f32x4 acc0 = {0.f, 0.f, 0.f, 0.f}, acc1 = {0.f, 0.f, 0.f, 0.f};
#pragma unroll 8
        for (int k = 0; k < K; k += 32) {
            const bf16x8 a = *(const bf16x8*)(ap + k), x = *(const bf16x8*)(b0 + k);
            acc0 = __builtin_amdgcn_mfma_f32_16x16x32_bf16(a, x, acc0, 0, 0, 0);
            if (MODE != 1) { const bf16x8 y = *(const bf16x8*)(b1 + k); acc1 = __builtin_amdgcn_mfma_f32_16x16x32_bf16(a, y, acc1, 0, 0, 0); }
        }
#pragma unroll
        for (int i = 0; i < 4; ++i) {
            const int m = 4 * fq + i; const size_t row = (size_t)(NREAL + m); const int x = x0 + fr;
            const float a0 = acc0[i], a1 = acc1[i];
            if (MODE == 0) {
                const float e = __builtin_amdgcn_exp2f(-a0 * 1.4426950408889634f);
                HFF[row * FF + 128 * pn + x] = (bf16_t)f2bf(a0 * __builtin_amdgcn_rcpf(1.0f + e) * a1);
            } else if (MODE == 1) {
                HFF[row * DM + x] = (bf16_t)f2bf(0.5f * a0);
            } else {
                if (pn == 2) {
                    if (x < 64) { const int d = x & 31; const float c = cosT[m * 32 + d], s = sinT[m * 32 + d]; unsigned char* K8m = (unsigned char*)HFF;
                        const float lo = a0 * c - a1 * s, hi = a1 * c + a0 * s;
                        K8m[row * 128 + (x >> 5) * 64 + d] = (unsigned char)(pk4_fp8(lo, lo, lo, lo) & 0xffu); K8m[row * 128 + (x >> 5) * 64 + 32 + d] = (unsigned char)(pk4_fp8(hi, hi, hi, hi) & 0xffu); }
                    else { unsigned char* V8m = (unsigned char*)KV;
                        V8m[row * 128 + (x - 64)] = (unsigned char)(pk4_fp8(a0, a0, a0, a0) & 0xffu); V8m[row * 128 + 64 + (x - 64)] = (unsigned char)(pk4_fp8(a1, a1, a1, a1) & 0xffu); }
                } else if (pn == 5) {
                    const float c = cosT[m * 32 + x], s = sinT[m * 32 + x]; unsigned char* KI8m = (unsigned char*)KI;
                    const float lo = a0 * c - a1 * s, hi = a1 * c + a0 * s;
                    KI8m[row * 64 + x] = (unsigned char)(pk4_fp8(lo, lo, lo, lo) & 0xffu); KI8m[row * 64 + 32 + x] = (unsigned char)(pk4_fp8(hi, hi, hi, hi) & 0xffu);
                } else {
                    CU[row * 512 + (pn - 6) * 128 + x] = (bf16_t)f2bf(a0 * a1);
                }
            }
        }
    }
}

template <bool FINAL> __device__ __forceinline__ void ln_phase(const float* z, const float* g, const float* bta, bf16_t* hb, float* stats, float* outf, int nrows, int gw, int NGW, int lane) {
    f32x4 gv[4], bv[4];
#pragma unroll
    for (int j = 0; j < 4; ++j) { gv[j] = *(const f32x4*)(g + 256 * j + 4 * lane); bv[j] = *(const f32x4*)(bta + 256 * j + 4 * lane); }
    f32x4 v[4], nv[4];
    if (gw < nrows) {
#pragma unroll
        for (int j = 0; j < 4; ++j) v[j] = *(const f32x4*)(z + (size_t)gw * DM + 256 * j + 4 * lane);
    }
    for (int row = gw; row < nrows; row += NGW) {
        float s = 0.f;
#pragma unroll
        for (int j = 0; j < 4; ++j) s += (v[j][0] + v[j][1]) + (v[j][2] + v[j][3]);
        const int nrow = row + NGW;
        if (nrow < nrows) {
#pragma unroll
            for (int j = 0; j < 4; ++j) nv[j] = *(const f32x4*)(z + (size_t)nrow * DM + 256 * j + 4 * lane);
        }
        const float mean = wave_sum(s) * (1.f / DM); float s2 = 0.f;
#pragma unroll
        for (int j = 0; j < 4; ++j) { v[j] = v[j] - mean; s2 += (v[j][0] * v[j][0] + v[j][1] * v[j][1]) + (v[j][2] * v[j][2] + v[j][3] * v[j][3]); }
        const float rstd = 1.f / sqrtf(wave_sum(s2) * (1.f / DM) + LN_EPS);
#pragma unroll
        for (int j = 0; j < 4; ++j) {
            const f32x4 y = v[j] * rstd * gv[j] + bv[j];
            if (FINAL) *(f32x4*)(outf + (size_t)row * DM + 256 * j + 4 * lane) = y;
            else { u32x2 w; w.x = pk2(y[0], y[1]); w.y = pk2(y[2], y[3]); *(u32x2*)(hb + (size_t)row * DM + 256 * j + 4 * lane) = w; }
        }
#pragma unroll
        for (int j = 0; j < 4; ++j) v[j] = nv[j];
        if (!FINAL && lane == 0) { stats[2 * row] = mean; stats[2 * row + 1] = rstd; }
    }
}

template <int MODE> __device__ __forceinline__ void lnres_phase(const float* x, const float* meta, const bf16_t* Y, const float* g, const float* bta, bf16_t* hb, float* outf, int nrows, int gw, int NGW, int lane) {
    f32x4 gv[4], bv[4];
#pragma unroll
    for (int j = 0; j < 4; ++j) { gv[j] = *(const f32x4*)(g + 256 * j + 4 * lane); bv[j] = *(const f32x4*)(bta + 256 * j + 4 * lane); }
    f32x4 v[4], nv[4]; u32x2 yv[4], nyv[4];
#define LNR_LOAD(dv, dy, row) do { \
        if (MODE == 0) { const float* src_ = (row) < NREAL ? x + (size_t)(row) * DM : meta + (size_t)(((row) - NREAL) & 15) * DM; \
            _Pragma("unroll") for (int j = 0; j < 4; ++j) dv[j] = *(const f32x4*)(src_ + 256 * j + 4 * lane); } \
        else { _Pragma("unroll") for (int j = 0; j < 4; ++j) { const u32x2 p_ = *(const u32x2*)(hb + (size_t)(row) * DM + 256 * j + 4 * lane); dv[j] = (f32x4){bf_lo(p_.x), bf_hi(p_.x), bf_lo(p_.y), bf_hi(p_.y)}; } } \
        _Pragma("unroll") for (int j = 0; j < 4; ++j) dy[j] = *(const u32x2*)(Y + (size_t)(row) * DM + 256 * j + 4 * lane); } while (0)
    if (gw < nrows) LNR_LOAD(v, yv, gw);
    for (int row = gw; row < nrows; row += NGW) {
        float s = 0.f;
#pragma unroll
        for (int j = 0; j < 4; ++j) { const f32x4 yy = {bf_lo(yv[j].x), bf_hi(yv[j].x), bf_lo(yv[j].y), bf_hi(yv[j].y)}; v[j] = v[j] * ALPHA + yy; s += (v[j][0] + v[j][1]) + (v[j][2] + v[j][3]); }
        const int nrow = row + NGW;
        if (nrow < nrows) LNR_LOAD(nv, nyv, nrow);
        const float mean = wave_sum(s) * (1.f / DM); float s2 = 0.f;
#pragma unroll
        for (int j = 0; j < 4; ++j) { v[j] = v[j] - mean; s2 += (v[j][0] * v[j][0] + v[j][1] * v[j][1]) + (v[j][2] * v[j][2] + v[j][3] * v[j][3]); }
        const float rstd = 1.f / sqrtf(wave_sum(s2) * (1.f / DM) + LN_EPS);
#pragma unroll
        for (int j = 0; j < 4; ++j) {
            const f32x4 y = v[j] * rstd * gv[j] + bv[j];
            if (MODE == 2) *(f32x4*)(outf + (size_t)row * DM + 256 * j + 4 * lane) = y;
            else { u32x2 w; w.x = pk2(y[0], y[1]); w.y = pk2(y[2], y[3]); *(u32x2*)(hb + (size_t)row * DM + 256 * j + 4 * lane) = w; }
        }
#pragma unroll
        for (int j = 0; j < 4; ++j) { v[j] = nv[j]; yv[j] = nyv[j]; }
    }
#undef LNR_LOAD
}

__device__ __forceinline__ void conv_phase(const bf16_t* CU, const bf16_t* GB, const float* cw, bf16_t* YCV, int gtid, int NT) {
    for (int it = gtid; it < NREAL * 64; it += NT) {
        const int row = it >> 6, c8 = (it & 63) * 8, s = row & (SEQ - 1);
        const size_t r0 = (size_t)row, r1 = s >= 1 ? (size_t)(row - 1) : (size_t)(NREAL + 15), r2 = s >= 2 ? (size_t)(row - 2) : (size_t)(NREAL + 14 + s);
        const u32x4 x0 = *(const u32x4*)(CU + r0 * 512 + c8), x1 = *(const u32x4*)(CU + r1 * 512 + c8), x2 = *(const u32x4*)(CU + r2 * 512 + c8), gb = *(const u32x4*)(GB + r0 * 512 + c8);
        float o[8];
#pragma unroll
        for (int h = 0; h < 4; ++h) {
            const unsigned a0 = h == 0 ? x0.x : h == 1 ? x0.y : h == 2 ? x0.z : x0.w, a1 = h == 0 ? x1.x : h == 1 ? x1.y : h == 2 ? x1.z : x1.w, a2 = h == 0 ? x2.x : h == 1 ? x2.y : h == 2 ? x2.z : x2.w, gg = h == 0 ? gb.x : h == 1 ? gb.y : h == 2 ? gb.z : gb.w;
            const int c = c8 + 2 * h;
            o[2 * h] = bf_lo(gg) * (cw[c] * bf_lo(a2) + cw[512 + c] * bf_lo(a1) + cw[1024 + c] * bf_lo(a0));
            o[2 * h + 1] = bf_hi(gg) * (cw[c + 1] * bf_hi(a2) + cw[512 + c + 1] * bf_hi(a1) + cw[1024 + c + 1] * bf_hi(a0));
        }
        u32x4 w; w.x = pk2(o[0], o[1]); w.y = pk2(o[2], o[3]); w.z = pk2(o[4], o[5]); w.w = pk2(o[6], o[7]);
        *(u32x4*)(YCV + r0 * 512 + c8) = w;
    }
}

__device__ __forceinline__ float relu_i(float x) { const int i = __builtin_bit_cast(int, x); return __builtin_bit_cast(float, i > 0 ? i : 0); }
__device__ __forceinline__ size_t seqrow(int b, int idx) { return idx < NMETA ? (size_t)(NREAL + idx) : (size_t)(b * SEQ + idx - NMETA); }

__device__ __forceinline__ void find_bin(LAS unsigned* hist, unsigned need, int lane, unsigned& bin, unsigned& above) {
    const u32x4 h = *(const LAS u32x4*)(hist + 252 - 4 * lane);
    const unsigned tot = h.x + h.y + h.z + h.w;
    unsigned incl = tot;
    incl += (unsigned)__builtin_amdgcn_update_dpp(0, (int)incl, 0x111, 0xf, 0xf, false);
    incl += (unsigned)__builtin_amdgcn_update_dpp(0, (int)incl, 0x112, 0xf, 0xf, false);
    incl += (unsigned)__builtin_amdgcn_update_dpp(0, (int)incl, 0x114, 0xf, 0xf, false);
    incl += (unsigned)__builtin_amdgcn_update_dpp(0, (int)incl, 0x118, 0xf, 0xf, false);
    incl += (unsigned)__builtin_amdgcn_update_dpp(0, (int)incl, 0x142, 0xa, 0xf, false);
    incl += (unsigned)__builtin_amdgcn_update_dpp(0, (int)incl, 0x143, 0xc, 0xf, false);
    const unsigned excl = incl - tot;
    const bool found = excl < need && need <= incl;
    unsigned a = excl, bsel = 0, asel = 0;
    if (a + h.w >= need) { bsel = 255 - 4 * lane; asel = a; }
    else { a += h.w; if (a + h.z >= need) { bsel = 254 - 4 * lane; asel = a; } else { a += h.z; if (a + h.y >= need) { bsel = 253 - 4 * lane; asel = a; } else { a += h.y; bsel = 252 - 4 * lane; asel = a; } } }
    const unsigned long long bal = __ballot(found);
    const int src = bal ? (int)__builtin_ctzll(bal) : 0;
    bin = (unsigned)__builtin_amdgcn_readlane((int)bsel, src); above = (unsigned)__builtin_amdgcn_readlane((int)asel, src);
}

__device__ __forceinline__ void attn_phase(const bf16_t* QS, const bf16_t* QI, const bf16_t* KV, const bf16_t* KI, const float* WI, bf16_t* ATT, const unsigned char* K8,
                                           LAS unsigned char* lds, int wave, int lane) {
    const int c32 = lane & 31, hi = lane >> 5, fr = lane & 15, fq = lane >> 4;
    LAS unsigned char* myreg = lds + wave * WREG;
    LAS unsigned short* myrow = (LAS unsigned short*)myreg;
    LAS unsigned* hist = (LAS unsigned*)(myreg + 16640);
    LAS unsigned short* list = (LAS unsigned short*)(myreg + 16640 + 1024);
    LAS unsigned char* vimg = myreg;
    LAS bf16_t* obuf = (LAS bf16_t*)(myreg);
    const int G = gridDim.x, cb = blockIdx.x;
    *(LAS u32x4*)(hist + 4 * lane) = (u32x4){0u, 0u, 0u, 0u};
    LDS_WAIT();
    __syncthreads();
    for (int p = cb; p < 4096; p += G) {
        const int b = p >> 9, pidx = p & 511;
#pragma unroll 1
        for (int half = 0; half < 2; ++half) {
            const int sblk = half ? 1023 - pidx : pidx, s0 = sblk * 8;
            const int rq0 = b * SEQ + s0;
            {
                const unsigned char* QI8 = (const unsigned char*)QI; const unsigned char* KI8 = (const unsigned char*)KI;
                u32x4 qa[4];
#pragma unroll
                for (int mt = 0; mt < 4; ++mt) qa[mt] = *(const u32x4*)(QI8 + (size_t)(rq0 + 2 * mt + (fr >> 3)) * 512 + (fr & 7) * 64 + 16 * fq);
                f32x4 wv[4];
#pragma unroll
                for (int mt = 0; mt < 4; ++mt) wv[mt] = *(const f32x4*)(WI + (size_t)(rq0 + 2 * mt + (fq >> 1)) * 8 + 4 * (fq & 1));
                const int nmax = NMETA + s0 + 8, ntile = (nmax + 15) >> 4;
                const int qa_ = 2 * (fq & 1) + (fq >> 1);
                asm volatile("" : "+v"(qa[0]), "+v"(qa[1]), "+v"(qa[2]), "+v"(qa[3]), "+v"(wv[0]), "+v"(wv[1]), "+v"(wv[2]), "+v"(wv[3]) :: "memory");
#define S1_LOAD(dst, tt) do { const int kk_ = 16 * (tt) + fr, kld_ = kk_ < nmax ? kk_ : nmax - 1; const unsigned char* kp_ = KI8 + seqrow(b, kld_) * 64 + 16 * fq; \
        asm volatile("global_load_dwordx4 %0, %1, off" : "=&v"(dst) : "v"(kp_) : "memory"); } while (0)
#define S1_WAIT(nn, dst) asm volatile("s_waitcnt vmcnt(" #nn ")" : "+v"(dst) :: "memory")
#define S1_TILE(kbv, tt) do { const int kk = 16 * (tt) + fr; float part_[4]; \
        const long kb0_ = (long)(((unsigned long long)kbv.y << 32) | kbv.x), kb1_ = (long)(((unsigned long long)kbv.w << 32) | kbv.z); \
        _Pragma("unroll") for (int mt = 0; mt < 4; ++mt) { f32x4 acc_ = {0.f, 0.f, 0.f, 0.f}; \
            acc_ = __builtin_amdgcn_mfma_f32_16x16x32_fp8_fp8((long)(((unsigned long long)qa[mt].y << 32) | qa[mt].x), kb0_, acc_, 0, 0, 0); \
            acc_ = __builtin_amdgcn_mfma_f32_16x16x32_fp8_fp8((long)(((unsigned long long)qa[mt].w << 32) | qa[mt].z), kb1_, acc_, 0, 0, 0); \
            const f32x4 w_ = wv[mt]; float p_ = 0.f; \
            _Pragma("unroll") for (int i = 0; i < 4; ++i) p_ = __builtin_fmaf(w_[i], relu_i(acc_[i]), p_); \
            part_[mt] = p_; } \
        _Pragma("unroll") for (int pr = 0; pr < 2; ++pr) { \
            auto rr_ = __builtin_amdgcn_permlane16_swap(__builtin_bit_cast(unsigned, part_[2 * pr]), __builtin_bit_cast(unsigned, part_[2 * pr + 1]), false, false); \
            const float tot_ = __builtin_bit_cast(float, (unsigned)rr_[0]) + __builtin_bit_cast(float, (unsigned)rr_[1]); \
            const int q = 4 * pr + qa_; const _Float16 hh = (_Float16)tot_; const unsigned hb = (unsigned)__builtin_bit_cast(unsigned short, hh); \
            unsigned key = (hb & 0x8000u) ? (~hb & 0xffffu) : (hb | 0x8000u); \
            const bool valid = kk <= NMETA + s0 + q; if (!valid) key = 0u; \
            *(LAS unsigned short*)(lds + q * WREG + kk * 2) = (unsigned short)key; \
            __hip_atomic_fetch_add((LAS unsigned*)(lds + q * WREG + 16640) + (key >> 8), valid ? 1u : 0u, __ATOMIC_RELAXED, __HIP_MEMORY_SCOPE_WORKGROUP); } } while (0)
                u32x4 kr0, kr1, kr2, kr3, kr4, kr5, kr6, kr7;
                S1_LOAD(kr0, wave); S1_LOAD(kr1, wave + NWAVES); S1_LOAD(kr2, wave + 2 * NWAVES); S1_LOAD(kr3, wave + 3 * NWAVES);
                S1_LOAD(kr4, wave + 4 * NWAVES); S1_LOAD(kr5, wave + 5 * NWAVES); S1_LOAD(kr6, wave + 6 * NWAVES); S1_LOAD(kr7, wave + 7 * NWAVES);
#define S1_STEP(kr, off) do { S1_WAIT(7, kr); if (t + (off) * NWAVES < ntile) { S1_TILE(kr, t + (off) * NWAVES); } S1_LOAD(kr, t + ((off) + 8) * NWAVES); } while (0)
                for (int t = wave; t < ntile; t += 8 * NWAVES) {
                    S1_STEP(kr0, 0); S1_STEP(kr1, 1); S1_STEP(kr2, 2); S1_STEP(kr3, 3); S1_STEP(kr4, 4); S1_STEP(kr5, 5); S1_STEP(kr6, 6); S1_STEP(kr7, 7);
                }
                S1_WAIT(0, kr0); S1_WAIT(0, kr1); S1_WAIT(0, kr2); S1_WAIT(0, kr3); S1_WAIT(0, kr4); S1_WAIT(0, kr5); S1_WAIT(0, kr6); S1_WAIT(0, kr7);
#undef S1_STEP
#undef S1_LOAD
#undef S1_WAIT
#undef S1_TILE
            }
            LDS_WAIT();
            __syncthreads();
            const int n = NMETA + s0 + wave + 1;
            const int cnt = n < 256 ? n : 256;
            if (n <= 256) {
#pragma unroll
                for (int i = 0; i < 4; ++i) { const int s = i * 64 + lane; list[s] = (unsigned short)(s < n ? s : 0); }
                LDS_WAIT();
                *(LAS u32x4*)(hist + 4 * lane) = (u32x4){0u, 0u, 0u, 0u};
            } else {
                unsigned b1, ab1; find_bin(hist, 256u, lane, b1, ab1);
                const unsigned c1 = hist[b1];
                if (c1 <= (unsigned)CAND_CAP) {
                    LAS unsigned short* cand = (LAS unsigned short*)(lds + 147456 + wave * 2048);
                    const unsigned need2 = 256u - ab1;
                    LDS_WAIT();
                    *(LAS u32x4*)(hist + 4 * lane) = (u32x4){0u, 0u, 0u, 0u};
                    const int nit8 = (n + 511) >> 9;
                    unsigned sel_cnt = 0, cand_cnt = 0;
                    u32x4 kwm = *(const LAS u32x4*)(myrow + 8 * lane);
                    for (int it = 0; it < nit8; ++it) {
                        const int i0 = 8 * (64 * it + lane);
                        const u32x4 kw = kwm;
                        kwm = *(const LAS u32x4*)(myrow + i0 + 512);
                        const unsigned k[8] = {kw.x & 0xffffu, kw.x >> 16, kw.y & 0xffffu, kw.y >> 16, kw.z & 0xffffu, kw.z >> 16, kw.w & 0xffffu, kw.w >> 16};
                        bool gt[8], cd[8]; unsigned cg = 0, cc = 0;
#pragma unroll
                        for (int j = 0; j < 8; ++j) { const bool in = i0 + j < n; const unsigned hj = k[j] >> 8; gt[j] = in && hj > b1; cd[j] = in && hj == b1; cg += gt[j] ? 1u : 0u; cc += cd[j] ? 1u : 0u; }
                        const unsigned v = cg | (cc << 16);
                        unsigned incl = v;
                        incl += (unsigned)__builtin_amdgcn_update_dpp(0, (int)incl, 0x111, 0xf, 0xf, false);
                        incl += (unsigned)__builtin_amdgcn_update_dpp(0, (int)incl, 0x112, 0xf, 0xf, false);
                        incl += (unsigned)__builtin_amdgcn_update_dpp(0, (int)incl, 0x114, 0xf, 0xf, false);
                        incl += (unsigned)__builtin_amdgcn_update_dpp(0, (int)incl, 0x118, 0xf, 0xf, false);
                        incl += (unsigned)__builtin_amdgcn_update_dpp(0, (int)incl, 0x142, 0xa, 0xf, false);
                        incl += (unsigned)__builtin_amdgcn_update_dpp(0, (int)incl, 0x143, 0xc, 0xf, false);
                        const unsigned excl = incl - v, tot = (unsigned)__builtin_amdgcn_readlane((int)incl, 63);
                        unsigned ps = sel_cnt + (excl & 0xffffu), pc = cand_cnt + (excl >> 16);
                        if (v != 0u) {
#pragma unroll
                            for (int j = 0; j < 8; ++j) {
                                if (gt[j] && ps < 256u) list[ps] = (unsigned short)(i0 + j);
                                if (cd[j] && pc < (unsigned)CAND_CAP) cand[pc] = (unsigned short)(i0 + j);
                                ps += gt[j] ? 1u : 0u; pc += cd[j] ? 1u : 0u;
                            }
                        }
                        sel_cnt += tot & 0xffffu; cand_cnt += tot >> 16;
                    }
                    LDS_WAIT();
                    for (unsigned i = lane; i < c1; i += 64) { const unsigned key = myrow[cand[i]]; __hip_atomic_fetch_add(hist + (key & 255u), 1u, __ATOMIC_RELAXED, __HIP_MEMORY_SCOPE_WORKGROUP); }
                    LDS_WAIT();
                    unsigned b2, ab2; find_bin(hist, need2, lane, b2, ab2);
                    const unsigned need_eq = need2 - ab2;
                    LDS_WAIT();
                    *(LAS u32x4*)(hist + 4 * lane) = (u32x4){0u, 0u, 0u, 0u};
                    unsigned out_cnt = ab1, eq_cnt = 0;
                    for (unsigned base = 0; base < c1; base += 64) {
                        const unsigned i = base + lane; const bool in = i < c1;
                        const unsigned idx = in ? (unsigned)cand[i] : 0u;
                        const unsigned lo = (unsigned)myrow[idx] & 255u;
                        const bool g2 = in && lo > b2, e2 = in && lo == b2;
                        const unsigned long long eqb = __ballot(e2);
                        const unsigned eq_rank = eq_cnt + __builtin_amdgcn_mbcnt_hi((unsigned)(eqb >> 32), __builtin_amdgcn_mbcnt_lo((unsigned)eqb, 0u));
                        const bool sel = g2 || (e2 && eq_rank < need_eq);
                        const unsigned long long sb = __ballot(sel);
                        const unsigned pos = out_cnt + __builtin_amdgcn_mbcnt_hi((unsigned)(sb >> 32), __builtin_amdgcn_mbcnt_lo((unsigned)sb, 0u));
                        if (sel && pos < 256u) list[pos] = (unsigned short)idx;
                        out_cnt += (unsigned)__popcll(sb); eq_cnt += (unsigned)__popcll(eqb);
                    }
                } else {
                const unsigned need2 = 256u - ab1;
                LDS_WAIT();
                *(LAS u32x4*)(hist + 4 * lane) = (u32x4){0u, 0u, 0u, 0u};
                LDS_WAIT();
                const int nit = (n + 255) >> 8;
                u32x2 kwn = *(const LAS u32x2*)(myrow + 4 * lane);
                for (int it = 0; it < nit; ++it) {
                    const int i0 = 4 * (64 * it + lane);
                    const u32x2 kw = kwn;
                    kwn = *(const LAS u32x2*)(myrow + i0 + 256);
                    const unsigned k0 = kw.x & 0xffffu, k1 = kw.x >> 16, k2 = kw.y & 0xffffu, k3 = kw.y >> 16;
                    if (i0 + 0 < n && (k0 >> 8) == b1) __hip_atomic_fetch_add(hist + (k0 & 255u), 1u, __ATOMIC_RELAXED, __HIP_MEMORY_SCOPE_WORKGROUP);
                    if (i0 + 1 < n && (k1 >> 8) == b1) __hip_atomic_fetch_add(hist + (k1 & 255u), 1u, __ATOMIC_RELAXED, __HIP_MEMORY_SCOPE_WORKGROUP);
                    if (i0 + 2 < n && (k2 >> 8) == b1) __hip_atomic_fetch_add(hist + (k2 & 255u), 1u, __ATOMIC_RELAXED, __HIP_MEMORY_SCOPE_WORKGROUP);
                    if (i0 + 3 < n && (k3 >> 8) == b1) __hip_atomic_fetch_add(hist + (k3 & 255u), 1u, __ATOMIC_RELAXED, __HIP_MEMORY_SCOPE_WORKGROUP);
                }
                LDS_WAIT();
                unsigned b2, ab2; find_bin(hist, need2, lane, b2, ab2);
                const unsigned T = (b1 << 8) | b2, need_eq = need2 - ab2;
                LDS_WAIT();
                *(LAS u32x4*)(hist + 4 * lane) = (u32x4){0u, 0u, 0u, 0u};
                unsigned sel_cnt = 0, eq_cnt = 0;
                u32x2 kwm = *(const LAS u32x2*)(myrow + 4 * lane);
                for (int it = 0; it < nit; ++it) {
                    const int i0 = 4 * (64 * it + lane);
                    const u32x2 kw = kwm;
                    kwm = *(const LAS u32x2*)(myrow + i0 + 256);
                    unsigned k[4] = {kw.x & 0xffffu, kw.x >> 16, kw.y & 0xffffu, kw.y >> 16};
                    unsigned cg = 0, ce = 0;
#pragma unroll
                    for (int j = 0; j < 4; ++j) { if (i0 + j >= n) k[j] = 0u; cg += (k[j] > T) ? 1u : 0u; ce += (k[j] == T) ? 1u : 0u; }
                    const unsigned v = cg | (ce << 16);
                    unsigned incl = v;
                    incl += (unsigned)__builtin_amdgcn_update_dpp(0, (int)incl, 0x111, 0xf, 0xf, false);
                    incl += (unsigned)__builtin_amdgcn_update_dpp(0, (int)incl, 0x112, 0xf, 0xf, false);
                    incl += (unsigned)__builtin_amdgcn_update_dpp(0, (int)incl, 0x114, 0xf, 0xf, false);
                    incl += (unsigned)__builtin_amdgcn_update_dpp(0, (int)incl, 0x118, 0xf, 0xf, false);
                    incl += (unsigned)__builtin_amdgcn_update_dpp(0, (int)incl, 0x142, 0xa, 0xf, false);
                    incl += (unsigned)__builtin_amdgcn_update_dpp(0, (int)incl, 0x143, 0xc, 0xf, false);
                    const unsigned excl = incl - v, tot = (unsigned)__builtin_amdgcn_readlane((int)incl, 63);
                    const unsigned pg = excl & 0xffffu, pe = excl >> 16;
                    const unsigned base_eq = eq_cnt < need_eq ? eq_cnt : need_eq;
                    unsigned r_eq = eq_cnt + pe;
                    unsigned pos = sel_cnt + pg + ((r_eq < need_eq ? r_eq : need_eq) - base_eq);
#pragma unroll
                    for (int j = 0; j < 4; ++j) {
                        const bool gt = k[j] > T, eq = k[j] == T;
                        const bool take = gt || (eq && r_eq < need_eq);
                        if (take && pos < 256u) list[pos] = (unsigned short)(i0 + j);
                        pos += take ? 1u : 0u; r_eq += eq ? 1u : 0u;
                    }
                    const unsigned tg = tot & 0xffffu, te = tot >> 16;
                    const unsigned e1 = eq_cnt + te;
                    sel_cnt += tg + ((e1 < need_eq ? e1 : need_eq) - base_eq); eq_cnt = e1;
                }
                            }
            }
            LDS_WAIT();
#ifdef PROBE_S3X2
            for (int rep3 = 0; rep3 < 2; ++rep3)
#endif
            {
                const int rq = rq0 + wave;
                long qb[4];
                {
                    const bool qv = fr < 8 && (fr >> 2) == (fq >> 1);
                    const bf16_t* qp = QS + (size_t)rq * 512 + (qv ? fr : 0) * 64 + ((32 * fq) & 63);
#pragma unroll
                    for (int s = 0; s < 4; ++s) {
                        const u32x4 w = *(const u32x4*)(qp + 8 * s);
                        const unsigned lo = pk4_fp8(bf_lo(w.x) * 8.f, bf_hi(w.x) * 8.f, bf_lo(w.y) * 8.f, bf_hi(w.y) * 8.f), hi = pk4_fp8(bf_lo(w.z) * 8.f, bf_hi(w.z) * 8.f, bf_lo(w.w) * 8.f, bf_hi(w.w) * 8.f);
                        qb[s] = qv ? (long)(((unsigned long long)hi << 32) | lo) : 0l;
                    }
                }
                const int vR = lane >> 4, vpc = lane & 15;
#define V_DMA(kk) do { _Pragma("unroll") for (int it = 0; it < 4; ++it) { const int rho_ = 8 * it + (lane >> 3), j_ = rho_ & 7, f_ = rho_ >> 3; \
        const int kidx_ = list[32 * (kk) + (j_ < 4 ? 4 * f_ + j_ : 12 + 4 * f_ + j_)]; \
        const unsigned char* gp_ = V8 + seqrow(b, kidx_) * 128 + 16 * ((lane & 7) ^ ((rho_ >> 1) & 7)); \
        __builtin_amdgcn_global_load_lds((const unsigned*)gp_, (LAS unsigned*)(vimg + ((kk) & 3) * 4096 + it * 1024), 16, 0, 0); } } while (0)
#define K_LOAD(dst, t) do { const int kidx_ = list[(t) * 16 + fr]; const unsigned char* kp_ = K8 + seqrow(b, kidx_) * 128 + 32 * fq; \
        dst[0] = *(const u32x4*)kp_; dst[1] = *(const u32x4*)(kp_ + 16); } while (0)
                const unsigned char* V8 = (const unsigned char*)KV;
                V_DMA(0); V_DMA(1); V_DMA(2); V_DMA(3);
                u32x4 ka[8][2];
#pragma unroll
                for (int t = 0; t < 8; ++t) K_LOAD(ka[t], t);
                f32x4 sc[16];
#pragma unroll
                for (int t = 0; t < 16; ++t) {
                    f32x4 acc = {0.f, 0.f, 0.f, 0.f};
#pragma unroll
                    for (int s = 0; s < 4; ++s) { const u32x4 kw_ = ka[t & 7][s >> 1]; const unsigned l_ = (s & 1) ? kw_.z : kw_.x, h_ = (s & 1) ? kw_.w : kw_.y;
                        acc = __builtin_amdgcn_mfma_f32_16x16x32_fp8_fp8((long)(((unsigned long long)h_ << 32) | l_), qb[s], acc, 0, 0, 0); }
                    sc[t] = acc * 0.18033688011112042f;
                    if (t + 8 < 16) K_LOAD(ka[t & 7], t + 8);
                    __builtin_amdgcn_sched_barrier(0);
                }
#undef K_LOAD
                float mx = -INFINITY;
#pragma unroll
                for (int t = 0; t < 16; ++t)
#pragma unroll
                    for (int i = 0; i < 4; ++i) { if (cnt < 256 && 16 * t + 4 * fq + i >= cnt) sc[t][i] = -INFINITY; mx = fmaxf(mx, sc[t][i]); }
                { auto r16 = __builtin_amdgcn_permlane16_swap(__builtin_bit_cast(unsigned, mx), __builtin_bit_cast(unsigned, mx), false, false);
                  mx = fmaxf(__builtin_bit_cast(float, (unsigned)r16[0]), __builtin_bit_cast(float, (unsigned)r16[1]));
                  auto r32 = __builtin_amdgcn_permlane32_swap(__builtin_bit_cast(unsigned, mx), __builtin_bit_cast(unsigned, mx), false, false);
                  mx = fmaxf(__builtin_bit_cast(float, (unsigned)r32[0]), __builtin_bit_cast(float, (unsigned)r32[1])); }
                float l = 0.f;
#pragma unroll
                for (int t = 0; t < 16; ++t)
#pragma unroll
                    for (int i = 0; i < 4; ++i) { const float e = __builtin_amdgcn_exp2f(sc[t][i] - mx); sc[t][i] = e; l += e; }
                { auto r16 = __builtin_amdgcn_permlane16_swap(__builtin_bit_cast(unsigned, l), __builtin_bit_cast(unsigned, l), false, false);
                  l = __builtin_bit_cast(float, (unsigned)r16[0]) + __builtin_bit_cast(float, (unsigned)r16[1]);
                  auto r32 = __builtin_amdgcn_permlane32_swap(__builtin_bit_cast(unsigned, l), __builtin_bit_cast(unsigned, l), false, false);
                  l = __builtin_bit_cast(float, (unsigned)r32[0]) + __builtin_bit_cast(float, (unsigned)r32[1]); }
                long pa[8];
#pragma unroll
                for (int kk = 0; kk < 8; ++kk) { const unsigned lo_ = pk4_fp8(sc[2 * kk][0], sc[2 * kk][1], sc[2 * kk][2], sc[2 * kk][3]), hi_ = pk4_fp8(sc[2 * kk + 1][0], sc[2 * kk + 1][1], sc[2 * kk + 1][2], sc[2 * kk + 1][3]); pa[kk] = (long)(((unsigned long long)hi_ << 32) | lo_); }
                f32x4 o[8];
#pragma unroll
                for (int nt = 0; nt < 8; ++nt) o[nt] = (f32x4){0.f, 0.f, 0.f, 0.f};
                const int vrow = 8 * fq + ((lane & 15) >> 1), vswz = (vrow >> 1) & 7;
                const LAS unsigned char* vb = vimg + vrow * 128 + 8 * (lane & 1);
                typedef int v2i32_t __attribute__((ext_vector_type(2)));
#define PV_STEP(kk) do { \
        if ((kk) <= 4) asm volatile("s_waitcnt vmcnt(12)" ::: "memory"); else if ((kk) == 5) asm volatile("s_waitcnt vmcnt(8)" ::: "memory"); else if ((kk) == 6) asm volatile("s_waitcnt vmcnt(4)" ::: "memory"); else asm volatile("s_waitcnt vmcnt(0)" ::: "memory"); \
        _Pragma("unroll") for (int nt = 0; nt < 8; ++nt) { \
            const v2i32_t vv_ = __builtin_amdgcn_ds_read_tr8_b64_v2i32((LAS v2i32_t*)(vb + ((kk) & 3) * 4096 + ((nt ^ vswz) << 4))); \
            o[nt] = __builtin_amdgcn_mfma_f32_16x16x32_fp8_fp8(pa[kk], (long)(((unsigned long long)(unsigned)vv_[1] << 32) | (unsigned)vv_[0]), o[nt], 0, 0, 0); } \
        LDS_WAIT(); \
        if ((kk) + 4 < 8) V_DMA((kk) + 4); __builtin_amdgcn_sched_barrier(0); } while (0)
                PV_STEP(0); PV_STEP(1); PV_STEP(2); PV_STEP(3); PV_STEP(4); PV_STEP(5); PV_STEP(6); PV_STEP(7);
#undef PV_STEP
#undef V_DMA
                LDS_WAIT();
                float linv[4];
#pragma unroll
                for (int i = 0; i < 4; ++i) linv[i] = 1.0f / __shfl(l, (4 * fq + i) & 7);
#pragma unroll
                for (int nt = 0; nt < 8; ++nt) {
                    if (fq == (nt >> 2)) {
#pragma unroll
                        for (int i = 0; i < 4; ++i) obuf[(4 * fq + i) * 64 + (nt & 3) * 16 + fr] = (bf16_t)f2bf(o[nt][i] * linv[i]);
                    }
                }
                LDS_WAIT();
                const u32x4 ov = *(const LAS u32x4*)((LAS unsigned char*)obuf + lane * 16);
                *(u32x4*)(ATT + (size_t)rq * 512 + lane * 8) = ov;
            }
            LDS_WAIT();
            __syncthreads();
        }
    }
}


#define XB_TMO      128
#define XB_XCNT(j)  (256  + 64 * (j))
#define XB_XSUB(j)  (1280 + 64 * (j))
#define XB_XGEN(j)  (2304 + 64 * (j))
#define XB_TOP      3328
#define XB_TOPGEN   3392
#define XCD_BAR_WORDS 3456
#define XB_SPIN_CAP (1u << 18)

__device__ __forceinline__ unsigned xb_ld(unsigned* p)              { return __hip_atomic_load(p, __ATOMIC_RELAXED, __HIP_MEMORY_SCOPE_AGENT); }
__device__ __forceinline__ unsigned xb_add(unsigned* p, unsigned v) { return __hip_atomic_fetch_add(p, v, __ATOMIC_RELAXED, __HIP_MEMORY_SCOPE_AGENT); }
__device__ __forceinline__ unsigned xb_xcc_id() { return (unsigned)__builtin_amdgcn_s_getreg((3 << 11) | 20) & 0xFu; }
#define XB_SPIN(cond, bar) do { unsigned _sp = 0; while (cond) { __builtin_amdgcn_s_sleep(1); \
    if ((++_sp & 255u) == 0u) { if (xb_ld(&(bar)[XB_TMO])) break; if (_sp > XB_SPIN_CAP) { atomicAdd(&(bar)[XB_TMO], 1u); break; } } } } while (0)

struct XcdBarrier {
    unsigned* bar; unsigned x;
    volatile LAS unsigned* st;
};

__device__ __forceinline__ XcdBarrier xcd_barrier_post(unsigned* bar, volatile LAS unsigned* st) {
    XcdBarrier b; b.bar = bar; b.x = xb_xcc_id(); b.st = st;
    if (threadIdx.x == 0) (void)xb_add(&bar[XB_XCNT(b.x)], 1u);
    return b;
}
__device__ __forceinline__ void xcd_barrier_complete(unsigned* bar, unsigned x, unsigned& nloc, unsigned& nx) {
    const unsigned G = gridDim.x * gridDim.y * gridDim.z;
    unsigned sum, cnt, mine, sp = 0u;
    for (;;) {
        sum = 0u; cnt = 0u; mine = 0u;
#pragma unroll
        for (unsigned j = 0; j < 16; ++j) { const unsigned c = xb_ld(&bar[XB_XCNT(j)]); sum += c; cnt += (c > 0u) ? 1u : 0u; mine = (j == x) ? c : mine; }
        if (sum == G) break;
        __builtin_amdgcn_s_sleep(1);
        if ((++sp & 255u) == 0u) { if (xb_ld(&bar[XB_TMO])) break; if (sp > XB_SPIN_CAP) { atomicAdd(&bar[XB_TMO], 1u); break; } }
    }
    nloc = mine > 0u ? mine : 1u; nx = cnt > 0u ? cnt : 1u;
}

__device__ __forceinline__ void xcd_barrier(const XcdBarrier& b) {
    asm volatile("s_waitcnt vmcnt(0)" ::: "memory");
    __syncthreads();
    if (threadIdx.x == 0) {
        unsigned* bar = b.bar;
        __builtin_amdgcn_s_waitcnt(0);
        unsigned nloc = b.st[0], nx = b.st[1];
        if (nloc == 0u) { xcd_barrier_complete(bar, b.x, nloc, nx); b.st[0] = nloc; b.st[1] = nx; }
        const unsigned old = xb_add(&bar[XB_XSUB(b.x)], 1u);
        const unsigned gen = old / nloc;
        if (old + 1u == (gen + 1u) * nloc) {
            __builtin_amdgcn_fence(__ATOMIC_RELEASE, "agent");
            asm volatile("s_waitcnt vmcnt(0)" ::: "memory");
            const unsigned og = xb_add(&bar[XB_TOP], 1u);
            const unsigned tg = og / nx;
            if (og + 1u == (tg + 1u) * nx) xb_add(&bar[XB_TOPGEN], 1u);
            else XB_SPIN(xb_ld(&bar[XB_TOPGEN]) == tg, bar);
            __builtin_amdgcn_fence(__ATOMIC_ACQUIRE, "agent");
            xb_add(&bar[XB_XGEN(b.x)], 1u);
            asm volatile("s_waitcnt vmcnt(0)" ::: "memory");
        } else {
            XB_SPIN(xb_ld(&bar[XB_XGEN(b.x)]) == gen, bar);
            __builtin_amdgcn_fence(__ATOMIC_ACQUIRE, "agent");
            asm volatile("s_waitcnt vmcnt(0)" ::: "memory");
        }
    }
    __syncthreads();
}

__global__ void __launch_bounds__(NWAVES * 64, 2) mk_fwd(Args a) {
    extern __shared__ __attribute__((aligned(16))) unsigned char lds_raw[];
    LAS unsigned char* lds = (LAS unsigned char*)lds_raw;
    const int tid = threadIdx.x, lane = tid & 63, wave = __builtin_amdgcn_readfirstlane(tid >> 6);
    const int G = gridDim.x, gw = blockIdx.x * NWAVES + wave, NGW = G * NWAVES;
    unsigned char* ws = a.ws;
    bf16_t* AB = (bf16_t*)(ws + OFF_AB); float* Z = (float*)(ws + OFF_Z); bf16_t* HFF = (bf16_t*)(ws + OFF_BIG);
    float* ST1 = (float*)(ws + OFF_ST1); float* ST2 = (float*)(ws + OFF_ST2);
    const int lo = a.ph_lo, hi = a.ph_hi;
    volatile LAS unsigned* bst = (volatile LAS unsigned*)(lds + LDS_BST);
    if (tid < 2) bst[tid] = 0u;
    __syncthreads();
    XcdBarrier gbar = xcd_barrier_post((unsigned*)(ws + OFF_CTL), bst);
#define IN(k) (lo <= (k) && (k) < hi)
#define SEAM(k) do { if (IN(k) && IN((k) + 1)) { if ((k) == 0) cooperative_groups::this_grid().sync(); else xcd_barrier(gbar); } } while (0)

    if (IN(0)) { p0_prologue(a, lds, gw, NGW, wave, lane, 7);
#ifdef PROBE_P0_PARTS
        p0_prologue(a, lds, gw, NGW, wave, lane, PROBE_P0_PARTS);
#endif
 }
    SEAM(0);
#ifdef PROBE_SYNC10
    for (int r_ = 0; r_ < 10; ++r_) cooperative_groups::this_grid().sync();
#endif
    if (IN(1)) { pg8::Gemm g{AB, (const bf16_t*)(ws + OFF_WGU1), NREAL, 5632, 1024}; pg8::StaticOrder S; S.init(NREAL, 5632, G, (int)blockIdx.x);
        EpiSwiglu E{HFF}; pg8::gemm_phase<EpiSwiglu, pg8::StaticOrder, true, true>(lds, g, S, E);
        skinny_meta<0>(AB + (size_t)NREAL * DM, DM, (const bf16_t*)(ws + OFF_WGU1), 1024, 22 * 8, gw, NGW, lane, HFF, nullptr, nullptr, nullptr, nullptr, nullptr, nullptr, nullptr); }
    SEAM(1);
    bf16_t* Y12 = (bf16_t*)a.out;
    bf16_t* Y3 = (bf16_t*)(ws + OFF_ATT);
    if (IN(2)) { pg8::Gemm g{HFF, (const bf16_t*)(ws + OFF_WD1), NREAL, 1024, FF}; pg8::StaticOrder S; S.init(NREAL, 1024, G, (int)blockIdx.x);
        EpiY E{Y12, 0.5f}; pg8::gemm_phase<EpiY, pg8::StaticOrder, true, true>(lds, g, S, E);
        skinny_meta<1>(HFF + (size_t)NREAL * FF, FF, (const bf16_t*)(ws + OFF_WD1), FF, 64, gw, NGW, lane, Y12, nullptr, nullptr, nullptr, nullptr, nullptr, nullptr, nullptr); }
    SEAM(2);
    if (IN(3)) { lnres_phase<0>(a.x, a.meta, Y12, a.ln1g, a.ln1b, AB, nullptr, NREAL + NMETA, gw, NGW, lane); }
    SEAM(3);
    if (IN(4)) { pg8::Gemm g{AB, (const bf16_t*)(ws + OFF_WIN), NREAL, 3072, 1024}; pg8::StaticOrder S; S.init(NREAL, 3072, G, (int)blockIdx.x);
        skinny_meta<2>(AB + (size_t)NREAL * DM, DM, (const bf16_t*)(ws + OFF_WIN), 1024, 42, gw, NGW, lane, (bf16_t*)(ws + OFF_K8), nullptr, nullptr, (bf16_t*)(ws + OFF_V8), (bf16_t*)(ws + OFF_KI8), (bf16_t*)(ws + OFF_CU), (const float*)(ws + OFF_COS), (const float*)(ws + OFF_SIN));
        EpiProj E{(bf16_t*)(ws + OFF_QS), (bf16_t*)(ws + OFF_QI), (bf16_t*)(ws + OFF_KV), (bf16_t*)(ws + OFF_KI), (bf16_t*)(ws + OFF_CU), (bf16_t*)(ws + OFF_GB), (float*)(ws + OFF_WI), (const float*)(ws + OFF_COS), (const float*)(ws + OFF_SIN), (unsigned char*)(ws + OFF_K8), (unsigned char*)(ws + OFF_QI8), (unsigned char*)(ws + OFF_KI8), (unsigned char*)(ws + OFF_V8)};
        pg8::gemm_phase<EpiProj, pg8::StaticOrder, true, true>(lds, g, S, E); }
    SEAM(4);
    if (IN(5)) {
        conv_phase((const bf16_t*)(ws + OFF_CU), (const bf16_t*)(ws + OFF_GB), a.convw, (bf16_t*)(ws + OFF_YCV), blockIdx.x * 512 + tid, G * 512);
#ifdef DBG_SKIP_ATTN
        for (int it = blockIdx.x * 512 + tid; it < NREAL * 64; it += G * 512) *(u32x4*)((bf16_t*)(ws + OFF_ATT) + (size_t)it * 8) = (u32x4){0u, 0u, 0u, 0u};
#else
        attn_phase((const bf16_t*)(ws + OFF_QS), (const bf16_t*)(ws + OFF_QI8), (const bf16_t*)(ws + OFF_V8), (const bf16_t*)(ws + OFF_KI8), (const float*)(ws + OFF_WI), (bf16_t*)(ws + OFF_ATT), (const unsigned char*)(ws + OFF_K8), lds, wave, lane);
#ifdef PROBE_ATTN2
        attn_phase((const bf16_t*)(ws + OFF_QS), (const bf16_t*)(ws + OFF_QI8), (const bf16_t*)(ws + OFF_V8), (const bf16_t*)(ws + OFF_KI8), (const float*)(ws + OFF_WI), (bf16_t*)(ws + OFF_ATT), (const unsigned char*)(ws + OFF_K8), lds, wave, lane);
#endif
#endif
    }
    SEAM(5);
    if (IN(6)) {
        bf16_t* S1 = (bf16_t*)(ws + OFF_S1); bf16_t* S2 = (bf16_t*)(ws + OFF_S2);
#ifdef DBG_E1_M
        pg8::StaticOrder S; S.init(DBG_E1_M, 1024, G, (int)blockIdx.x);
        { pg8::Gemm g{AB, (const bf16_t*)(ws + OFF_WGA), DBG_E1_M, 1024, 1024};
#else
        pg8::StaticOrder S; S.init(NREAL, 1024, G, (int)blockIdx.x);
        { pg8::Gemm g{AB, (const bf16_t*)(ws + OFF_WGA), NREAL, 1024, 1024};
#endif
 EpiGate<0> E{S1, nullptr}; pg8::gemm_phase<EpiGate<0>, pg8::StaticOrder, true, true>(lds, g, S, E); }
#ifndef DBG_NO_E3
        { pg8::Gemm g{AB, (const bf16_t*)(ws + OFF_WGC), NREAL, 1024, 1024}; EpiGate<0> E{S2, nullptr}; pg8::gemm_phase<EpiGate<0>, pg8::StaticOrder, true, true>(lds, g, S, E); }
#endif
    }
    if (IN(6)) {
        bf16_t* S1 = (bf16_t*)(ws + OFF_S1);
        pg8::StaticOrder S; S.init(NREAL, 1024, G, (int)blockIdx.x);
        pg8::Gemm g{(const bf16_t*)(ws + OFF_ATT), (const bf16_t*)(ws + OFF_WAO), NREAL, 1024, 512}; EpiGate<1> E{S1, nullptr}; pg8::gemm_phase<EpiGate<1>, pg8::StaticOrder, true, true>(lds, g, S, E);
    }
    if (IN(6)) {
        bf16_t* S1 = (bf16_t*)(ws + OFF_S1); bf16_t* S2 = (bf16_t*)(ws + OFF_S2);
        pg8::StaticOrder S; S.init(NREAL, 1024, G, (int)blockIdx.x);
        pg8::Gemm g{(const bf16_t*)(ws + OFF_YCV), (const bf16_t*)(ws + OFF_WCO), NREAL, 1024, 512}; EpiGate<2> E{S1, S2}; pg8::gemm_phase<EpiGate<2>, pg8::StaticOrder, true, true>(lds, g, S, E);
    }
    SEAM(8);
    if (IN(9)) { pg8::Gemm g{(const bf16_t*)(ws + OFF_S1), (const bf16_t*)(ws + OFF_WO), NREAL, 1024, 1024}; pg8::StaticOrder S; S.init(NREAL, 1024, G, (int)blockIdx.x);
        EpiY E{Y12, 1.0f}; pg8::gemm_phase<EpiY, pg8::StaticOrder, true, true>(lds, g, S, E); }
    SEAM(9);
    if (IN(10)) { lnres_phase<1>(nullptr, nullptr, Y12, a.ln2g, a.ln2b, AB, nullptr, NREAL, gw, NGW, lane); }
    SEAM(10);
    if (IN(11)) { pg8::Gemm g{AB, (const bf16_t*)(ws + OFF_WGU2), NREAL, 5632, 1024}; pg8::StaticOrder S; S.init(NREAL, 5632, G, (int)blockIdx.x);
        EpiSwiglu E{HFF}; pg8::gemm_phase<EpiSwiglu, pg8::StaticOrder, true, true>(lds, g, S, E); }
    SEAM(11);
    if (IN(12)) { pg8::Gemm g{HFF, (const bf16_t*)(ws + OFF_WD2), NREAL, 1024, FF}; pg8::StaticOrder S; S.init(NREAL, 1024, G, (int)blockIdx.x);
        EpiY E{Y3, 0.5f}; pg8::gemm_phase<EpiY, pg8::StaticOrder, true, true>(lds, g, S, E); }
    SEAM(12);
    if (IN(13)) { lnres_phase<2>(nullptr, nullptr, Y3, a.ln3g, a.ln3b, AB, a.out, NREAL, gw, NGW, lane); }
#ifdef DBG_STOP
    if (lo == 100) {
        const int gt = blockIdx.x * 512 + tid, NT = G * 512;
        for (int it = gt; it < NREAL * 256; it += NT) {
            const int row = it >> 8, c4 = (it & 255) * 4; f32x4 v;
#ifdef DBG_DUMP_INPUTS
            if (c4 < 512) { const u32x2 w = *(const u32x2*)(AB + (size_t)row * DM + c4); v = (f32x4){bf_lo(w.x), bf_hi(w.x), bf_lo(w.y), bf_hi(w.y)}; }
            else if (row < 2048) { const u32x2 w = *(const u32x2*)((const bf16_t*)(ws + OFF_WGA) + (size_t)row * 512 + (c4 - 512)); v = (f32x4){bf_lo(w.x), bf_hi(w.x), bf_lo(w.y), bf_hi(w.y)}; }
            else v = (f32x4){0.f, 0.f, 0.f, 0.f};
#else
            if (DBG_STOP == 2 || DBG_STOP == 9) v = *(const f32x4*)(Z + (size_t)row * DM + c4);
            else if (DBG_STOP == 3 || DBG_STOP == 10) { const u32x2 w = *(const u32x2*)(AB + (size_t)row * DM + c4); v = (f32x4){bf_lo(w.x), bf_hi(w.x), bf_lo(w.y), bf_hi(w.y)}; }
            else if (DBG_STOP == 1 || DBG_STOP == 11) { const u32x2 w = *(const u32x2*)(HFF + (size_t)row * FF + c4); v = (f32x4){bf_lo(w.x), bf_hi(w.x), bf_lo(w.y), bf_hi(w.y)}; }
            else if (DBG_STOP == 4) { const bf16_t* src = c4 < 512 ? (const bf16_t*)(ws + OFF_QS) + (size_t)row * 512 + c4 : (const bf16_t*)(ws + OFF_CU) + (size_t)row * 512 + (c4 - 512); const u32x2 w = *(const u32x2*)src; v = (f32x4){bf_lo(w.x), bf_hi(w.x), bf_lo(w.y), bf_hi(w.y)}; }
            else if (DBG_STOP == 5) { const bf16_t* src = c4 < 512 ? (const bf16_t*)(ws + OFF_ATT) + (size_t)row * 512 + c4 : (const bf16_t*)(ws + OFF_YCV) + (size_t)row * 512 + (c4 - 512); const u32x2 w = *(const u32x2*)src; v = (f32x4){bf_lo(w.x), bf_hi(w.x), bf_lo(w.y), bf_hi(w.y)}; }
            else { const u32x2 w = *(const u32x2*)((const bf16_t*)(ws + OFF_S1) + (size_t)row * DM + c4); v = (f32x4){bf_lo(w.x), bf_hi(w.x), bf_lo(w.y), bf_hi(w.y)}; }
#endif
            *(f32x4*)(a.out + (size_t)row * DM + c4) = v;
        }
    }
#endif
#undef IN
#undef SEAM
}

extern "C" void kernel_launch(void* const* d_in, const int* in_sizes, int n_in, void* d_out, int out_size, void* d_ws, size_t ws_size, hipStream_t stream) {
    static int grid = 0;
    if (grid == 0) {
        if (n_in != 19 || in_sizes[0] != NREAL * DM || out_size != NREAL * DM || ws_size < WS_END) {
            fprintf(stderr, "kernel_launch: unexpected shapes (n_in %d, in0 %d, out %d, ws %zu, need %zu); nothing launched\n", n_in, n_in > 0 ? in_sizes[0] : -1, out_size, ws_size, (size_t)WS_END);
            grid = -1; return; }
        int dev = 0, cus = 0, per_cu = 0;
        (void)hipGetDevice(&dev); (void)hipDeviceGetAttribute(&cus, hipDeviceAttributeMultiprocessorCount, dev);
        (void)hipFuncSetAttribute((const void*)mk_fwd, hipFuncAttributeMaxDynamicSharedMemorySize, LDS_BYTES);
        (void)hipOccupancyMaxActiveBlocksPerMultiprocessor(&per_cu, (const void*)mk_fwd, NWAVES * 64, LDS_BYTES);
        if (per_cu < 1) { fprintf(stderr, "kernel_launch: occupancy query says %d blocks per CU\n", per_cu); per_cu = 1; }
        (void)hipGetLastError();
        grid = cus;
    }
    if (grid < 0) return;
    Args a{};
    a.x = (const float*)d_in[0]; a.meta = (const float*)d_in[1];
    a.f1g = (const float*)d_in[2]; a.f1u = (const float*)d_in[3]; a.f1d = (const float*)d_in[4]; a.ln1g = (const float*)d_in[5]; a.ln1b = (const float*)d_in[6];
    a.win = (const float*)d_in[7]; a.convw = (const float*)d_in[8]; a.wao = (const float*)d_in[9]; a.wco = (const float*)d_in[10]; a.wo = (const float*)d_in[11];
    a.ln2g = (const float*)d_in[12]; a.ln2b = (const float*)d_in[13]; a.f2g = (const float*)d_in[14]; a.f2u = (const float*)d_in[15]; a.f2d = (const float*)d_in[16];
    a.ln3g = (const float*)d_in[17]; a.ln3b = (const float*)d_in[18];
    a.out = (float*)d_out; a.ws = (unsigned char*)d_ws;
    (void)hipMemsetAsync((char*)d_ws + OFF_CTL, 0, SZ_CTL, stream);
#if ONE_LAUNCH
    a.ph_lo = 0; a.ph_hi = NPH;
    void* kargs[] = {&a};
    hipError_t e = hipLaunchCooperativeKernel((const void*)mk_fwd, dim3(grid), dim3(NWAVES * 64), kargs, LDS_BYTES, stream);
    if (e != hipSuccess) fprintf(stderr, "cooperative launch failed: %s (grid %d)\n", hipGetErrorString(e), grid);
#else
#ifdef DBG_STOP
    for (int ph = 0; ph <= DBG_STOP; ++ph) {
        a.ph_lo = ph; a.ph_hi = ph + 1;
        hipLaunchKernelGGL(mk_fwd, dim3(grid), dim3(NWAVES * 64), LDS_BYTES, stream, a);
    }
    a.ph_lo = 100; a.ph_hi = 101;
    hipLaunchKernelGGL(mk_fwd, dim3(grid), dim3(NWAVES * 64), LDS_BYTES, stream, a);
#else
    for (int ph = 0; ph < NPH; ++ph) {
        a.ph_lo = ph; a.ph_hi = ph + 1;
        hipLaunchKernelGGL(mk_fwd, dim3(grid), dim3(NWAVES * 64), LDS_BYTES, stream, a);
    }
#endif
#endif
}
```
